# Optimizing an MI355X kernel written in HIP

```python
import jax
import jax.numpy as jnp
from jax import lax
import numpy as np


D_MODEL = 1024
BATCH = 8
SEQ = 4096
DEPTH = 2

HEAD_DIM = 64
Q_BLK = 128
ROPE_THETA = 10000.0
LN_EPS = 1e-5
RMS_EPS = 1e-6

NSA_HEADS = 6
NSA_KV_HEADS = 2
NSA_GROUP = NSA_HEADS // NSA_KV_HEADS
NSA_WIDTH = NSA_HEADS * HEAD_DIM
CMP_LEN = 32
CMP_STRIDE = 16
SEL_BLOCK = 64
SEL_TOP = 16
WINDOW = 512
FORCE_BONUS = 1e4

DSA_HEADS = 6
DSA_WIDTH = DSA_HEADS * HEAD_DIM
DSA_LATENT = 128
IDX_HEADS = 4
IDX_DIM = 32
IDX_TOPK_MAX = 256

SGU_GROUPS = 4
SGU_CHUNK = 128
SGU_WIDTH = SGU_GROUPS * HEAD_DIM

MIX_WIDTH = NSA_WIDTH + DSA_WIDTH + SGU_WIDTH

SPLIT_SIZES = (NSA_WIDTH, 6 * NSA_KV_HEADS * HEAD_DIM, 3 * NSA_HEADS, DSA_WIDTH, DSA_LATENT, IDX_HEADS * IDX_DIM, IDX_DIM, IDX_HEADS, 2 * SGU_WIDTH)
IN_WIDTH = sum(SPLIT_SIZES)

D_FF = 2816
N_EXPERTS = 8
TOP_K = 2
EXPERT_FF = 3584
N_DENSE = (DEPTH + 1) // 2
N_MOE = DEPTH // 2

ALPHA = (2 * DEPTH) ** 0.25
BETA = (8 * DEPTH) ** -0.25
POS_OFFSET_MAX = 1024

kernel_name = 'hybrid_nsa_dsa_sgu_deepnorm_adaln_moe'


def standardize(x):
    xf = x.astype(jnp.float32)
    mu = jnp.mean(xf, -1, keepdims=True)
    var = jnp.mean(jnp.square(xf - mu), -1, keepdims=True)
    return ((xf - mu) * lax.rsqrt(var + LN_EPS)).astype(x.dtype)


def layer_norm(x, g, b):
    return standardize(x) * g + b


def rms_norm(x, g):
    xf = x.astype(jnp.float32)
    y = xf * lax.rsqrt(jnp.mean(jnp.square(xf), -1, keepdims=True) + RMS_EPS)
    return (y * g).astype(x.dtype)


def modulate(x, shift, scale):
    return standardize(x) * (1.0 + scale) + shift


def rope_tables(positions, dim):
    inv = ROPE_THETA ** (-jnp.arange(0, dim, 2, dtype=jnp.float32) / dim)
    ang = positions.astype(jnp.float32)[..., None] * inv
    return jnp.cos(ang), jnp.sin(ang)


def apply_rope(x, cos, sin):
    x1, x2 = jnp.split(x, 2, axis=-1)
    c = cos[:, :, None, :]
    s = sin[:, :, None, :]
    return jnp.concatenate([x1 * c - x2 * s, x2 * c + x1 * s], axis=-1).astype(x.dtype)


def masked_softmax(scores, mask):
    s = jnp.where(mask, scores.astype(jnp.float32), -jnp.inf)
    m = jnp.max(s, axis=-1, keepdims=True)
    m = jnp.where(jnp.isfinite(m), m, 0.0)
    p = jnp.exp(s - m)
    return p / jnp.maximum(jnp.sum(p, axis=-1, keepdims=True), 1e-30)


def nsa_mixer(q, kv, gate_logits, cos, sin, cmp_pos, cmp_w1, cmp_w2):
    B, S = q.shape[0], q.shape[1]
    G, R, dh = NSA_KV_HEADS, NSA_GROUP, HEAD_DIM
    n_cmp = (S - CMP_LEN) // CMP_STRIDE + 1
    n_blk = S // SEL_BLOCK
    n_sel = min(SEL_TOP, n_blk)
    n_q = S // Q_BLK
    scale = dh ** -0.5

    kv = kv.reshape(B, S, 6, G, dh)
    k_sel = apply_rope(kv[:, :, 2], cos, sin)
    v_sel = kv[:, :, 3]
    k_win = apply_rope(kv[:, :, 4], cos, sin)
    v_win = kv[:, :, 5]
    q_rot = apply_rope(q, cos, sin)
    gates = jax.nn.sigmoid(gate_logits.astype(jnp.float32)).astype(q.dtype)
    gates = gates.reshape(B, S, G, R, 3)

    win_idx = jnp.arange(n_cmp)[:, None] * CMP_STRIDE + jnp.arange(CMP_LEN)[None, :]

    def compress(x_tok, j):
        blocks = x_tok[:, win_idx] + cmp_pos[j][:, None, :]
        hid = jax.nn.gelu(jnp.einsum('bnlgd,lde->bnge', blocks, cmp_w1[j]))
        return jnp.einsum('bnge,ef->bngf', hid, cmp_w2[j])

    k_cmp = compress(kv[:, :, 0], 0)
    v_cmp = compress(kv[:, :, 1], 1)
    cmp_start = jnp.arange(n_cmp) * CMP_STRIDE
    cmp_end = cmp_start + CMP_LEN - 1
    blk_start = jnp.arange(n_blk) * SEL_BLOCK
    overlap = ((cmp_start[:, None] < blk_start[None, :] + SEL_BLOCK)
               & (cmp_start[:, None] + CMP_LEN > blk_start[None, :])).astype(jnp.float32)

    k_sel_blk = k_sel.reshape(B, n_blk, SEL_BLOCK, G, dh).transpose(0, 3, 1, 2, 4)
    v_sel_blk = v_sel.reshape(B, n_blk, SEL_BLOCK, G, dh).transpose(0, 3, 1, 2, 4)
    gather_blocks = jax.vmap(jax.vmap(lambda kb, ib: kb[ib]))

    pad = jnp.zeros((B, WINDOW, G, dh), k_win.dtype)
    k_win_pad = jnp.concatenate([pad, k_win], axis=1)
    v_win_pad = jnp.concatenate([pad, v_win], axis=1)
    blk_ids = jnp.arange(n_blk)

    def block(qb):
        t0 = qb * Q_BLK
        t = t0 + jnp.arange(Q_BLK)
        qc = lax.dynamic_slice_in_dim(q, t0, Q_BLK, 1).reshape(B, Q_BLK, G, R, dh)
        qr = lax.dynamic_slice_in_dim(q_rot, t0, Q_BLK, 1).reshape(B, Q_BLK, G, R, dh)

        s_c = jnp.einsum('bqgrd,bngd->bqgrn', qc, k_cmp) * scale
        p_c = masked_softmax(s_c, (cmp_end[None, :] <= t[:, None])[None, :, None, None, :])
        o_c = jnp.einsum('bqgrn,bngd->bqgrd', p_c.astype(v_cmp.dtype), v_cmp)

        imp = jnp.einsum('bqgrn,nj->bqgj', p_c, overlap)
        cur = t // SEL_BLOCK
        valid = blk_ids[None, :] <= cur[:, None]
        forced = ((blk_ids[None, :] == 0) | (blk_ids[None, :] == cur[:, None])
                  | (blk_ids[None, :] == cur[:, None] - 1)).astype(jnp.float32)
        score = jnp.where(valid[None, :, None, :], imp + FORCE_BONUS * forced[None, :, None, :], -jnp.inf)
        _, idx = lax.top_k(score, n_sel)
        idx_bg = idx.transpose(0, 2, 1, 3)
        k_g = gather_blocks(k_sel_blk, idx_bg)
        v_g = gather_blocks(v_sel_blk, idx_bg)
        key_pos = idx_bg[..., None] * SEL_BLOCK + jnp.arange(SEL_BLOCK)
        m_s = (key_pos <= t[None, None, :, None, None]).transpose(0, 2, 1, 3, 4)
        m_s = m_s.reshape(B, Q_BLK, G, 1, n_sel * SEL_BLOCK)
        s_s = jnp.einsum('bqgrd,bgqnsd->bqgrns', qr, k_g) * scale
        p_s = masked_softmax(s_s.reshape(B, Q_BLK, G, R, n_sel * SEL_BLOCK), m_s)
        p_s = p_s.reshape(B, Q_BLK, G, R, n_sel, SEL_BLOCK)
        o_s = jnp.einsum('bqgrns,bgqnsd->bqgrd', p_s.astype(v_g.dtype), v_g)

        k_w = lax.dynamic_slice_in_dim(k_win_pad, t0, WINDOW + Q_BLK, 1)
        v_w = lax.dynamic_slice_in_dim(v_win_pad, t0, WINDOW + Q_BLK, 1)
        s_pos = t0 - WINDOW + jnp.arange(WINDOW + Q_BLK)
        diff = t[:, None] - s_pos[None, :]
        m_w = (diff >= 0) & (diff < WINDOW) & (s_pos[None, :] >= 0)
        s_w = jnp.einsum('bqgrd,bsgd->bqgrs', qr, k_w) * scale
        p_w = masked_softmax(s_w, m_w[None, :, None, None, :])
        o_w = jnp.einsum('bqgrs,bsgd->bqgrd', p_w.astype(v_w.dtype), v_w)

        g = lax.dynamic_slice_in_dim(gates, t0, Q_BLK, 1)
        o = g[..., 0:1] * o_c + g[..., 1:2] * o_s + g[..., 2:3] * o_w
        return o.reshape(B, Q_BLK, NSA_WIDTH)

    out = lax.map(block, jnp.arange(n_q))
    return out.transpose(1, 0, 2, 3).reshape(B, S, NSA_WIDTH)


def dsa_mixer(q, c_kv, iq, ik, iw, cos, sin, cos_i, sin_i, kv_norm_g, w_uk, w_uv):
    B, S = q.shape[0], q.shape[1]
    k_top = min(IDX_TOPK_MAX, S // 4)
    n_q = S // Q_BLK
    scale = HEAD_DIM ** -0.5
    ckv = rms_norm(c_kv, kv_norm_g)
    k = apply_rope((ckv @ w_uk)[:, :, None, :], cos, sin)[:, :, 0]
    v = ckv @ w_uv
    q = apply_rope(q, cos, sin)
    iq = apply_rope(iq.reshape(B, S, IDX_HEADS, IDX_DIM), cos_i, sin_i)
    ik = apply_rope(ik[:, :, None, :], cos_i, sin_i)[:, :, 0]
    iw = iw * (IDX_HEADS ** -0.5)
    key_ids = jnp.arange(S)
    gather_tok = jax.vmap(lambda kb, ib: kb[ib])

    def block(qb):
        t0 = qb * Q_BLK
        t = t0 + jnp.arange(Q_BLK)
        iq_b = lax.dynamic_slice_in_dim(iq, t0, Q_BLK, 1)
        iw_b = lax.dynamic_slice_in_dim(iw, t0, Q_BLK, 1)
        logits = jnp.einsum('bqhe,bse->bqhs', iq_b, ik)
        i_score = jnp.einsum('bqh,bqhs->bqs', iw_b, jax.nn.relu(logits)).astype(jnp.float32)
        causal = key_ids[None, :] <= t[:, None]
        i_score = jnp.where(causal[None], i_score, -jnp.inf)
        _, idx = lax.top_k(i_score, k_top)
        k_g = gather_tok(k, idx)
        v_g = gather_tok(v, idx)
        q_b = lax.dynamic_slice_in_dim(q, t0, Q_BLK, 1)
        s = jnp.einsum('bqhd,bqkd->bqhk', q_b, k_g) * scale
        p = masked_softmax(s, (idx <= t[None, :, None])[:, :, None, :])
        o = jnp.einsum('bqhk,bqkd->bqhd', p.astype(v_g.dtype), v_g)
        return o.reshape(B, Q_BLK, DSA_WIDTH)

    out = lax.map(block, jnp.arange(n_q))
    return out.transpose(1, 0, 2, 3).reshape(B, S, DSA_WIDTH)


def sgu_mixer(z, norm_g, norm_b, w_s, b_s):
    B, S = z.shape[0], z.shape[1]
    z = jax.nn.gelu(z)
    u, v = jnp.split(z, 2, axis=-1)
    v = layer_norm(v.reshape(B, S, SGU_GROUPS, HEAD_DIM), norm_g, norm_b)
    v = v.reshape(B, S // SGU_CHUNK, SGU_CHUNK, SGU_GROUPS, HEAD_DIM)
    causal = jnp.tril(jnp.ones((SGU_CHUNK, SGU_CHUNK), w_s.dtype))
    s = jnp.einsum('gts,bnsgd->bntgd', w_s * causal, v) + jnp.swapaxes(b_s, 0, 1)[None, None, :, :, None]
    return u * s.reshape(B, S, SGU_WIDTH)


def swiglu(h, w_gate, w_up, w_down):
    return (jax.nn.silu(h @ w_gate) * (h @ w_up)) @ w_down


def moe_swiglu(h, w_router, b_router, w_gate, w_up, w_down):
    logits = (h @ w_router + b_router).astype(jnp.float32)
    top_val, top_idx = lax.top_k(logits, TOP_K)
    top_w = jax.nn.softmax(top_val, axis=-1)
    gates = jnp.sum(jax.nn.one_hot(top_idx, N_EXPERTS, dtype=jnp.float32) * top_w[..., None], axis=-2)
    gates = gates.astype(h.dtype)
    out = jnp.zeros_like(h)
    for e in range(N_EXPERTS):
        out = out + gates[..., e:e + 1] * swiglu(h, w_gate[e], w_up[e], w_down[e])
    return out


def setup_inputs(seed: int = 0) -> dict:
    key = jax.random.key(seed)
    ks = iter(jax.random.split(key, 40))
    D, dh = D_MODEL, HEAD_DIM

    def nrm(shape, scale):
        return jax.random.normal(next(ks), shape, jnp.float32) * scale

    x = nrm((BATCH, SEQ, D), 1.0)
    c = nrm((BATCH, D), 1.0)
    offs = jax.random.randint(next(ks), (BATCH, 1), 0, POS_OFFSET_MAX, dtype=jnp.int32)
    positions = (jnp.arange(SEQ, dtype=jnp.int32)[None, :] + offs).astype(jnp.int32)
    return {
        'x': x,
        'c': c,
        'positions': positions,
        'w_ada': nrm((DEPTH, D, 6 * D), D ** -0.5),
        'b_ada': nrm((DEPTH, 6 * D), 0.02),
        'w_in': nrm((DEPTH, D, IN_WIDTH), D ** -0.5),
        'nsa_cmp_pos': nrm((DEPTH, 2, CMP_LEN, dh), 0.5),
        'nsa_cmp_w1': nrm((DEPTH, 2, CMP_LEN, dh, dh), (CMP_LEN * dh) ** -0.5),
        'nsa_cmp_w2': nrm((DEPTH, 2, dh, dh), dh ** -0.5),
        'dsa_kv_norm': 1.0 + nrm((DEPTH, DSA_LATENT), 0.02),
        'dsa_w_uk': nrm((DEPTH, DSA_LATENT, dh), DSA_LATENT ** -0.5),
        'dsa_w_uv': nrm((DEPTH, DSA_LATENT, dh), DSA_LATENT ** -0.5),
        'sgu_norm_g': 1.0 + nrm((DEPTH, SGU_GROUPS, dh), 0.02),
        'sgu_norm_b': nrm((DEPTH, SGU_GROUPS, dh), 0.02),
        'sgu_w': nrm((DEPTH, SGU_GROUPS, SGU_CHUNK, SGU_CHUNK), SGU_CHUNK ** -0.5),
        'sgu_b': 1.0 + nrm((DEPTH, SGU_GROUPS, SGU_CHUNK), 0.02),
        'w_out': nrm((DEPTH, MIX_WIDTH, D), BETA * MIX_WIDTH ** -0.5),
        'ln1_g': 1.0 + nrm((DEPTH, D), 0.02),
        'ln1_b': nrm((DEPTH, D), 0.02),
        'ln2_g': 1.0 + nrm((DEPTH, D), 0.02),
        'ln2_b': nrm((DEPTH, D), 0.02),
        'ffn_w_gate': nrm((N_DENSE, D, D_FF), D ** -0.5),
        'ffn_w_up': nrm((N_DENSE, D, D_FF), D ** -0.5),
        'ffn_w_down': nrm((N_DENSE, D_FF, D), BETA * D_FF ** -0.5),
        'moe_w_router': nrm((N_MOE, D, N_EXPERTS), D ** -0.5),
        'moe_b_router': nrm((N_MOE, N_EXPERTS), 0.01),
        'moe_w_gate': nrm((N_MOE, N_EXPERTS, D, EXPERT_FF), D ** -0.5),
        'moe_w_up': nrm((N_MOE, N_EXPERTS, D, EXPERT_FF), D ** -0.5),
        'moe_w_down': nrm((N_MOE, N_EXPERTS, EXPERT_FF, D), BETA * EXPERT_FF ** -0.5),
    }


def reference(x, c, positions, w_ada, b_ada, w_in, nsa_cmp_pos, nsa_cmp_w1, nsa_cmp_w2,
              dsa_kv_norm, dsa_w_uk, dsa_w_uv, sgu_norm_g, sgu_norm_b, sgu_w, sgu_b,
              w_out, ln1_g, ln1_b, ln2_g, ln2_b, ffn_w_gate, ffn_w_up, ffn_w_down,
              moe_w_router, moe_b_router, moe_w_gate, moe_w_up, moe_w_down):
    B, S = x.shape[0], x.shape[1]
    cos_h, sin_h = rope_tables(positions, HEAD_DIM)
    cos_i, sin_i = rope_tables(positions, IDX_DIM)
    split_points = np.cumsum(SPLIT_SIZES)[:-1].tolist()
    c_act = jax.nn.silu(c)
    for layer in range(DEPTH):
        mod = (c_act @ w_ada[layer] + b_ada[layer])[:, None, :]
        shift1, scale1, gate1, shift2, scale2, gate2 = jnp.split(mod, 6, axis=-1)

        h = modulate(x, shift1, scale1)
        z = h @ w_in[layer]
        nsa_q, nsa_kv, nsa_g, dsa_q, dsa_ckv, idx_q, idx_k, idx_w, sgu_z = jnp.split(z, split_points, axis=-1)
        o_a = nsa_mixer(nsa_q.reshape(B, S, NSA_HEADS, HEAD_DIM), nsa_kv, nsa_g, cos_h, sin_h,
                        nsa_cmp_pos[layer], nsa_cmp_w1[layer], nsa_cmp_w2[layer])
        o_b = dsa_mixer(dsa_q.reshape(B, S, DSA_HEADS, HEAD_DIM), dsa_ckv, idx_q, idx_k, idx_w,
                        cos_h, sin_h, cos_i, sin_i, dsa_kv_norm[layer], dsa_w_uk[layer], dsa_w_uv[layer])
        o_c = sgu_mixer(sgu_z, sgu_norm_g[layer], sgu_norm_b[layer], sgu_w[layer], sgu_b[layer])
        mix = jnp.concatenate([o_a, o_b, o_c], axis=-1) @ w_out[layer]
        x = layer_norm(ALPHA * x + gate1 * mix, ln1_g[layer], ln1_b[layer])

        h = modulate(x, shift2, scale2)
        if layer % 2 == 0:
            j = layer // 2
            f = swiglu(h, ffn_w_gate[j], ffn_w_up[j], ffn_w_down[j])
        else:
            j = layer // 2
            f = moe_swiglu(h, moe_w_router[j], moe_b_router[j], moe_w_gate[j], moe_w_up[j], moe_w_down[j])
        x = layer_norm(ALPHA * x + gate2 * f, ln2_g[layer], ln2_b[layer])
    return x
```

```cpp
#include <hip/hip_runtime.h>
#include <stdint.h>
#include <math.h>

#define LAS __attribute__((address_space(3)))
typedef unsigned short u16;
typedef short bf16x8 __attribute__((ext_vector_type(8)));
typedef short s16x4 __attribute__((ext_vector_type(4)));
typedef float f32x4 __attribute__((ext_vector_type(4)));
typedef float f32x2 __attribute__((ext_vector_type(2)));
typedef float f32x16 __attribute__((ext_vector_type(16)));
typedef unsigned u32x4 __attribute__((ext_vector_type(4)));
typedef unsigned u32x2 __attribute__((ext_vector_type(2)));

constexpr int D = 1024, NB = 8, SEQ = 4096, M = NB * SEQ, DEPTH = 2;
constexpr int ZP = 2560;
constexpr int ZQ = 0, ZKV = 384, ZDQ = 1152, ZCKV = 1536, ZIQ = 1664, ZIK = 1792, ZSG = 1824, ZG = 2336, ZIW = 2360;
constexpr int INW = 2358;
constexpr int DFF = 2816, EFF = 3584, NEXP = 8;
constexpr float ALPHA = 1.41421356237309515f;
constexpr float C2 = 0.125f * 1.4426950408889634f;
constexpr int NTHR = 512;
constexpr int LDS_BYTES = 147456;
constexpr int LDS_TAB = 131072;
constexpr int MOE_ROWS = 65536 + 8 * 256;
constexpr int MOE_TILES = MOE_ROWS / 256;
constexpr int MOE_CHUNK = 128;
constexpr int MOE_NCHUNK = 2;

constexpr size_t al256(size_t x) { return (x + 255) & ~(size_t)255; }
constexpr size_t OFF_BAR = 0;
constexpr size_t OFF_MOD = 65536;
constexpr size_t OFF_COSH = OFF_MOD + (size_t)2 * 8 * 6144 * 4;
constexpr size_t OFF_SINH = OFF_COSH + (size_t)M * 32 * 4;
constexpr size_t OFF_COSI = OFF_SINH + (size_t)M * 32 * 4;
constexpr size_t OFF_SINI = OFF_COSI + (size_t)M * 16 * 4;
constexpr size_t OFF_WIN = OFF_SINI + (size_t)M * 16 * 4;
constexpr size_t OFF_WOUT = OFF_WIN + (size_t)2 * ZP * D * 2;
constexpr size_t OFF_WGU = OFF_WOUT + (size_t)2 * D * D * 2;
constexpr size_t OFF_WDN = OFF_WGU + (size_t)2 * DFF * D * 2;
constexpr size_t OFF_CW1T = OFF_WDN + (size_t)D * DFF * 2;
constexpr size_t OFF_CB1 = OFF_CW1T + (size_t)4 * 64 * 2048 * 2;
constexpr size_t OFF_SGW = OFF_CB1 + 1024;
constexpr size_t OFF_KC = OFF_SGW + (size_t)2 * 4 * 128 * 128 * 2;
constexpr size_t OFF_VCT = OFF_KC + (size_t)8 * 2 * 256 * 64 * 2;
constexpr size_t OFF_BLK = OFF_VCT + (size_t)8 * 2 * 256 * 64 * 2;
constexpr size_t OFF_TOK = OFF_BLK + (size_t)M * 2 * 8;
constexpr size_t OFF_SLOT = OFF_TOK + (size_t)M * 16;
constexpr size_t OFF_HIST = OFF_SLOT + (size_t)M * 8;
constexpr size_t OFF_RZ = al256(OFF_HIST + 256 * 8 * 4);
constexpr size_t SZ_RZ = (size_t)M * DFF * 2;
constexpr size_t OFF_RH = OFF_RZ + SZ_RZ;
constexpr size_t SZ_RH = (size_t)MOE_ROWS * D * 2;
constexpr size_t OFF_RO = OFF_RH + SZ_RH;
constexpr size_t SZ_RO = (size_t)MOE_CHUNK * 256 * EFF;
constexpr size_t OFF_OC = OFF_RO, OFF_OW = OFF_OC + (size_t)M * 384 * 2, OFF_QROT = OFF_OW + (size_t)M * 384 * 2;
constexpr size_t OFF_MASKW = OFF_QROT + (size_t)M * 384 * 2;
static_assert(OFF_MASKW + (size_t)M * 128 * 4 <= OFF_RO + SZ_RO, "R_O map");
constexpr size_t OFF_XR = OFF_RO + SZ_RO;
constexpr size_t OFF_HT = OFF_XR + (size_t)M * D * 2;
constexpr size_t WS_END = OFF_HT + (size_t)8 * 256 * EFF;
constexpr size_t OFF_MW1 = OFF_RZ;
constexpr size_t OFF_MW2 = OFF_RZ + (size_t)NEXP * 2 * EFF * D;
constexpr size_t OFF_HG8 = OFF_RZ + ((size_t)96 << 20);
static_assert(OFF_MW2 + (size_t)NEXP * D * EFF <= OFF_HG8 && OFF_HG8 + (size_t)MOE_ROWS * D <= OFF_RZ + SZ_RZ, "R_Z map");
#ifndef FFN0_FP8
#define FFN0_FP8 0
#endif
constexpr float WSC_UP = 64.f, WSC_DN = 128.f, ASC = 8.f;
constexpr int SCB_UP = 0x79797979, SCB_DN = 0x78787878, SCB_ACT = 0x7C7C7C7C;
constexpr int CTL_Q = 4096;

__device__ __forceinline__ unsigned cvt_pk_bf16(float lo, float hi) { unsigned r; asm volatile("v_cvt_pk_bf16_f32 %0, %1, %2" : "=v"(r) : "v"(lo), "v"(hi)); return r; }
__device__ __forceinline__ u16 f2bf(float f) { return (u16)(cvt_pk_bf16(f, 0.f) & 0xffffu); }
__device__ __forceinline__ float bf2f(u16 b) { return __uint_as_float(((unsigned)b) << 16); }
__device__ __forceinline__ float bflo(unsigned w) { return __uint_as_float(w << 16); }
__device__ __forceinline__ float bfhi(unsigned w) { return __uint_as_float(w & 0xffff0000u); }
__device__ __forceinline__ int lane_fresh() { unsigned z = 0u; asm volatile("" : "+v"(z)); return (int)__builtin_amdgcn_mbcnt_hi(~0u, __builtin_amdgcn_mbcnt_lo(~0u, z)); }
template <class T> __device__ __forceinline__ T bperm(T v, int src) { return __builtin_bit_cast(T, __builtin_amdgcn_ds_bpermute(src << 2, __builtin_bit_cast(int, v))); }
#define SHFL_XOR(v, m) bperm((v), lane_fresh() ^ (m))
#define SHFL_DOWN(v, o) bperm((v), lane_fresh() + (o))
#define SHFL_UP(v, o) bperm((v), lane_fresh() - (o))
#define SHFL_IDX(v, s) bperm((v), (s))
#define DPP_ADD(v, ctrl, row_mask) ((v) + __int_as_float(__builtin_amdgcn_update_dpp(0, __float_as_int(v), (ctrl), (row_mask), 0xF, false)))
__device__ __forceinline__ float wave_sum(float v) {
    v = DPP_ADD(v, 0xB1, 0xF);
    v = DPP_ADD(v, 0x4E, 0xF);
    v = DPP_ADD(v, 0x141, 0xF);
    v = DPP_ADD(v, 0x140, 0xF);
    v = DPP_ADD(v, 0x142, 0xA);
    v = DPP_ADD(v, 0x143, 0xC);
    return __int_as_float(__builtin_amdgcn_readlane(__float_as_int(v), 63)); }
__device__ __forceinline__ float gelu_tanh(float x) { const float y = 0.7978845608028654f * (x + 0.044715f * x * x * x); const float e = __expf(2.f * y); const float t = 1.f - 2.f / (e + 1.f); return 0.5f * x * (1.f + t); }
__device__ __forceinline__ int crow(int r, int hi) { return (r & 3) + 8 * (r >> 2) + 4 * hi; }

struct Params {
    const float *x, *c; const int* pos;
    const float *w_ada, *b_ada, *w_in, *cmp_pos, *cmp_w1, *cmp_w2, *kvn, *w_uk, *w_uv, *sgu_g, *sgu_bn, *sgu_w, *sgu_b, *w_out, *ln1g, *ln1b, *ln2g, *ln2b;
    const float *fg, *fu, *fd, *mr, *mbr, *mg, *mu, *md;
    float* out; char* ws;
    int phase_lo, phase_hi, use_bar, wave;
};
__device__ __forceinline__ int tid_fresh(int wave) { unsigned z = 0u; asm volatile("" : "+v"(z)); const int l = (int)__builtin_amdgcn_mbcnt_hi(~0u, __builtin_amdgcn_mbcnt_lo(~0u, z)); return (wave << 6) | l; }
#define XB_TMO      128
#define XB_XCNT(j)  (256  + 64 * (j))
#define XB_XSUB(j)  (1280 + 64 * (j))
#define XB_XGEN(j)  (2304 + 64 * (j))
#define XB_TOP      3328
#define XB_TOPGEN   3392
#define XCD_BAR_WORDS 3456
#define XB_SPIN_CAP (1u << 18)

__device__ __forceinline__ unsigned xb_ld(unsigned* p)              { return __hip_atomic_load(p, __ATOMIC_RELAXED, __HIP_MEMORY_SCOPE_AGENT); }
__device__ __forceinline__ unsigned xb_add(unsigned* p, unsigned v) { return __hip_atomic_fetch_add(p, v, __ATOMIC_RELAXED, __HIP_MEMORY_SCOPE_AGENT); }
__device__ __forceinline__ unsigned xb_xcc_id() { return (unsigned)__builtin_amdgcn_s_getreg((3 << 11) | 20) & 0xFu; }
#define XB_SPIN(cond, bar) do { unsigned _sp = 0; while (cond) { __builtin_amdgcn_s_sleep(1); \
    if ((++_sp & 255u) == 0u) { if (xb_ld(&(bar)[XB_TMO])) break; if (_sp > XB_SPIN_CAP) { atomicAdd(&(bar)[XB_TMO], 1u); break; } } } } while (0)

struct XcdBarrier {
    unsigned* bar; unsigned x; int wave;
    volatile LAS unsigned* st;
};

__device__ __forceinline__ XcdBarrier xcd_barrier_post(unsigned* bar, volatile LAS unsigned* st) {
    XcdBarrier b; b.bar = bar; b.x = xb_xcc_id(); b.st = st;
    if (threadIdx.x == 0) (void)xb_add(&bar[XB_XCNT(b.x)], 1u);
    return b;
}
__device__ __forceinline__ void xcd_barrier_complete(unsigned* bar, unsigned x, unsigned& nloc, unsigned& nx) {
    const unsigned G = gridDim.x * gridDim.y * gridDim.z;
    unsigned sum, cnt, mine, sp = 0u;
    for (;;) {
        sum = 0u; cnt = 0u; mine = 0u;
#pragma unroll
        for (unsigned j = 0; j < 16; ++j) { const unsigned c = xb_ld(&bar[XB_XCNT(j)]); sum += c; cnt += (c > 0u) ? 1u : 0u; mine = (j == x) ? c : mine; }
        if (sum == G) break;
        __builtin_amdgcn_s_sleep(1);
        if ((++sp & 255u) == 0u) { if (xb_ld(&bar[XB_TMO])) break; if (sp > XB_SPIN_CAP) { atomicAdd(&bar[XB_TMO], 1u); break; } }
    }
    nloc = mine > 0u ? mine : 1u; nx = cnt > 0u ? cnt : 1u;
}

__device__ __forceinline__ void xcd_barrier(const XcdBarrier& b) {
    asm volatile("s_waitcnt vmcnt(0)" ::: "memory");
    __syncthreads();
    if (tid_fresh(b.wave) == 0) {
        unsigned* bar = b.bar;
        __builtin_amdgcn_s_waitcnt(0);
        unsigned nloc = b.st[0], nx = b.st[1];
        if (nloc == 0u) { xcd_barrier_complete(bar, b.x, nloc, nx); b.st[0] = nloc; b.st[1] = nx; }
        const unsigned old = xb_add(&bar[XB_XSUB(b.x)], 1u);
        const unsigned gen = old / nloc;
        if (old + 1u == (gen + 1u) * nloc) {
            __builtin_amdgcn_fence(__ATOMIC_RELEASE, "agent");
            asm volatile("s_waitcnt vmcnt(0)" ::: "memory");
            const unsigned og = xb_add(&bar[XB_TOP], 1u);
            const unsigned tg = og / nx;
            if (og + 1u == (tg + 1u) * nx) xb_add(&bar[XB_TOPGEN], 1u);
            else XB_SPIN(xb_ld(&bar[XB_TOPGEN]) == tg, bar);
            __builtin_amdgcn_fence(__ATOMIC_ACQUIRE, "agent");
            xb_add(&bar[XB_XGEN(b.x)], 1u);
            asm volatile("s_waitcnt vmcnt(0)" ::: "memory");
        } else {
            XB_SPIN(xb_ld(&bar[XB_XGEN(b.x)]) == gen, bar);
            __builtin_amdgcn_fence(__ATOMIC_ACQUIRE, "agent");
            asm volatile("s_waitcnt vmcnt(0)" ::: "memory");
        }
    }
    __syncthreads();
}
namespace pg8 {
constexpr int BM = 256, BK = 64, HALF = 128, HTB = HALF * BK * 2, STAGE_BYTES = 8 * HTB, NXCD = 8, WGM = 8;
__host__ __device__ __forceinline__ int lds_byte(int r, int c) { const int st = (r >> 4) * 2 + (c >> 5), rr = r & 15, cc = c & 31, ob = rr * 64 + cc * 2; return st * 1024 + (ob ^ (((ob >> 9) & 1) << 5)); }
__host__ __device__ __forceinline__ void stage_rc(int b, int& R, int& C) { const int st = b / 1024, sb = b % 1024, swz = sb ^ (((sb >> 9) & 1) << 5); R = (st >> 1) * 16 + swz / 64; C = (st & 1) * 32 + (swz % 64) / 2; }
__host__ __device__ __forceinline__ int perm32(int rho) { const int n = rho >> 4, i = rho & 15; return 8 * (i >> 2) + 4 * n + (i & 3); }

struct Unit { int pm, pn; };

struct SchedDense {
    const char* A; const char* B; size_t tstep;
    int nM, nN, nwg, G, c;
    __device__ void init(const void* A_, const void* B_, int Mr, int N, int K, int G_, int c_) { A = (const char*)A_; B = (const char*)B_; tstep = (size_t)256 * K * 2; nM = Mr / BM; nN = N / BM; nwg = nM * nN; G = G_; c = c_; }
    __device__ bool next(int i, Unit& u) const {
        const long L = (long)i * G + c; if (L >= nwg) return false;
        int wgid = (int)L; { const int q = nwg / NXCD, r = nwg % NXCD, xcd = wgid % NXCD, off = wgid / NXCD; wgid = (xcd < r ? xcd * (q + 1) : r * (q + 1) + (xcd - r) * q) + off; }
        const int nig = WGM * nN, gid = wgid / nig, fm = gid * WGM, gsz = (nM - fm) < WGM ? (nM - fm) : WGM;
        u.pm = fm + ((wgid % nig) % gsz); u.pn = (wgid % nig) / gsz; return true;
    }
    __device__ __forceinline__ const char* a_ptr(const Unit& u) const { return A + (size_t)u.pm * tstep; }
    __device__ __forceinline__ const char* b_ptr(const Unit& u) const { return B + (size_t)u.pn * tstep; }
};
struct SchedMoe {
    const char* A; const char* B; size_t tstep, estride; int tile0, ntile, nN, G, c; const LAS int* texp;
    __device__ bool next(int i, Unit& u) const { const long L = (long)i * G + c; if (L >= (long)ntile * nN) return false; u.pm = tile0 + (int)(L % ntile); u.pn = (int)(L / ntile); return true; }
    __device__ __forceinline__ const char* a_ptr(const Unit& u) const { return A + (size_t)u.pm * tstep; }
    __device__ __forceinline__ const char* b_ptr(const Unit& u) const { return B + (size_t)texp[u.pm] * estride + (size_t)u.pn * tstep; }
};

struct SchedMoeSkip {
    const char* A; const char* B; size_t tstep, estride; int tile0, ntile, nN, G, c; const LAS int* texp; int nlong, skip;
    __device__ bool next(int i, Unit& u) const { const long tot = (long)ntile * nN; long L;
        if (c < nlong) L = (long)(i + skip) * G + c;
        else { const long nreg = (tot - c + G - 1) / G; if (i < nreg) L = (long)i * G + c; else { const int a = c - nlong; if (i > nreg || a >= nlong * skip) return false; L = (long)(a / nlong) * G + (a % nlong); } }
        if (L >= tot) return false; u.pm = tile0 + (int)(L % ntile); u.pn = (int)(L / ntile); return true; }
    __device__ __forceinline__ const char* a_ptr(const Unit& u) const { return A + (size_t)u.pm * tstep; }
    __device__ __forceinline__ const char* b_ptr(const Unit& u) const { return B + (size_t)texp[u.pm] * estride + (size_t)u.pn * tstep; }
};

struct EpiBf16 {
    u16* O; int ldc; float sc = 1.f;
    __device__ __forceinline__ void operator()(const f32x4 (&acc)[2][2][4][2], const Unit& u, int wr, int wc, int fr, int fq) const {
        const int row0 = u.pm * BM + wr * 64 + fr; const int col0 = u.pn * BM + wc * 32 + 8 * fq;
#pragma unroll
        for (int ai = 0; ai < 2; ++ai)
#pragma unroll
            for (int m = 0; m < 4; ++m) { u16* rowp = O + (size_t)(row0 + ai * HALF + m * 16) * ldc + col0;
#pragma unroll
                for (int bj = 0; bj < 2; ++bj) { const f32x4 v0 = acc[ai][bj][m][0] * sc, v1 = acc[ai][bj][m][1] * sc;
                    u32x4 w; w.x = cvt_pk_bf16(v0[0], v0[1]); w.y = cvt_pk_bf16(v0[2], v0[3]); w.z = cvt_pk_bf16(v1[0], v1[1]); w.w = cvt_pk_bf16(v1[2], v1[3]);
                    *(u32x4*)(rowp + bj * HALF) = w; } }
    }
};
struct EpiSwiglu {
    u16* H; int ldc; int row_off; float isc = 1.f;
    __device__ __forceinline__ void operator()(const f32x4 (&acc)[2][2][4][2], const Unit& u, int wr, int wc, int fr, int fq) const {
        const int row0 = u.pm * BM - row_off + wr * 64 + fr; const int col0 = u.pn * HALF + wc * 32 + 8 * fq;
#pragma unroll
        for (int ai = 0; ai < 2; ++ai)
#pragma unroll
            for (int m = 0; m < 4; ++m) { u16* rowp = H + (size_t)(row0 + ai * HALF + m * 16) * ldc + col0;
                float o[8];
#pragma unroll
                for (int n = 0; n < 2; ++n)
#pragma unroll
                    for (int j = 0; j < 4; ++j) { const float g = acc[ai][0][m][n][j] * isc, up = acc[ai][1][m][n][j] * isc; o[n * 4 + j] = g * __builtin_amdgcn_rcpf(1.f + __expf(-g)) * up; }
                u32x4 w; w.x = cvt_pk_bf16(o[0], o[1]); w.y = cvt_pk_bf16(o[2], o[3]); w.z = cvt_pk_bf16(o[4], o[5]); w.w = cvt_pk_bf16(o[6], o[7]);
                *(u32x4*)rowp = w; }
    }
};

typedef int i32x8 __attribute__((ext_vector_type(8)));
typedef int i32x4 __attribute__((ext_vector_type(4)));
__device__ __forceinline__ i32x8 cat8(bf16x8 a, bf16x8 b) { const i32x4 x = __builtin_bit_cast(i32x4, a), y = __builtin_bit_cast(i32x4, b); return __builtin_shufflevector(x, y, 0, 1, 2, 3, 4, 5, 6, 7); }
__device__ __forceinline__ float clamp448(float x) { return __builtin_fminf(__builtin_fmaxf(x, -448.f), 448.f); }
__device__ __forceinline__ unsigned pk4_fp8(float a, float b, float c, float d) { int w = 0; w = __builtin_amdgcn_cvt_pk_fp8_f32(clamp448(a), clamp448(b), w, false); w = __builtin_amdgcn_cvt_pk_fp8_f32(clamp448(c), clamp448(d), w, true); return (unsigned)w; }
struct EpiSwiglu8 {
    unsigned char* H; int ldc; int row_off; float hsc; float isc;
    __device__ __forceinline__ void operator()(const f32x4 (&acc)[2][2][4][2], const Unit& u, int wr, int wc, int fr, int fq) const {
        const int row0 = u.pm * BM - row_off + wr * 64 + fr; const int col0 = u.pn * HALF + wc * 32 + 8 * fq;
#pragma unroll
        for (int ai = 0; ai < 2; ++ai)
#pragma unroll
            for (int m = 0; m < 4; ++m) { unsigned char* rowp = H + (size_t)(row0 + ai * HALF + m * 16) * ldc + col0;
                float o[8];
#pragma unroll
                for (int n = 0; n < 2; ++n)
#pragma unroll
                    for (int j = 0; j < 4; ++j) { const float g = acc[ai][0][m][n][j] * isc, up = acc[ai][1][m][n][j] * isc; o[n * 4 + j] = g * __builtin_amdgcn_rcpf(1.f + __expf(-g)) * up * hsc; }
                u32x2 w; w.x = pk4_fp8(o[0], o[1], o[2], o[3]); w.y = pk4_fp8(o[4], o[5], o[6], o[7]);
                *(u32x2*)rowp = w; }
    }
};

template <class Epi, class Sched, bool FP8 = false, int SCW = 0x7F7F7F7F, int SCA = 0x7F7F7F7F>
__device__ __forceinline__ void gemm_phase(LAS unsigned char* lds, const int K, const Sched& S, const Epi& E, const int wave) {
    const int tid = tid_fresh(wave), wid = __builtin_amdgcn_readfirstlane(tid >> 6), lane = tid & 63, wr = wid >> 2, wc = wid & 3, fr = lane & 15, fq = lane >> 4;
    const int nt = K / BK;
    unsigned voffA[2], voffB[2];
#pragma unroll
    for (int i = 0; i < 2; ++i) { int R, C; stage_rc(tid * 16 + i * 8192, R, C); const int Rb = (R & ~31) + perm32(R & 31);
        voffA[i] = (unsigned)(R * K + C) * 2u; voffB[i] = (unsigned)(Rb * K + C) * 2u; }
    const size_t kstep = (size_t)(BK * 2);
    const size_t hstep = (size_t)HALF * K * 2;
    const unsigned ldsw = (unsigned)wid * 1024u;
    const int aoff = lds_byte(wr * 64 + fr, fq * 8), boff = lds_byte(wc * 32 + fr, fq * 8);
#define PG8_SA(b, h) (((b) * 2 + (h)) * HTB)
#define PG8_SB(b, h) ((4 + (b) * 2 + (h)) * HTB)
#define PG8_STAGE(bufoff, gbase, voff) do { _Pragma("unroll") for (int _i = 0; _i < 2; ++_i) \
        __builtin_amdgcn_global_load_lds((const unsigned*)((const char*)(gbase) + (voff)[_i]), (LAS unsigned*)(lds + (bufoff) + ldsw + _i * 8192), 16, 0, 0); } while (0)
#define PG8_LDA(dst, b, h) do { if (FP8) { _Pragma("unroll") for (int m = 0; m < 4; ++m) dst##8[m] = cat8(*(const LAS bf16x8*)(lds + PG8_SA(b, h) + aoff + m * 2048), *(const LAS bf16x8*)(lds + PG8_SA(b, h) + aoff + m * 2048 + 1024)); } \
        else { _Pragma("unroll") for (int m = 0; m < 4; ++m) _Pragma("unroll") for (int k = 0; k < 2; ++k) dst[m][k] = *(const LAS bf16x8*)(lds + PG8_SA(b, h) + aoff + m * 2048 + k * 1024); } } while (0)
#define PG8_LDB(dst, b, h) do { if (FP8) { _Pragma("unroll") for (int n = 0; n < 2; ++n) dst##8[n] = cat8(*(const LAS bf16x8*)(lds + PG8_SB(b, h) + boff + n * 2048), *(const LAS bf16x8*)(lds + PG8_SB(b, h) + boff + n * 2048 + 1024)); } \
        else { _Pragma("unroll") for (int n = 0; n < 2; ++n) _Pragma("unroll") for (int k = 0; k < 2; ++k) dst[n][k] = *(const LAS bf16x8*)(lds + PG8_SB(b, h) + boff + n * 2048 + k * 1024); } } while (0)
#define PG8_MMA(ai, bj, At, Bt) do { __builtin_amdgcn_s_setprio(1); \
        if (FP8) { _Pragma("unroll") for (int m = 0; m < 4; ++m) _Pragma("unroll") for (int n = 0; n < 2; ++n) \
            asm volatile("v_mfma_f32_16x16x128_f8f6f4 %0, %1, %2, %0" : "+v"(acc[ai][bj][m][n]) : "v"(Bt##8[n]), "v"(At##8[m])); } \
        else { _Pragma("unroll") for (int m = 0; m < 4; ++m) _Pragma("unroll") for (int n = 0; n < 2; ++n) _Pragma("unroll") for (int k = 0; k < 2; ++k) \
            acc[ai][bj][m][n] = __builtin_amdgcn_mfma_f32_16x16x32_bf16(Bt[n][k], At[m][k], acc[ai][bj][m][n], 0, 0, 0); } \
        __builtin_amdgcn_s_setprio(0); } while (0)
#define PG8_WAIT_V(n) asm volatile("s_waitcnt vmcnt(" #n ")" ::: "memory")
#define PG8_WAIT_L(n) asm volatile("s_waitcnt lgkmcnt(" #n ")" ::: "memory")
#define PG8_BAR __builtin_amdgcn_s_barrier()
#define PG8_SCHED __builtin_amdgcn_sched_barrier(0)
    Unit cur, nxt; int ui = 0;
    if (!S.next(0, cur)) return;
    f32x4 acc[2][2][4][2];
#pragma unroll
    for (int a = 0; a < 2; ++a)
#pragma unroll
        for (int b = 0; b < 2; ++b)
#pragma unroll
            for (int m = 0; m < 4; ++m)
#pragma unroll
                for (int n = 0; n < 2; ++n) acc[a][b][m][n] = (f32x4){0.f, 0.f, 0.f, 0.f};
    bf16x8 At[4][2], B0[2][2], B1[2][2]; i32x8 At8[4], B08[2], B18[2];
    const char* cA = S.a_ptr(cur); const char* cB = S.b_ptr(cur);
    PG8_STAGE(PG8_SB(0, 0), cB, voffB); PG8_STAGE(PG8_SA(0, 0), cA, voffA); PG8_STAGE(PG8_SB(0, 1), cB + hstep, voffB); PG8_STAGE(PG8_SA(0, 1), cA + hstep, voffA);
    if (wr == 1) PG8_BAR;
    PG8_WAIT_V(4); PG8_BAR;
    PG8_STAGE(PG8_SB(1, 0), cB + kstep, voffB); PG8_STAGE(PG8_SA(1, 0), cA + kstep, voffA); PG8_STAGE(PG8_SB(1, 1), cB + hstep + kstep, voffB);
    PG8_WAIT_V(6); PG8_BAR;
    for (;;) {
        const bool has_next = S.next(ui + 1, nxt);
        const char* nA = has_next ? S.a_ptr(nxt) : cA; const char* nB = has_next ? S.b_ptr(nxt) : cB;
        for (int t = 0; t < nt; t += 2) {
            const bool last = (t == nt - 2);
            const char* a1 = cA + (size_t)(t + 1) * kstep;
            const char* a2 = last ? nA : cA + (size_t)(t + 2) * kstep; const char* b2 = last ? nB : cB + (size_t)(t + 2) * kstep;
            const char* a3 = a2 + kstep; const char* b3 = b2 + kstep;
            PG8_LDB(B0, 0, 0); PG8_SCHED; PG8_LDA(At, 0, 0); PG8_STAGE(PG8_SA(1, 1), a1 + hstep, voffA);
            PG8_WAIT_L(8); PG8_BAR; PG8_WAIT_L(0); PG8_MMA(0, 0, At, B0); PG8_BAR; PG8_SCHED;
            PG8_LDB(B1, 0, 1); PG8_STAGE(PG8_SB(0, 0), b2, voffB);
            PG8_BAR; PG8_WAIT_L(0); PG8_MMA(0, 1, At, B1); PG8_BAR;
            PG8_LDA(At, 0, 1); PG8_STAGE(PG8_SA(0, 0), a2, voffA);
            PG8_BAR; PG8_WAIT_L(0); PG8_MMA(1, 0, At, B0); PG8_BAR; PG8_SCHED;
            PG8_STAGE(PG8_SB(0, 1), b2 + hstep, voffB);
            PG8_WAIT_V(6); PG8_BAR; PG8_MMA(1, 1, At, B1); PG8_BAR;
            PG8_LDB(B0, 1, 0); PG8_SCHED; PG8_LDA(At, 1, 0); PG8_STAGE(PG8_SA(0, 1), a2 + hstep, voffA);
            PG8_WAIT_L(8); PG8_BAR; PG8_WAIT_L(0); PG8_MMA(0, 0, At, B0); PG8_BAR; PG8_SCHED;
            PG8_LDB(B1, 1, 1); PG8_STAGE(PG8_SB(1, 0), b3, voffB);
            PG8_BAR; PG8_WAIT_L(0); PG8_MMA(0, 1, At, B1); PG8_BAR;
            PG8_LDA(At, 1, 1); PG8_STAGE(PG8_SA(1, 0), a3, voffA);
            PG8_BAR; PG8_WAIT_L(0); PG8_MMA(1, 0, At, B0); PG8_BAR; PG8_SCHED;
            PG8_STAGE(PG8_SB(1, 1), b3 + hstep, voffB);
            PG8_WAIT_V(6); PG8_BAR; PG8_MMA(1, 1, At, B1); PG8_BAR;
        }
        if (FP8) asm volatile("s_nop 15\n\ts_nop 7" ::: "memory");
        E(acc, cur, wr, wc, fr, fq);
        if (!has_next) break;
#pragma unroll
        for (int a = 0; a < 2; ++a)
#pragma unroll
            for (int b = 0; b < 2; ++b)
#pragma unroll
                for (int m = 0; m < 4; ++m)
#pragma unroll
                    for (int n = 0; n < 2; ++n) acc[a][b][m][n] = (f32x4){0.f, 0.f, 0.f, 0.f};
        cur = nxt; cA = nA; cB = nB; ++ui;
    }
    PG8_WAIT_V(0);
    if (wr == 0) PG8_BAR;
    PG8_BAR;
#undef PG8_SA
#undef PG8_SB
#undef PG8_STAGE
#undef PG8_LDA
#undef PG8_LDB
#undef PG8_MMA
#undef PG8_WAIT_V
#undef PG8_WAIT_L
#undef PG8_BAR
#undef PG8_SCHED
}
}
__device__ __forceinline__ int zcol_to_orig(int n) {
    if (n < 1152) return n;
    if (n < 1536) return 1170 + (n - 1152);
    if (n < 1664) return 1554 + (n - 1536);
    if (n < 1792) return 1682 + (n - 1664);
    if (n < 1824) return 1810 + (n - 1792);
    if (n < 2336) return 1846 + (n - 1824);
    if (n < 2354) return 1152 + (n - 2336);
    if (n < 2360) return -1;
    if (n < 2364) return 1842 + (n - 2360);
    return -1;
}
__constant__ float ROPE_INV[32] = {1.f, 0.749894261f, 0.562341332f, 0.421696514f, 0.316227764f, 0.237137377f, 0.177827939f, 0.133352131f, 0.100000001f, 0.0749894157f, 0.0562341325f, 0.0421696529f, 0.0316227749f, 0.0237137377f, 0.0177827943f, 0.0133352149f,
    0.00999999978f, 0.00749894185f, 0.00562341325f, 0.00421696482f, 0.00316227763f, 0.00237137359f, 0.00177827943f, 0.00133352145f, 0.00100000005f, 0.000749894243f, 0.000562341302f, 0.000421696517f, 0.000316227757f, 0.00023713737f, 0.00017782794f, 0.00013335215f};
template <class F, bool OUT8 = false> __device__ __forceinline__ void conv_tile(LAS float* tile, const F srcp, int ld, int n0, int k0, void* dstv, int K, int wave, float sc = 1.f) {
    const int tid = tid_fresh(wave);
    { const int nn = tid & 63, kk = tid >> 6; const float* p = srcp(n0 + nn); float v[16];
#pragma unroll
      for (int ps = 0; ps < 16; ++ps) v[ps] = p ? p[(size_t)(k0 + ps * 8 + kk) * ld] : 0.f;
#pragma unroll
      for (int ps = 0; ps < 16; ++ps) tile[(ps * 8 + kk) * 65 + nn] = v[ps]; }
    __syncthreads();
    if (OUT8) { const int nn = tid >> 3, kc = tid & 7; float v[16];
#pragma unroll
      for (int i = 0; i < 16; ++i) v[i] = tile[(kc * 16 + i) * 65 + nn] * sc;
      u32x4 w; w.x = pg8::pk4_fp8(v[0], v[1], v[2], v[3]); w.y = pg8::pk4_fp8(v[4], v[5], v[6], v[7]); w.z = pg8::pk4_fp8(v[8], v[9], v[10], v[11]); w.w = pg8::pk4_fp8(v[12], v[13], v[14], v[15]);
      *(u32x4*)((unsigned char*)dstv + (size_t)(n0 + nn) * K + k0 + kc * 16) = w;
    } else { u16* dst = (u16*)dstv;
#pragma unroll
    for (int hf = 0; hf < 2; ++hf) { const int nn = tid >> 3, kc = (tid & 7) + 8 * hf; float v[8];
#pragma unroll
      for (int i = 0; i < 8; ++i) v[i] = tile[(kc * 8 + i) * 65 + nn];
      u32x4 w; w.x = cvt_pk_bf16(v[0], v[1]); w.y = cvt_pk_bf16(v[2], v[3]); w.z = cvt_pk_bf16(v[4], v[5]); w.w = cvt_pk_bf16(v[6], v[7]);
      *(u32x4*)(dst + (size_t)(n0 + nn) * K + k0 + kc * 8) = w; } }
    __syncthreads();
}
struct SrcPlain { const float* base; __device__ __forceinline__ const float* operator()(int n) const { return base + n; } };
struct SrcWin { const float* base; __device__ __forceinline__ const float* operator()(int n) const { const int o = zcol_to_orig(n); return o < 0 ? nullptr : base + o; } };
struct SrcGU { const float* g; const float* u; __device__ __forceinline__ const float* operator()(int n) const { const int pn = n >> 8, bj = (n >> 7) & 1, j = n & 127; const uintptr_t a = (uintptr_t)g, d = (uintptr_t)u - (uintptr_t)g; return (const float*)(a + (uintptr_t)bj * d) + pn * 128 + j; } };

constexpr int PJ_WIN = 0, PJ_WOUT = PJ_WIN + 2 * 40 * 8, PJ_WGU = PJ_WOUT + 2 * 16 * 8, PJ_WDN = PJ_WGU + 88 * 8, PJ_CW1 = PJ_WDN + 16 * 22, PJ_MOD = PJ_CW1 + 4 * 16,
              PJ_ROPE = PJ_MOD + 192, PJ_CB1 = PJ_ROPE + 256, PJ_SGW = PJ_CB1 + 4, PJ_WKV = PJ_SGW + 64, PJ_END = PJ_WKV + 2 * 16;

__device__ __forceinline__ void prologue_job(const Params& p, int job, LAS unsigned char* lds) {
    char* ws = p.ws; const int tid = tid_fresh(p.wave);
    LAS float* tile = (LAS float*)lds;
    if (job < PJ_WOUT) { const int j = job - PJ_WIN, layer = j / 320, r = j % 320, nt = r / 8, kt = r % 8;
        if (nt == 37 || nt == 38) return;
        SrcWin s{p.w_in + (size_t)layer * D * INW}; conv_tile(tile, s, INW, nt * 64, kt * 128, (u16*)(ws + OFF_WIN) + (size_t)layer * ZP * D, D, p.wave);
    } else if (job < PJ_WGU) { const int j = job - PJ_WOUT, layer = j / 128, r = j % 128, nt = r / 8, kt = r % 8;
        SrcPlain s{p.w_out + (size_t)layer * D * D}; conv_tile(tile, s, D, nt * 64, kt * 128, (u16*)(ws + OFF_WOUT) + (size_t)layer * D * D, D, p.wave);
    } else if (job < PJ_WDN) { const int j = job - PJ_WGU, nt = j / 8, kt = j % 8;
        SrcGU s{p.fg, p.fu};
        if (FFN0_FP8) conv_tile<SrcGU, true>(tile, s, DFF, nt * 64, kt * 128, ws + OFF_WGU, D, p.wave, WSC_UP); else conv_tile(tile, s, DFF, nt * 64, kt * 128, (u16*)(ws + OFF_WGU), D, p.wave);
    } else if (job < PJ_CW1) { const int j = job - PJ_WDN, nt = j / 22, kt = j % 22;
        SrcPlain s{p.fd};
        if (FFN0_FP8 == 2) conv_tile<SrcPlain, true>(tile, s, D, nt * 64, kt * 128, ws + OFF_WDN, DFF, p.wave, WSC_DN); else conv_tile(tile, s, D, nt * 64, kt * 128, (u16*)(ws + OFF_WDN), DFF, p.wave);
    } else if (job < PJ_MOD) { const int j = job - PJ_CW1, mat = j / 16, kt = j % 16;
        SrcPlain s{p.cmp_w1 + (size_t)mat * 2048 * 64}; conv_tile(tile, s, 64, 0, kt * 128, (u16*)(ws + OFF_CW1T) + (size_t)mat * 64 * 2048, 2048, p.wave);
    } else if (job < PJ_ROPE) {
        const int j = job - PJ_MOD, layer = j / 96, cg = j % 96;
        LAS float* cact = (LAS float*)lds;
        LAS float* red = cact + 8 * 1024;
        for (int i = tid; i < 8 * 1024; i += NTHR) { const float v = p.c[i]; cact[i] = v / (1.f + __expf(-v)); }
        __syncthreads();
        const int col = tid & 63, kg = tid >> 6; float acc[8];
#pragma unroll
        for (int b = 0; b < 8; ++b) acc[b] = 0.f;
        const float* w = p.w_ada + (size_t)layer * D * 6144 + cg * 64 + col;
#pragma unroll 16
        for (int k = kg; k < 1024; k += 8) { const float wv = w[(size_t)k * 6144];
#pragma unroll
            for (int b = 0; b < 8; ++b) acc[b] = fmaf(cact[b * 1024 + k], wv, acc[b]); }
#pragma unroll
        for (int b = 0; b < 8; ++b) red[(kg * 8 + b) * 64 + col] = acc[b];
        __syncthreads();
        { const int b = tid >> 6; float s = 0.f;
#pragma unroll
          for (int g = 0; g < 8; ++g) s += red[(g * 8 + b) * 64 + col];
          ((float*)(ws + OFF_MOD))[((size_t)layer * 8 + b) * 6144 + cg * 64 + col] = s + p.b_ada[layer * 6144 + cg * 64 + col]; }
        __syncthreads();
    } else if (job < PJ_CB1) {
        const int j = job - PJ_ROPE;
        float* ch = (float*)(ws + OFF_COSH); float* sh = (float*)(ws + OFF_SINH); float* ci = (float*)(ws + OFF_COSI); float* si = (float*)(ws + OFF_SINI);
        for (int e = tid; e < 128 * 32; e += NTHR) { const int row = j * 128 + (e >> 5), i = e & 31; const float ang = (float)p.pos[row] * ROPE_INV[i];
            const double rev = (double)ang * 0.15915494309189535; const float fr = (float)(rev - floor(rev));
            ch[(size_t)row * 32 + i] = __builtin_amdgcn_cosf(fr); sh[(size_t)row * 32 + i] = __builtin_amdgcn_sinf(fr); }
        for (int e = tid; e < 128 * 16; e += NTHR) { const int row = j * 128 + (e >> 4), i = e & 15; const float ang = (float)p.pos[row] * ROPE_INV[2 * i];
            const double rev = (double)ang * 0.15915494309189535; const float fr = (float)(rev - floor(rev));
            ci[(size_t)row * 16 + i] = __builtin_amdgcn_cosf(fr); si[(size_t)row * 16 + i] = __builtin_amdgcn_sinf(fr); }
    } else if (job < PJ_SGW) {
        const int mat = job - PJ_CB1; LAS float* red = (LAS float*)lds;
        const int e = tid & 63, kg = tid >> 6; float s = 0.f;
        const float* w = p.cmp_w1 + (size_t)mat * 2048 * 64; const float* ps = p.cmp_pos + (size_t)mat * 2048;
#pragma unroll 16
        for (int k = kg * 256; k < kg * 256 + 256; ++k) s = fmaf(ps[k], w[(size_t)k * 64 + e], s);
        red[kg * 64 + e] = s; __syncthreads();
        if (tid < 64) { float t = 0.f;
#pragma unroll
            for (int g = 0; g < 8; ++g) t += red[g * 64 + tid];
            ((float*)(ws + OFF_CB1))[mat * 64 + tid] = t; }
        __syncthreads();
    } else if (job >= PJ_WKV) {
        const int j = job - PJ_WKV, layer = j / 16, kb = j % 16;
        LAS float* Aw = (LAS float*)lds; LAS float* Wg = Aw + 64 * 128;
        for (int i = tid; i < 64 * 128; i += NTHR) Aw[i] = p.w_in[((size_t)layer * D + kb * 64 + (i >> 7)) * INW + 1554 + (i & 127)];
        for (int i = tid; i < 128 * 128; i += NTHR) { const int c = i >> 7, n = i & 127; Wg[i] = p.kvn[layer * 128 + c] * (n < 64 ? p.w_uk[((size_t)layer * 128 + c) * 64 + n] : p.w_uv[((size_t)layer * 128 + c) * 64 + n - 64]); }
        __syncthreads();
        { const int n = tid & 127, kq = tid >> 7; float acc[16];
#pragma unroll
          for (int i = 0; i < 16; ++i) acc[i] = 0.f;
          for (int c = 0; c < 128; ++c) { const float w = Wg[c * 128 + n];
#pragma unroll
              for (int i = 0; i < 16; ++i) acc[i] = fmaf(Aw[(kq * 16 + i) * 128 + c], w, acc[i]); }
          u16* dst = (u16*)(ws + OFF_WIN) + (size_t)layer * ZP * D + (size_t)(2368 + n) * D + kb * 64 + kq * 16;
          u32x4 w0, w1; w0.x = cvt_pk_bf16(acc[0], acc[1]); w0.y = cvt_pk_bf16(acc[2], acc[3]); w0.z = cvt_pk_bf16(acc[4], acc[5]); w0.w = cvt_pk_bf16(acc[6], acc[7]);
          w1.x = cvt_pk_bf16(acc[8], acc[9]); w1.y = cvt_pk_bf16(acc[10], acc[11]); w1.z = cvt_pk_bf16(acc[12], acc[13]); w1.w = cvt_pk_bf16(acc[14], acc[15]);
          *(u32x4*)dst = w0; *(u32x4*)(dst + 8) = w1; }
        __syncthreads();
    } else {
        const int j = job - PJ_SGW; u16* dst = (u16*)(ws + OFF_SGW);
        for (int e = j * 2048 + tid; e < j * 2048 + 2048; e += NTHR) { const int t = (e >> 7) & 127, s = e & 127; dst[e] = f2bf(s <= t ? p.sgu_w[e] : 0.f); }
    }
}
constexpr int MJ_W1 = 0, MJ_W2 = NEXP * 112 * 4, MJ_END = MJ_W2 + NEXP * 16 * 14;
struct MoeConvJob { const float* src; unsigned char* dst; int ld, K; float sc; };
__device__ __forceinline__ MoeConvJob moe_conv_decode(const Params& p, int job, int tid) {
    MoeConvJob J; const int nn = tid & 63;
    if (job < MJ_W2) { const int e = job / 448, r = job % 448, nt = r / 4, kt = r % 4; const int n = nt * 64 + nn; const int pn = n >> 8, bj = (n >> 7) & 1, j = n & 127;
        const uintptr_t a = (uintptr_t)(p.mg + (size_t)e * D * EFF), dlt = (uintptr_t)(p.mu + (size_t)e * D * EFF) - a;
        J.src = (const float*)(a + (uintptr_t)bj * dlt) + pn * 128 + j + (size_t)(kt * 256) * EFF; J.ld = EFF; J.K = D; J.sc = WSC_UP; J.dst = (unsigned char*)(p.ws + OFF_MW1) + (size_t)e * 2 * EFF * D + (size_t)(nt * 64) * D + kt * 256;
    } else { const int jj = job - MJ_W2, e = jj / 224, r = jj % 224, nt = r / 14, kt = r % 14;
        J.src = p.md + (size_t)e * EFF * D + nt * 64 + nn + (size_t)(kt * 256) * D; J.ld = D; J.K = EFF; J.sc = WSC_DN; J.dst = (unsigned char*)(p.ws + OFF_MW2) + (size_t)e * D * EFF + (size_t)(nt * 64) * EFF + kt * 256; }
    return J;
}
__device__ __forceinline__ void moe_conv_all(const Params& p, LAS unsigned char* lds) {
    const int tid = tid_fresh(p.wave), kk = tid >> 6, nn = tid & 63, G = gridDim.x; LAS float* tile = (LAS float*)lds;
    int job = blockIdx.x; if (job >= MJ_END) return;
    MoeConvJob J = moe_conv_decode(p, job, tid); float v[32];
#pragma unroll
    for (int ps = 0; ps < 32; ++ps) v[ps] = J.src[(size_t)(ps * 8 + kk) * J.ld];
    for (;;) { const int nj = job + G; const bool more = nj < MJ_END; MoeConvJob N = J; float w[32];
        if (more) { N = moe_conv_decode(p, nj, tid);
#pragma unroll
            for (int ps = 0; ps < 32; ++ps) w[ps] = N.src[(size_t)(ps * 8 + kk) * N.ld]; }
#pragma unroll
        for (int ps = 0; ps < 32; ++ps) tile[(ps * 8 + kk) * 65 + nn] = v[ps];
        __syncthreads();
        { const int n2 = tid >> 3, kc = tid & 7;
#pragma unroll
          for (int hf = 0; hf < 2; ++hf) { float x[16];
#pragma unroll
              for (int i = 0; i < 16; ++i) x[i] = tile[(kc * 32 + hf * 16 + i) * 65 + n2] * J.sc;
              u32x4 o; o.x = pg8::pk4_fp8(x[0], x[1], x[2], x[3]); o.y = pg8::pk4_fp8(x[4], x[5], x[6], x[7]); o.z = pg8::pk4_fp8(x[8], x[9], x[10], x[11]); o.w = pg8::pk4_fp8(x[12], x[13], x[14], x[15]);
              *(u32x4*)(J.dst + (size_t)n2 * J.K + kc * 32 + hf * 16) = o; } }
        __syncthreads();
        if (!more) break;
        job = nj; J = N;
#pragma unroll
        for (int ps = 0; ps < 32; ++ps) v[ps] = w[ps];
    }
}
__device__ __forceinline__ void row_stats(const f32x4 (&v)[4], float& mu, float& rstd) {
    float s = 0.f;
#pragma unroll
    for (int i = 0; i < 4; ++i) s += (v[i][0] + v[i][1]) + (v[i][2] + v[i][3]);
    s = wave_sum(s); mu = s * (1.f / 1024.f); float q = 0.f;
#pragma unroll
    for (int i = 0; i < 4; ++i) { const f32x4 d = v[i] - mu; q += (d[0] * d[0] + d[1] * d[1]) + (d[2] * d[2] + d[3] * d[3]); }
    q = wave_sum(q); rstd = rsqrtf(q * (1.f / 1024.f) + 1e-5f);
}
__device__ __forceinline__ void ld_row_f32(const float* p, int lane, f32x4 (&v)[4]) {
#pragma unroll
    for (int i = 0; i < 4; ++i) v[i] = *(const f32x4*)(p + i * 256 + lane * 4); }
__device__ __forceinline__ void ld_row_bf16(const u16* p, int lane, f32x4 (&v)[4]) {
#pragma unroll
    for (int i = 0; i < 4; ++i) { const u32x2 w = *(const u32x2*)(p + i * 256 + lane * 4); v[i] = (f32x4){bflo(w.x), bfhi(w.x), bflo(w.y), bfhi(w.y)}; } }
__device__ __forceinline__ void st_row_bf16(u16* p, int lane, const f32x4 (&v)[4]) {
#pragma unroll
    for (int i = 0; i < 4; ++i) { u32x2 w; w.x = cvt_pk_bf16(v[i][0], v[i][1]); w.y = cvt_pk_bf16(v[i][2], v[i][3]); *(u32x2*)(p + i * 256 + lane * 4) = w; } }
__device__ __forceinline__ void st_row_fp8(unsigned char* p, int lane, const f32x4 (&v)[4]) {
#pragma unroll
    for (int i = 0; i < 4; ++i) *(unsigned*)(p + i * 256 + lane * 4) = pg8::pk4_fp8(v[i][0] * ASC, v[i][1] * ASC, v[i][2] * ASC, v[i][3] * ASC); }
template <bool BF> struct XRaw { typedef f32x4 T; };
template <> struct XRaw<true> { typedef u32x2 T; };
template <bool BF> __device__ __forceinline__ void ldx(const void* base, size_t row, int lane, typename XRaw<BF>::T (&r)[4]) {
#pragma unroll
    for (int i = 0; i < 4; ++i) { if constexpr (BF) r[i] = *(const u32x2*)((const u16*)base + row * D + i * 256 + lane * 4); else r[i] = *(const f32x4*)((const float*)base + row * D + i * 256 + lane * 4); } }
__device__ __forceinline__ f32x4 cvx(const f32x4 r) { return r; }
__device__ __forceinline__ f32x4 cvx(const u32x2 r) { return (f32x4){bflo(r.x), bfhi(r.x), bflo(r.y), bfhi(r.y)}; }
__device__ __forceinline__ void st_row_f32(float* p, int lane, const f32x4 (&v)[4]) {
#pragma unroll
    for (int i = 0; i < 4; ++i) *(f32x4*)(p + i * 256 + lane * 4) = v[i]; }
__device__ __forceinline__ void modulate_row(const f32x4 (&v)[4], const float* shift, const float* scale, int lane, f32x4 (&h)[4]) {
    float mu, rstd; row_stats(v, mu, rstd);
#pragma unroll
    for (int i = 0; i < 4; ++i) { const f32x4 sc = *(const f32x4*)(scale + i * 256 + lane * 4), sh = *(const f32x4*)(shift + i * 256 + lane * 4); h[i] = (v[i] - mu) * rstd * (sc + 1.f) + sh; } }
__device__ __forceinline__ void layernorm_row(f32x4 (&v)[4], const float* g, const float* b, int lane) {
    float mu, rstd; row_stats(v, mu, rstd);
#pragma unroll
    for (int i = 0; i < 4; ++i) { const f32x4 gg = *(const f32x4*)(g + i * 256 + lane * 4), bb = *(const f32x4*)(b + i * 256 + lane * 4); v[i] = (v[i] - mu) * rstd * gg + bb; } }

__device__ __forceinline__ void modulate_regs(const f32x4 (&v)[4], const f32x4 (&sh)[4], const f32x4 (&sc)[4], f32x4 (&h)[4]) {
    float mu, rstd; row_stats(v, mu, rstd);
#pragma unroll
    for (int i = 0; i < 4; ++i) h[i] = (v[i] - mu) * rstd * (sc[i] + 1.f) + sh[i]; }
__device__ __forceinline__ void layernorm_regs(f32x4 (&v)[4], const f32x4 (&g)[4], const f32x4 (&b)[4]) {
    float mu, rstd; row_stats(v, mu, rstd);
#pragma unroll
    for (int i = 0; i < 4; ++i) v[i] = (v[i] - mu) * rstd * g[i] + b[i]; }

__device__ __forceinline__ void phase_lnmod0(const Params& p) {
    const int tid = tid_fresh(p.wave); const int lane = tid & 63, wid = tid >> 6; u16* H = (u16*)(p.ws + OFF_RH); const float* mod = (const float*)(p.ws + OFF_MOD);
    for (int vb = blockIdx.x; vb < 256; vb += gridDim.x) { const int b = (vb * 128) / SEQ; const float* mb = mod + (size_t)b * 6144;
        f32x4 sh[4], sc[4], na[4], nb[4]; ld_row_f32(mb + 0 * 1024, lane, sh); ld_row_f32(mb + 1 * 1024, lane, sc);
        const int r0 = vb * 128 + wid; ld_row_f32(p.x + (size_t)r0 * D, lane, na); ld_row_f32(p.x + (size_t)(r0 + 8) * D, lane, nb);
        for (int i = 0; i < 16; ++i) { const int row = r0 + i * 8; f32x4 v[4], h[4];
#pragma unroll
            for (int k = 0; k < 4; ++k) { v[k] = na[k]; na[k] = nb[k]; }
            if (i + 2 < 16) ld_row_f32(p.x + (size_t)(row + 16) * D, lane, nb);
            modulate_regs(v, sh, sc, h);
            st_row_bf16(H + (size_t)row * D, lane, h); } }
}
template <bool XBF> __device__ __forceinline__ void phase_ln1_t(const Params& p, int layer, LAS unsigned char* lds) {
    const int tid = tid_fresh(p.wave); const int lane = tid & 63, wid = tid >> 6; const bool moe = (layer & 1) != 0;
    const void* xin = XBF ? (const void*)(p.ws + OFF_XR) : (const void*)p.x; u16* XR = (u16*)(p.ws + OFF_XR); const u16* mix = (const u16*)(p.ws + OFF_RZ); u16* H = (u16*)(p.ws + OFF_RH);
    const float* mod = (const float*)(p.ws + OFF_MOD) + (size_t)layer * 8 * 6144;
    LAS int* hist = (LAS int*)lds; LAS float* wrt = (LAS float*)(lds + 64);
    if (moe) { for (int i = tid; i < 8192; i += NTHR) wrt[(i & 7) * 1024 + (i >> 3)] = p.mr[i]; __syncthreads(); }
    f32x4 lg1[4], lb1[4]; ld_row_f32(p.ln1g + layer * D, lane, lg1); ld_row_f32(p.ln1b + layer * D, lane, lb1);
    for (int vb = blockIdx.x; vb < 256; vb += gridDim.x) { const int b = (vb * 128) / SEQ; const float* mb = mod + (size_t)b * 6144;
        if (moe) { if (tid < 8) hist[tid] = 0; __syncthreads(); }
        f32x4 g1[4], sh[4], sc[4]; ld_row_f32(mb + 2 * 1024, lane, g1); ld_row_f32(mb + 3 * 1024, lane, sh); ld_row_f32(mb + 4 * 1024, lane, sc);
        typename XRaw<XBF>::T nv[4], nv2[4]; u32x2 nm[4], nm2[4];
        { const int r0 = vb * 128 + wid; ldx<XBF>(xin, (size_t)r0, lane, nv); ldx<XBF>(xin, (size_t)(r0 + 8), lane, nv2);
#pragma unroll
            for (int k = 0; k < 4; ++k) { nm[k] = *(const u32x2*)(mix + (size_t)r0 * D + k * 256 + lane * 4); nm2[k] = *(const u32x2*)(mix + (size_t)(r0 + 8) * D + k * 256 + lane * 4); } }
        for (int i = 0; i < 16; ++i) { const int row = vb * 128 + i * 8 + wid;
            f32x4 v[4], h[4];
#pragma unroll
            for (int k = 0; k < 4; ++k) { const f32x4 mx = (f32x4){bflo(nm[k].x), bfhi(nm[k].x), bflo(nm[k].y), bfhi(nm[k].y)}; v[k] = cvx(nv[k]) * ALPHA + g1[k] * mx; nv[k] = nv2[k]; nm[k] = nm2[k]; }
            if (i + 2 < 16) { const int rn = row + 16; ldx<XBF>(xin, (size_t)rn, lane, nv2);
#pragma unroll
                for (int k = 0; k < 4; ++k) nm2[k] = *(const u32x2*)(mix + (size_t)rn * D + k * 256 + lane * 4); }
            layernorm_regs(v, lg1, lb1);
            st_row_bf16(XR + (size_t)row * D, lane, v);
            modulate_regs(v, sh, sc, h);
            if (!moe) { if (FFN0_FP8) st_row_fp8((unsigned char*)H + (size_t)row * D, lane, h); else st_row_bf16(H + (size_t)row * D, lane, h); }
            else {
                float lg[8];
#pragma unroll
                for (int e = 0; e < 8; ++e) { float a = 0.f;
#pragma unroll
                    for (int k = 0; k < 4; ++k) { const f32x4 w = *(const LAS f32x4*)(wrt + e * 1024 + k * 256 + lane * 4); a = fmaf(h[k][0], w[0], a); a = fmaf(h[k][1], w[1], a); a = fmaf(h[k][2], w[2], a); a = fmaf(h[k][3], w[3], a); }
                    lg[e] = wave_sum(a) + p.mbr[e]; }
                int e0 = 0; float v0 = lg[0];
#pragma unroll
                for (int e = 1; e < 8; ++e) if (lg[e] > v0) { v0 = lg[e]; e0 = e; }
                int e1 = -1; float v1 = -INFINITY;
#pragma unroll
                for (int e = 0; e < 8; ++e) if (e != e0 && (e1 < 0 || lg[e] > v1)) { v1 = lg[e]; e1 = e; }
                const float ex = __expf(v1 - v0), w0 = 1.f / (1.f + ex), w1 = ex / (1.f + ex);
                if (lane == 0) { int4 ti; ti.x = e0 | (e1 << 8); ti.y = __float_as_int(w0); ti.z = __float_as_int(w1); ti.w = 0; ((int4*)(p.ws + OFF_TOK))[row] = ti;
                    __hip_atomic_fetch_add(hist + e0, 1, __ATOMIC_RELAXED, __HIP_MEMORY_SCOPE_WORKGROUP); __hip_atomic_fetch_add(hist + e1, 1, __ATOMIC_RELAXED, __HIP_MEMORY_SCOPE_WORKGROUP); }
            }
        }
        if (moe) { __syncthreads(); if (tid < 8) ((int*)(p.ws + OFF_HIST))[vb * 8 + tid] = hist[tid]; __syncthreads(); }
    }
}
__device__ __forceinline__ void phase_ln1(const Params& p, int layer, LAS unsigned char* lds) { if (layer == 0) phase_ln1_t<false>(p, layer, lds); else phase_ln1_t<true>(p, layer, lds); }
__device__ __forceinline__ void moe_tables(const Params& p, int vb, LAS int* tab) {
    const int tid = tid_fresh(p.wave);
    const int* hist = (const int*)(p.ws + OFF_HIST);
    LAS int* cnt = tab + 300; LAS int* part = tab + 320;
    { const int e = tid & 7, j = tid >> 3; int tot = 0, pre = 0;
#pragma unroll
      for (int k = 0; k < 4; ++k) { const int b = 4 * j + k; const int h = hist[b * 8 + e]; tot += h; pre += (b < vb) ? h : 0; }
      part[j * 16 + e] = tot; part[j * 16 + 8 + e] = pre; }
    __syncthreads();
    if (tid < 16) { int s = 0;
        for (int j = 0; j < 64; ++j) s += part[j * 16 + tid];
        cnt[tid] = s; }
    __syncthreads();
    if (tid == 0) { int start = 0, t = 0;
        for (int e = 0; e < 8; ++e) { const int nt = (cnt[e] + 255) >> 8; tab[e] = start + cnt[8 + e]; int ev = e; asm volatile("" : "+v"(ev)); for (int k = 0; k < nt; ++k) tab[16 + t + k] = ev; t += nt;        start += nt * 256; }
        tab[8] = t; }
    __syncthreads();
}
__device__ __forceinline__ void phase_moe_slots(const Params& p, int layer, LAS unsigned char* lds) {
    const int tid = tid_fresh(p.wave); const int lane = tid & 63, wid = tid >> 6; LAS int* tab = (LAS int*)lds; LAS int* te = tab + 1408; LAS int* tp = tab + 1600;
    unsigned char* HG = (unsigned char*)(p.ws + OFF_HG8); const float* mod = (const float*)(p.ws + OFF_MOD) + (size_t)layer * 8 * 6144;
    for (int vb = blockIdx.x; vb < 256; vb += gridDim.x) {
        moe_tables(p, vb, tab);
        if (tid < 128) te[tid] = ((const int4*)(p.ws + OFF_TOK))[vb * 128 + tid].x;
        __syncthreads();
        if (tid < 128) { const int t = tid, e0 = te[t] & 255, e1 = te[t] >> 8; int c0 = 0, c1 = 0;
            for (int k = 0; k < t; ++k) { const int a = te[k] & 255, b = te[k] >> 8; c0 += (a == e0) + (b == e0); c1 += (a == e1) + (b == e1); }
            const int p0 = tab[e0] + c0, p1 = tab[e1] + c1; tp[2 * t] = p0; tp[2 * t + 1] = p1; ((int2*)(p.ws + OFF_SLOT))[vb * 128 + t] = make_int2(p0, p1); }
        __syncthreads();
        u32x2 nv[4], nv2[4]; f32x4 sh[4], sc[4]; { const float* mb = mod + (size_t)((vb * 128) / SEQ) * 6144; ld_row_f32(mb + 3 * 1024, lane, sh); ld_row_f32(mb + 4 * 1024, lane, sc); }
        const void* XR = (const void*)(p.ws + OFF_XR);
        ldx<true>(XR, (size_t)(vb * 128 + wid), lane, nv); ldx<true>(XR, (size_t)(vb * 128 + wid + 8), lane, nv2);
        for (int i = 0; i < 16; ++i) { const int tl = i * 8 + wid, row = vb * 128 + tl;
            f32x4 v[4], h[4];
#pragma unroll
            for (int k = 0; k < 4; ++k) { v[k] = cvx(nv[k]); nv[k] = nv2[k]; }
            if (i + 2 < 16) ldx<true>(XR, (size_t)(row + 16), lane, nv2);
            modulate_regs(v, sh, sc, h);
            st_row_fp8(HG + (size_t)tp[2 * tl] * D, lane, h); st_row_fp8(HG + (size_t)tp[2 * tl + 1] * D, lane, h); }
        __syncthreads();
    }
}
__device__ __forceinline__ void phase_ln2(const Params& p, int layer) {
    const int tid = tid_fresh(p.wave); const int lane = tid & 63, wid = tid >> 6; const bool moe = (layer & 1) != 0;
    u16* H = (u16*)(p.ws + OFF_RH); const float* mod = (const float*)(p.ws + OFF_MOD) + (size_t)layer * 8 * 6144;
    f32x4 lg2[4], lb2[4]; ld_row_f32(p.ln2g + layer * D, lane, lg2); ld_row_f32(p.ln2b + layer * D, lane, lb2);
    for (int vb = blockIdx.x; vb < 256; vb += gridDim.x) { const int b = (vb * 128) / SEQ; const float* mb = mod + (size_t)b * 6144;
        f32x4 g2[4], nsh[4], nsc[4]; ld_row_f32(mb + 5 * 1024, lane, g2);
        if (layer + 1 < DEPTH) { const float* mn = mb + (size_t)8 * 6144; ld_row_f32(mn + 0 * 1024, lane, nsh); ld_row_f32(mn + 1 * 1024, lane, nsc); }
        const int r0 = vb * 128 + wid;
        u32x2 nv[4], nv2[4]; u32x2 na[4], nb[4]; int4 ti = make_int4(0, 0, 0, 0), ti2 = ti; int2 sl = make_int2(0, 0), sl2 = sl; u16* XR = (u16*)(p.ws + OFF_XR);
#pragma unroll
        for (int k = 0; k < 4; ++k) { na[k] = (u32x2){0u, 0u}; nb[k] = (u32x2){0u, 0u}; }
        ldx<true>(XR, (size_t)r0, lane, nv); ldx<true>(XR, (size_t)(r0 + 8), lane, nv2);
        if (moe) { ti = ((const int4*)(p.ws + OFF_TOK))[r0]; sl = ((const int2*)(p.ws + OFF_SLOT))[r0];
#pragma unroll
            for (int k = 0; k < 4; ++k) { na[k] = *(const u32x2*)(H + (size_t)sl.x * D + k * 256 + lane * 4); nb[k] = *(const u32x2*)(H + (size_t)sl.y * D + k * 256 + lane * 4); }
            ti2 = ((const int4*)(p.ws + OFF_TOK))[r0 + 8]; sl2 = ((const int2*)(p.ws + OFF_SLOT))[r0 + 8]; }
        else {
#pragma unroll
            for (int k = 0; k < 4; ++k) na[k] = *(const u32x2*)(H + (size_t)r0 * D + k * 256 + lane * 4); }
        for (int i = 0; i < 16; ++i) { const int row = r0 + i * 8;
            f32x4 v[4], f[4]; const float w0 = __int_as_float(ti.y), w1 = __int_as_float(ti.z);
#pragma unroll
            for (int k = 0; k < 4; ++k) { v[k] = cvx(nv[k]); nv[k] = nv2[k]; const f32x4 a = (f32x4){bflo(na[k].x), bfhi(na[k].x), bflo(na[k].y), bfhi(na[k].y)};
                if (moe) { const f32x4 c = (f32x4){bflo(nb[k].x), bfhi(nb[k].x), bflo(nb[k].y), bfhi(nb[k].y)}; f[k] = a * w0 + c * w1; } else f[k] = a; }
            if (i + 2 < 16) ldx<true>(XR, (size_t)(row + 16), lane, nv2);
            if (i + 1 < 16) { const int nx = row + 8;
                if (moe) { ti = ti2; sl = sl2;
#pragma unroll
                    for (int k = 0; k < 4; ++k) { na[k] = *(const u32x2*)(H + (size_t)sl.x * D + k * 256 + lane * 4); nb[k] = *(const u32x2*)(H + (size_t)sl.y * D + k * 256 + lane * 4); }
                    if (i + 2 < 16) { ti2 = ((const int4*)(p.ws + OFF_TOK))[nx + 8]; sl2 = ((const int2*)(p.ws + OFF_SLOT))[nx + 8]; } }
                else {
#pragma unroll
                    for (int k = 0; k < 4; ++k) na[k] = *(const u32x2*)(H + (size_t)nx * D + k * 256 + lane * 4); } }
#pragma unroll
            for (int k = 0; k < 4; ++k) v[k] = v[k] * ALPHA + g2[k] * f[k];
            layernorm_regs(v, lg2, lb2);
            if (layer + 1 < DEPTH) st_row_bf16(XR + (size_t)row * D, lane, v); else st_row_f32(p.out + (size_t)row * D, lane, v);
            if (layer + 1 < DEPTH) { f32x4 h[4]; modulate_regs(v, nsh, nsc, h); st_row_bf16(H + (size_t)row * D, lane, h); }
        }
    }
}
template <bool DRY = false> __device__ __forceinline__ void phase_prep(const Params& p, int layer, LAS unsigned char* lds) {
    const int tid = tid_fresh(p.wave), lane = tid & 63, wid = tid >> 6;
    LAS u16* z = (LAS u16*)(lds + 65536 + wid * 6400); LAS u16* qr = z + 2560;
    u16* Z = (u16*)(p.ws + OFF_RZ); u16* QR = (u16*)(p.ws + OFF_QROT);
    const float* CH = (const float*)(p.ws + OFF_COSH); const float* SH = (const float*)(p.ws + OFF_SINH); const float* CI = (const float*)(p.ws + OFF_COSI); const float* SI = (const float*)(p.ws + OFF_SINI);
    const int d = lane & 31, half = lane >> 5, e16 = lane & 15, hh = lane >> 4;
    const int stride = gridDim.x * 8; int row = blockIdx.x * 8 + wid;
    bool ldc[5], stc[5];
#pragma unroll
    for (int i = 0; i < 5; ++i) { const int ci = lane + 64 * i; ldc[i] = !((ci >= 48 && ci < 80) || (ci >= 96 && ci < 112) || (ci >= 128 && ci < 144) || ci >= 312); stc[i] = ldc[i] && ci >= 48 && ci < 296; }
    u32x4 pf[5]; float nch = 0.f, nsh = 0.f, nci = 0.f, nsi = 0.f;
    if (row < M) {
#pragma unroll
        for (int i = 0; i < 5; ++i) if (ldc[i]) pf[i] = *(const u32x4*)(Z + (size_t)row * ZP + (lane + 64 * i) * 8);
        nch = CH[(size_t)row * 32 + d]; nsh = SH[(size_t)row * 32 + d]; nci = CI[(size_t)row * 16 + e16]; nsi = SI[(size_t)row * 16 + e16]; }
    float sgg[4], sgb[4];
#pragma unroll
    for (int g = 0; g < 4; ++g) { sgg[g] = p.sgu_g[layer * 256 + g * 64 + lane]; sgb[g] = p.sgu_bn[layer * 256 + g * 64 + lane]; }
    for (; row < M; row += stride) {
#pragma unroll
        for (int i = 0; i < 5; ++i) *(LAS u32x4*)(z + (lane + 64 * i) * 8) = pf[i];
        const float ch = nch, sh = nsh, ci = nci, si = nsi;
        { const int nx = row + stride; if (nx < M) {
#pragma unroll
            for (int i = 0; i < 5; ++i) if (ldc[i]) pf[i] = *(const u32x4*)(Z + (size_t)nx * ZP + (lane + 64 * i) * 8);
            nch = CH[(size_t)nx * 32 + d]; nsh = SH[(size_t)nx * 32 + d]; nci = CI[(size_t)nx * 16 + e16]; nsi = SI[(size_t)nx * 16 + e16]; } }
        asm volatile("s_waitcnt lgkmcnt(0)" ::: "memory");
        float q1[3], q2[3], s1[2], s2[2], e1[3], e2[3], su[4], sv[4];
#pragma unroll
        for (int k = 0; k < 3; ++k) { const int h = half + 2 * k; q1[k] = bf2f(z[ZQ + h * 64 + d]); q2[k] = bf2f(z[ZQ + h * 64 + 32 + d]); e1[k] = bf2f(z[ZDQ + h * 64 + d]); e2[k] = bf2f(z[ZDQ + h * 64 + 32 + d]); }
#pragma unroll
        for (int k = 0; k < 2; ++k) { const LAS u16* q = z + ZKV + (2 + 2 * k) * 128 + half * 64; s1[k] = bf2f(q[d]); s2[k] = bf2f(q[32 + d]); }
        const float i1 = bf2f(z[ZIQ + hh * 32 + e16]), i2 = bf2f(z[ZIQ + hh * 32 + 16 + e16]), y1 = bf2f(z[ZIK + e16]), y2 = bf2f(z[ZIK + 16 + e16]);
        const float iwv = bf2f(z[ZIW + (lane & 3)]), gtv = bf2f(z[ZG + (lane < 18 ? lane : 17)]);
        const float c0 = bf2f(z[ZCKV + lane]), c1 = bf2f(z[ZCKV + 64 + lane]), kraw = bf2f(z[2368 + lane]), vraw = bf2f(z[2432 + lane]);
#pragma unroll
        for (int g = 0; g < 4; ++g) { su[g] = bf2f(z[ZSG + g * 64 + lane]); sv[g] = bf2f(z[ZSG + 256 + g * 64 + lane]); }
        asm volatile("s_waitcnt lgkmcnt(0)" ::: "memory");
#pragma unroll
        for (int k = 0; k < 3; ++k) { const int h = half + 2 * k;
            qr[h * 64 + d] = f2bf((q1[k] * ch - q2[k] * sh) * C2); qr[h * 64 + 32 + d] = f2bf((q2[k] * ch + q1[k] * sh) * C2);
            z[ZDQ + h * 64 + d] = f2bf((e1[k] * ch - e2[k] * sh) * C2); z[ZDQ + h * 64 + 32 + d] = f2bf((e2[k] * ch + e1[k] * sh) * C2); }
#pragma unroll
        for (int k = 0; k < 2; ++k) { LAS u16* q = z + ZKV + (2 + 2 * k) * 128 + half * 64; q[d] = f2bf(s1[k] * ch - s2[k] * sh); q[32 + d] = f2bf(s2[k] * ch + s1[k] * sh); }
        z[ZIQ + hh * 32 + e16] = f2bf(i1 * ci - i2 * si); z[ZIQ + hh * 32 + 16 + e16] = f2bf(i2 * ci + i1 * si);
        if (lane < 16) { z[ZIK + e16] = f2bf(y1 * ci - y2 * si); z[ZIK + 16 + e16] = f2bf(y2 * ci + y1 * si); }
        if (lane < 4) z[ZIW + lane] = f2bf(iwv * 0.5f);
        if (lane < 18) z[ZG + lane] = f2bf(1.f / (1.f + __expf(-gtv)));
        { const float ss = wave_sum(c0 * c0 + c1 * c1); const float r = rsqrtf(ss * (1.f / 128.f) + 1e-6f);
          const float ak = kraw * r, av = vraw * r;
          const float ko = SHFL_XOR(ak, 32); const float kr = half == 0 ? ak * ch - ko * sh : ak * ch + ko * sh;
          z[ZCKV + lane] = f2bf(kr); z[ZCKV + 64 + lane] = f2bf(av); }
        { float xg[4], mu[4], dx[4], var[4];
#pragma unroll
          for (int g = 0; g < 4; ++g) xg[g] = gelu_tanh(sv[g]);
#pragma unroll
          for (int g = 0; g < 4; ++g) mu[g] = wave_sum(xg[g]) * (1.f / 64.f);
#pragma unroll
          for (int g = 0; g < 4; ++g) { dx[g] = xg[g] - mu[g]; var[g] = wave_sum(dx[g] * dx[g]) * (1.f / 64.f); }
#pragma unroll
          for (int g = 0; g < 4; ++g) { z[ZSG + g * 64 + lane] = f2bf(gelu_tanh(su[g])); z[ZSG + 256 + g * 64 + lane] = f2bf(dx[g] * rsqrtf(var[g] + 1e-5f) * sgg[g] + sgb[g]); } }
        asm volatile("s_waitcnt lgkmcnt(0)" ::: "memory");
        { u32x4 w_[6];
#pragma unroll
          for (int i = 0; i < 5; ++i) w_[i] = *(const LAS u32x4*)(z + (lane + 64 * i) * 8);
          w_[5] = *(const LAS u32x4*)(qr + (lane < 48 ? lane : 47) * 8);
          asm volatile("s_waitcnt lgkmcnt(0)" ::: "memory");
#pragma unroll
          for (int i = 0; i < 5; ++i) { if (!DRY && stc[i]) *(u32x4*)(Z + (size_t)row * ZP + (lane + 64 * i) * 8) = w_[i]; else asm volatile("" :: "v"(w_[i])); }
          if (!DRY && lane < 48) *(u32x4*)(QR + (size_t)row * 384 + lane * 8) = w_[5]; else asm volatile("" :: "v"(w_[5])); }
        asm volatile("s_waitcnt lgkmcnt(0)" ::: "memory");
    }
    __syncthreads();
}

__device__ __forceinline__ void phase_compress(const Params& p, int layer, LAS unsigned char* lds) {
    const int tid = tid_fresh(p.wave), lane = tid & 63, wid = tid >> 6, fr = lane & 15, fq = lane >> 4;
    LAS float* part = (LAS float*)lds; LAS float* hid = (LAS float*)(lds + 32768);
    const u16* Z = (const u16*)(p.ws + OFF_RZ);
    for (int task = blockIdx.x; task < 8 * 2 * 2 * 16; task += gridDim.x) {
        const int nt = task & 15, j = (task >> 4) & 1, g = (task >> 5) & 1, b = task >> 6;
        const u16* W1 = (const u16*)(p.ws + OFF_CW1T) + (size_t)(layer * 2 + j) * 64 * 2048;
        const int n = nt * 16 + fr; const bool nvalid = n < 255;
        const u16* arow = Z + ((size_t)b * SEQ + (nvalid ? 16 * n : 0)) * ZP + ZKV + j * 128 + g * 64 + fq * 8;
        f32x4 acc[4];
#pragma unroll
        for (int c = 0; c < 4; ++c) acc[c] = (f32x4){0.f, 0.f, 0.f, 0.f};
        bf16x8 av[8], bv[8][4];
#pragma unroll
        for (int i = 0; i < 8; ++i) { const int st = wid * 8 + i, l = st >> 1, dd = (st & 1) * 32; av[i] = *(const bf16x8*)(arow + (size_t)l * ZP + dd);
#pragma unroll
            for (int c = 0; c < 4; ++c) bv[i][c] = *(const bf16x8*)(W1 + (size_t)(c * 16 + fr) * 2048 + st * 32 + fq * 8); }
#pragma unroll
        for (int i = 0; i < 8; ++i) { bf16x8 a = av[i]; if (!nvalid) a = (bf16x8){0, 0, 0, 0, 0, 0, 0, 0};
#pragma unroll
            for (int c = 0; c < 4; ++c) acc[c] = __builtin_amdgcn_mfma_f32_16x16x32_bf16(a, bv[i][c], acc[c], 0, 0, 0); }
#pragma unroll
        for (int c = 0; c < 4; ++c)
#pragma unroll
            for (int r = 0; r < 4; ++r) part[(wid * 16 + 4 * fq + r) * 64 + c * 16 + fr] = acc[c][r];
        __syncthreads();
        const float* cb = (const float*)(p.ws + OFF_CB1) + (layer * 2 + j) * 64;
#pragma unroll
        for (int k = 0; k < 2; ++k) { const int o = tid + k * NTHR, rw = o >> 6, e = o & 63; float sacc = 0.f;
#pragma unroll
            for (int w = 0; w < 8; ++w) sacc += part[(w * 16 + rw) * 64 + e];
            hid[rw * 65 + e] = gelu_tanh(sacc + cb[e]); }
        __syncthreads();
        { const float* w2 = p.cmp_w2 + (size_t)(layer * 2 + j) * 4096; const int rw = tid >> 5, f0 = 2 * (tid & 31); float o0 = 0.f, o1 = 0.f;
#pragma unroll 16
          for (int e = 0; e < 64; ++e) { const float hv = hid[rw * 65 + e]; const f32x2 w = *(const f32x2*)(w2 + e * 64 + f0); o0 = fmaf(hv, w.x, o0); o1 = fmaf(hv, w.y, o1); }
          const int nn = nt * 16 + rw; if (nn >= 255) { o0 = 0.f; o1 = 0.f; }
          if (j == 0) { u16* kc = (u16*)(p.ws + OFF_KC) + ((size_t)(b * 2 + g) * 256 + nn) * 64 + f0; *(unsigned*)kc = cvt_pk_bf16(o0, o1); }
          else { u16* vc = (u16*)(p.ws + OFF_VCT) + ((size_t)(b * 2 + g) * 64 + f0) * 256 + nn; vc[0] = f2bf(o0); vc[256] = f2bf(o1); } }
        __syncthreads();
    }
    __syncthreads();
}
__device__ __forceinline__ f32x16 mfma32(bf16x8 a, bf16x8 b, f32x16 c) { return __builtin_amdgcn_mfma_f32_32x32x16_bf16(a, b, c, 0, 0, 0); }
__device__ __forceinline__ bf16x8 pack8(const f32x16& p, int s) {
    u32x4 w; w.x = cvt_pk_bf16(p[8 * s + 0], p[8 * s + 1]); w.y = cvt_pk_bf16(p[8 * s + 2], p[8 * s + 3]); w.z = cvt_pk_bf16(p[8 * s + 4], p[8 * s + 5]); w.w = cvt_pk_bf16(p[8 * s + 6], p[8 * s + 7]);
    return __builtin_bit_cast(bf16x8, w); }
__device__ __forceinline__ void stage_o(LAS u16* stg, const f32x16 (&o)[2], float inv, int r32, int hi) {
#pragma unroll
    for (int db = 0; db < 2; ++db)
#pragma unroll
        for (int r = 0; r < 16; ++r) stg[r32 * 72 + db * 32 + crow(r, hi)] = f2bf(o[db][r] * inv);
    asm volatile("s_waitcnt lgkmcnt(0)" ::: "memory");
}

__device__ __forceinline__ void phase_cmpattn(const Params& p, int layer, LAS unsigned char* lds) {
    const int tid = tid_fresh(p.wave), lane = tid & 63, wid = tid >> 6, r32 = lane & 31, hi = lane >> 5;
    LAS u16* Kl = (LAS u16*)lds;
    LAS u16* Vl = (LAS u16*)(lds + 36864);
    LAS u16* stg = (LAS u16*)(lds + 36864 + 33792 + wid * 4608);
    const u16* Z = (const u16*)(p.ws + OFF_RZ); u16* OC = (u16*)(p.ws + OFF_OC);
    for (int c = blockIdx.x; c < 256; c += gridDim.x) { const int bg = c >> 4, b = bg >> 1, g = bg & 1; const int rr_ = p.wave < 4 ? p.wave : 11 - p.wave; const int qt = 16 * rr_ + (c & 15);
        { const u16* Kg = (const u16*)(p.ws + OFF_KC) + (size_t)bg * 256 * 64;
          __syncthreads();
#pragma unroll
          for (int i = 0; i < 4; ++i) { const int cc = tid + i * NTHR; const int rw = cc >> 3, ch = cc & 7; *(LAS u32x4*)(Kl + rw * 72 + ch * 8) = *(const u32x4*)(Kg + rw * 64 + ch * 8); }
          { const u16* Vg = (const u16*)(p.ws + OFF_VCT) + (size_t)bg * 64 * 256;
#pragma unroll
            for (int i = 0; i < 4; ++i) { const int cc = tid + i * NTHR; const int rw = cc >> 5, ch = cc & 31; *(LAS u32x4*)(Vl + rw * 264 + ch * 8) = *(const u32x4*)(Vg + rw * 256 + ch * 8); } }
          __syncthreads(); }
        const int t0 = qt * 32, t = t0 + r32; const size_t row = (size_t)b * SEQ + t;
        const int nmax = (t - 31) >> 4;
        const int kbl = qt >> 4, kfull = (2 * qt - 33) >> 5;
        float imps[32];
#pragma unroll
        for (int i = 0; i < 32; ++i) imps[i] = 0.f;
        for (int r = 0; r < 3; ++r) { const int h = 3 * g + r;
            { LAS bf16x8* qs = (LAS bf16x8*)stg;
#pragma unroll
              for (int d0 = 0; d0 < 4; ++d0) qs[d0 * 64 + lane] = *(const bf16x8*)(Z + row * ZP + ZQ + h * 64 + d0 * 16 + hi * 8); }
            float m = 0.f, l = 0.f, carry = 0.f; bool seen = false; f32x16 o[2]; o[0] = (f32x16){}; o[1] = (f32x16){}; float imp[32];
#pragma unroll
            for (int i = 0; i < 32; ++i) imp[i] = 0.f;
#pragma unroll
            for (int kb = 0; kb < 8; ++kb) { if (kb <= kbl) { f32x16 s = {};
#pragma unroll
                for (int d0 = 0; d0 < 4; ++d0) s = mfma32(*(const LAS bf16x8*)(Kl + (32 * kb + r32) * 72 + d0 * 16 + hi * 8), ((const LAS bf16x8*)stg)[d0 * 64 + lane], s);
                if (kb > kfull) {
#pragma unroll
                    for (int rr = 0; rr < 16; ++rr) { const int n = 32 * kb + crow(rr, hi); s[rr] = (n <= nmax) ? fmaf(s[rr], C2, -m) : -INFINITY; } }
                else {
#pragma unroll
                    for (int rr = 0; rr < 16; ++rr) s[rr] = fmaf(s[rr], C2, -m); }
                float mk = fmaxf(fmaxf(s[0], s[1]), s[2]);
#pragma unroll
                for (int rr = 3; rr < 15; rr += 2) mk = fmaxf(fmaxf(mk, s[rr]), s[rr + 1]);
                mk = fmaxf(mk, s[15]); mk = fmaxf(mk, SHFL_XOR(mk, 32));
                const bool mv = (mk > 8.f) | (!seen & (mk > -INFINITY));
                if (__any(mv)) { const float dl = mv ? mk : 0.f; m += dl; const float f = __builtin_amdgcn_exp2f(-dl); l *= f; carry *= f;
#pragma unroll
                    for (int rr = 0; rr < 16; ++rr) { s[rr] -= dl; o[0][rr] *= f; o[1][rr] *= f; }
#pragma unroll
                    for (int i = 0; i < 32; ++i) imp[i] *= f; }
                seen = seen | (mk > -INFINITY);
#pragma unroll
                for (int rr = 0; rr < 16; ++rr) s[rr] = __builtin_amdgcn_exp2f(s[rr]);
#pragma unroll
                for (int gq = 0; gq < 4; ++gq) { const float sum4 = (s[4 * gq] + s[4 * gq + 1]) + (s[4 * gq + 2] + s[4 * gq + 3]); const float ol = SHFL_XOR(s[4 * gq + 3], 32);
                    const float extra = hi ? ol : carry; carry = ol; l += sum4;
                    imp[4 * kb + gq] += sum4 + extra; }
#pragma unroll
                for (int ks = 0; ks < 2; ++ks) { const bf16x8 pb = pack8(s, ks);
#pragma unroll
                    for (int db = 0; db < 2; ++db) { const LAS u16* vp = Vl + (32 * db + r32) * 264 + 32 * kb + 16 * ks + 4 * hi; const s16x4 lo = *(const LAS s16x4*)vp, hh = *(const LAS s16x4*)(vp + 8);
                        const bf16x8 a = (bf16x8){lo[0], lo[1], lo[2], lo[3], hh[0], hh[1], hh[2], hh[3]};
                        o[db] = mfma32(a, pb, o[db]); } }
                } }
            l += SHFL_XOR(l, 32); const float inv = l > 0.f ? 1.f / l : 0.f;
#pragma unroll
            for (int i = 0; i < 32; ++i) imps[i] = fmaf(imp[i], inv, imps[i]);
            asm volatile("s_nop 15\n\ts_nop 7" : "+v"(o[0]), "+v"(o[1]));
            stage_o(stg, o, inv, r32, hi);
#pragma unroll
            for (int i = 0; i < 4; ++i) { const int rw = i * 8 + (lane >> 3), ch = lane & 7; const u32x4 v = *(const LAS u32x4*)(stg + rw * 72 + ch * 8);
                *(u32x4*)(OC + ((size_t)b * SEQ + t0 + rw) * 384 + h * 64 + ch * 8) = v; }
            asm volatile("s_waitcnt lgkmcnt(0)" ::: "memory");
        }
        { asm volatile("s_waitcnt lgkmcnt(0)" ::: "memory");
          const int cur = t >> 6; float k[32]; LAS float* tr = (LAS float*)stg;
#pragma unroll
          for (int hf = 0; hf < 2; ++hf) {
#pragma unroll
              for (int i = 0; i < 16; ++i) tr[r32 * 33 + 8 * (i >> 2) + 2 * (i & 3) + hi] = imps[16 * hf + i];
              asm volatile("s_waitcnt lgkmcnt(0)" ::: "memory");
#pragma unroll
              for (int i = 0; i < 32; ++i) { const float v = tr[r32 * 33 + i]; if (hf == 0) k[i] = v; else k[i] = hi ? v : k[i]; }
              asm volatile("s_waitcnt lgkmcnt(0)" ::: "memory"); }
#pragma unroll
          for (int i = 0; i < 32; ++i) { const int j = 32 * hi + i; const bool valid = j <= cur; const bool forced = (j == 0) | (j == cur) | (j == cur - 1);
              k[i] = valid ? k[i] + (forced ? 1e4f : 0.f) : -INFINITY; }
          unsigned long long msk = 0ull;
#pragma unroll 1
          for (int rd = 0; rd < 16; ++rd) { float best = k[0]; int bi = 0;
#pragma unroll
              for (int i = 1; i < 32; ++i) { const bool gt = k[i] > best; best = gt ? k[i] : best; bi = gt ? i : bi; }
              const float ob = SHFL_XOR(best, 32); const int obi = SHFL_XOR(bi, 32);
              const float v0 = hi ? ob : best, v1 = hi ? best : ob; const int i0 = hi ? obi : bi, i1 = hi ? bi : obi;
              const bool w0 = v0 >= v1; const float wv = w0 ? v0 : v1; const int wj = w0 ? i0 : 32 + i1;
              if (wv > -INFINITY) msk |= 1ull << wj;
              const bool mine = (w0 ? 0 : 1) == hi;
#pragma unroll
              for (int i = 0; i < 32; ++i) k[i] = (mine && i == bi) ? -INFINITY : k[i]; }
          if (hi == 0) ((unsigned long long*)(p.ws + OFF_BLK))[((size_t)b * SEQ + t) * 2 + g] = msk; }
        asm volatile("s_waitcnt lgkmcnt(0)" ::: "memory");
    }
    __syncthreads();
}
constexpr int AT_K = 0, AT_V = 24576, AT_M = 49152, AT_O = 55296, AT_Q = AT_O + 8 * 4608, AT_BYTES = AT_Q + 8 * 4096;
__device__ __forceinline__ float max3f(float a, float b, float c) { float r; asm("v_max3_f32 %0, %1, %2, %3" : "=v"(r) : "v"(a), "v"(b), "v"(c)); return r; }
__device__ __forceinline__ s16x4 vtr(const LAS unsigned char* q) { return __builtin_bit_cast(s16x4, __builtin_amdgcn_ds_read_tr16_b64_v4i16((LAS s16x4*)q)); }
typedef __bf16 bf16x2_t __attribute__((ext_vector_type(2)));
__device__ __forceinline__ unsigned cvtpk_c(float lo, float hi) { const f32x2 v = {lo, hi}; return __builtin_bit_cast(unsigned, __builtin_convertvector(v, bf16x2_t)); }
__device__ __forceinline__ float xor32_max(float v) { auto rr = __builtin_amdgcn_permlane32_swap(__float_as_uint(v), __float_as_uint(v), false, false); return fmaxf(__uint_as_float(rr[0]), __uint_as_float(rr[1])); }
__device__ __forceinline__ void glds16(const void* gsrc, unsigned lds_dst) { unsigned keep;
    asm volatile("s_mov_b32 %0, m0\n\ts_mov_b32 m0, %2\n\ts_nop 0\n\tglobal_load_lds_dwordx4 %1, off\n\ts_mov_b32 m0, %0" : "=&s"(keep) : "v"(gsrc), "s"(lds_dst) : "memory"); }
__device__ __forceinline__ void glds4(const void* gsrc, unsigned lds_dst) { unsigned keep;
    asm volatile("s_mov_b32 %0, m0\n\ts_mov_b32 m0, %2\n\ts_nop 0\n\tglobal_load_lds_dword %1, off\n\ts_mov_b32 m0, %0" : "=&s"(keep) : "v"(gsrc), "s"(lds_dst) : "memory"); }
struct AttnArgs { const u16* Q; int qp, qc; const u16* K; int kp, kc; const u16* V; int vp, vc; u16* O; int op, oc; };
#define SBAR() __builtin_amdgcn_sched_barrier(0)
template <int MODE> __device__ __forceinline__ void attn_unit(const Params& p, const AttnArgs& A, int b, int h, int g, int qb, LAS unsigned char* lds) {
    const int tid = tid_fresh(p.wave), lane = tid & 63, wid = tid >> 6, r32 = lane & 31, hi = lane >> 5; const int wu = p.wave;
    const int q0 = qb * 256, t = q0 + wid * 32 + r32; const size_t row = (size_t)b * SEQ + t;
    const int H1 = 4 * qb + 3, H0 = (MODE == 3) ? (4 * qb - 8 > 0 ? 4 * qb - 8 : 0) : 0;
    const u16* kg = A.K + ((size_t)b * SEQ + lane) * A.kp + A.kc + wu * 8; const u16* vg = A.V + ((size_t)b * SEQ + 16 * (wu & 3) + (lane >> 2)) * A.vp + A.vc + (wu >> 2) * 32 + (lane & 3) * 8;
    const unsigned* mg = (const unsigned*)(p.ws + OFF_MASKW) + ((size_t)b * SEQ + q0 + wu * 32 + (lane >> 1)) * 128 + (lane & 1);
    const unsigned ldsb = (unsigned)(uintptr_t)lds;
#define AT_CL(x) (((x) <= H1) ? (x) : H1)
#define AT_DMA_K(hh, so) glds16(kg + (size_t)AT_CL(hh) * 64 * A.kp, (unsigned)__builtin_amdgcn_readfirstlane(ldsb + AT_K + (so) + wu * 1024))
#define AT_DMA_V(hh, so) glds16(vg + (size_t)AT_CL(hh) * 64 * A.vp, (unsigned)__builtin_amdgcn_readfirstlane(ldsb + AT_V + (so) + wu * 1024))
#define AT_DMA_M(hh, so) do { if (MODE == 2) glds4(mg + 2 * AT_CL(hh), (unsigned)__builtin_amdgcn_readfirstlane(ldsb + AT_M + ((so) >> 2) + wu * 256)); } while (0)
#define AT_WAIT_BAR(N) asm volatile("s_waitcnt vmcnt(" #N ") lgkmcnt(0)\n\ts_barrier" ::: "memory")
#define AT_WAIT_STEP() do { if (MODE == 2) AT_WAIT_BAR(3); else AT_WAIT_BAR(2); } while (0)
    AT_DMA_K(H0, 0); AT_DMA_V(H0, 0); AT_DMA_K(H0 + 1, 8192); AT_DMA_M(H0, 0); AT_DMA_M(H0 + 1, 8192);
    bf16x8 qr[4];
#pragma unroll
    for (int d0 = 0; d0 < 4; ++d0) qr[d0] = *(const bf16x8*)(A.Q + row * A.qp + A.qc + h * 64 + d0 * 16 + hi * 8);
    LAS u16* Qs = (LAS u16*)(lds + AT_Q) + (wid * 256 + lane) * 8;
    if (MODE == 2) {
#pragma unroll
        for (int d0 = 0; d0 < 4; ++d0) *(LAS bf16x8*)(Qs + d0 * 512) = qr[d0]; }
#define AT_QR(j) ((MODE == 2) ? *(const LAS bf16x8*)(Qs + (j) * 512) : qr[j])
    unsigned long long bmask = 0ull; if (MODE == 1) bmask = ((const unsigned long long*)(p.ws + OFF_BLK))[row * 2 + g];
    AT_DMA_K(H0 + 2, 16384);
    const LAS unsigned char* kp0 = lds + AT_K + hi * 1024 + r32 * 16; const LAS unsigned char* vp0 = lds + AT_V + ((lane >> 4) & 1) * 32 + (lane & 3) * 8 + (4 * hi + ((lane & 15) >> 2)) * 64;
    const LAS unsigned char* mp0 = lds + AT_M + wid * 256 + r32 * 8;
    float m = 0.f, l = 0.f; f32x16 o[2], negm; { float z = 0.f; asm volatile("" : "+v"(z));
#pragma unroll
      for (int r = 0; r < 16; ++r) { o[0][r] = z; o[1][r] = z; negm[r] = z; } }
    asm volatile("" : "+v"(negm));
    f32x16 pA0, pA1, pB0, pB1; bf16x8 kf[8]; bool seen = false; bool resc = false; float fsc = 1.f;
    int sl_prev = 0, sl_cur = 0, sl_next = 8192;
#define AT_ROT() do { sl_prev = sl_cur; sl_cur = sl_next; sl_next = (sl_next == 16384) ? 0 : sl_next + 8192; } while (0)
#define AT_KV(sb_, r_) (64 * tt_ + 32 * (sb_) + 4 * hi + ((r_) & 3) + 8 * ((r_) >> 2))
#define AT_CMASK(C0, C1, tt, DG, LW) do { const int tt_ = (tt); \
        if (DG) { _Pragma("unroll") for (int r = 0; r < 16; ++r) { C0[r] = (AT_KV(0, r) > t) ? -INFINITY : C0[r]; C1[r] = (AT_KV(1, r) > t) ? -INFINITY : C1[r]; } } \
        if (LW) { _Pragma("unroll") for (int r = 0; r < 16; ++r) { C0[r] = (AT_KV(0, r) <= t - 512) ? -INFINITY : C0[r]; C1[r] = (AT_KV(1, r) <= t - 512) ? -INFINITY : C1[r]; } } } while (0)
#define AT_EXM(X, B, WW) do { _Pragma("unroll") for (int j_ = 0; j_ < 4; ++j_) { const float e_ = __builtin_amdgcn_exp2f(X[(B) + j_]); \
            X[(B) + j_] = (MODE == 2) ? __int_as_float(__float_as_int(e_) & __builtin_amdgcn_sbfe((int)(WW), (((B) + j_) & 3) + 8 * (((B) + j_) >> 2) + 4 * hi, 1)) : e_; } } while (0)
    AT_WAIT_BAR(0);
    { const LAS unsigned char* kb_ = kp0;
#pragma unroll
      for (int d0 = 0; d0 < 4; ++d0) { const bf16x8 b0 = *(const LAS bf16x8*)(kb_ + d0 * 2048), b1 = *(const LAS bf16x8*)(kb_ + d0 * 2048 + 512);
          if (d0 == 0) { pA0 = mfma32(b0, qr[0], negm); pA1 = mfma32(b1, qr[0], negm); } else { pA0 = mfma32(b0, qr[d0], pA0); pA1 = mfma32(b1, qr[d0], pA1); } }
      asm volatile("s_nop 15\n\ts_nop 7" : "+v"(pA0), "+v"(pA1));
      AT_CMASK(pA0, pA1, H0, true, (MODE == 3));
      float a = max3f(pA0[0], pA0[1], pA1[0]), bb = max3f(pA0[2], pA0[3], pA1[1]); a = max3f(a, pA1[2], pA1[3]);
#pragma unroll
      for (int r = 4; r < 16; r += 4) { a = max3f(a, pA0[r], pA0[r + 1]); bb = max3f(bb, pA0[r + 2], pA0[r + 3]); a = max3f(a, pA1[r], pA1[r + 1]); bb = max3f(bb, pA1[r + 2], pA1[r + 3]); }
      const float rm = xor32_max(fmaxf(a, bb)); seen = rm > -INFINITY; const float dl = seen ? rm : 0.f; m = dl;
#pragma unroll
      for (int r = 0; r < 16; ++r) { pA0[r] -= dl; pA1[r] -= dl; negm[r] = -m; }
      asm volatile("" : "+v"(negm));
      u32x2 mwv = (u32x2){0u, 0u}; if (MODE == 2) mwv = *(const LAS u32x2*)(mp0);
      AT_EXM(pA0, 0, mwv.x); AT_EXM(pA0, 4, mwv.x); AT_EXM(pA0, 8, mwv.x); AT_EXM(pA0, 12, mwv.x); AT_EXM(pA1, 0, mwv.y); AT_EXM(pA1, 4, mwv.y); AT_EXM(pA1, 8, mwv.y); AT_EXM(pA1, 12, mwv.y); }
    AT_WAIT_BAR(0);
    AT_DMA_K(H0 + 3, 0); AT_DMA_V(H0 + 1, 8192); AT_DMA_M(H0 + 2, 16384);
    AT_ROT();
#pragma unroll
    for (int j = 0; j < 4; ++j) { kf[2 * j] = *(const LAS bf16x8*)(kp0 + sl_cur + j * 2048); kf[2 * j + 1] = *(const LAS bf16x8*)(kp0 + sl_cur + j * 2048 + 512); }
    AT_WAIT_STEP();
    s16x4 vlo[8], vhi[8]; u32x4 pw0, pw1, pw2, pw3;
#define PKW(P, B) (cvtpk_c(P[B], P[(B) + 1]) & km)
#define PAF(k) __builtin_bit_cast(bf16x8, pw##k)
#define VFR(i) (bf16x8){vlo[i][0], vlo[i][1], vlo[i][2], vlo[i][3], vhi[i][0], vhi[i][1], vhi[i][2], vhi[i][3]}
#define PIN(x) asm volatile("" : "+v"(x))
#define GAPA(MF, A0, A1, A2, A3, W0, W1, PW) do { MF; sacc += A0; sacc += A1; sacc += A2; sacc += A3; PIN(sacc); W0; W1; PIN(PW); SBAR(); } while (0)
#define GAPB(MF, X, B, WW) do { MF; AT_EXM(X, B, WW); PIN(X); SBAR(); } while (0)
#define VRD(i) do { vlo[i] = vtr(vp_ + (((i) >> 2) * 4096 + ((i) & 3) * 1024)); vhi[i] = vtr(vp_ + (((i) >> 2) * 4096 + ((i) & 3) * 1024 + 512)); } while (0)
#define KRD(j) do { kf[2 * (j)] = *(const LAS bf16x8*)(kp0 + sl_next + (j) * 2048); kf[2 * (j) + 1] = *(const LAS bf16x8*)(kp0 + sl_next + (j) * 2048 + 512); SBAR(); } while (0)
#define AT_STEP(C0, C1, P0, P1, DG, LW) do { SBAR(); \
    const LAS unsigned char* vp_ = vp0 + sl_prev; \
    const bool sel = (MODE != 1) || (((bmask >> (tq - 1)) & 1ull) != 0ull); const unsigned km = sel ? 0xffffffffu : 0u;     \
    VRD(0); SBAR(); float sacc = (P0[0] + P0[1]); \
    GAPA(C0 = mfma32(kf[0], AT_QR(0), negm), P0[2], P0[3], P0[4], P0[5],     pw0[0] = PKW(P0, 0), pw0[1] = PKW(P0, 2), pw0); \
    VRD(4); SBAR(); GAPA(C1 = mfma32(kf[1], AT_QR(0), negm), P0[6], P0[7], P0[8], P0[9],     pw0[2] = PKW(P0, 4), pw0[3] = PKW(P0, 6), pw0); \
    VRD(1); SBAR(); GAPA(C0 = mfma32(kf[2], AT_QR(1), C0),   P0[10], P0[11], P0[12], P0[13], pw1[0] = PKW(P0, 8), pw1[1] = PKW(P0, 10), pw1); \
    VRD(5); SBAR(); GAPA(C1 = mfma32(kf[3], AT_QR(1), C1),   P0[14], P0[15], P1[0], P1[1],   pw1[2] = PKW(P0, 12), pw1[3] = PKW(P0, 14), pw1); \
    VRD(2); SBAR(); GAPA(C0 = mfma32(kf[4], AT_QR(2), C0),   P1[2], P1[3], P1[4], P1[5],     pw2[0] = PKW(P1, 0), pw2[1] = PKW(P1, 2), pw2); \
    VRD(6); SBAR(); GAPA(C1 = mfma32(kf[5], AT_QR(2), C1),   P1[6], P1[7], P1[8], P1[9],     pw2[2] = PKW(P1, 4), pw2[3] = PKW(P1, 6), pw2); \
    VRD(3); SBAR(); GAPA(C0 = mfma32(kf[6], AT_QR(3), C0),   P1[10], P1[11], P1[12], P1[13], pw3[0] = PKW(P1, 8), pw3[1] = PKW(P1, 10), pw3); \
    VRD(7); SBAR(); GAPA(C1 = mfma32(kf[7], AT_QR(3), C1),   P1[14], P1[15], 0.f, 0.f,       pw3[2] = PKW(P1, 12), pw3[3] = PKW(P1, 14), pw3); \
    l += sel ? sacc : 0.f; \
    AT_DMA_K(tq + 3, sl_cur); AT_DMA_V(tq + 1, sl_next); AT_DMA_M(tq + 2, sl_prev); \
    AT_CMASK(C0, C1, tq, DG, LW); \
    u32x2 mwv = (u32x2){0u, 0u}; if (MODE == 2) mwv = *(const LAS u32x2*)(mp0 + (sl_cur >> 2)); \
    { float a = fmaxf(fmaxf(C0[0], C0[1]), C1[0]), bb = fmaxf(fmaxf(C0[2], C0[3]), C1[1]); a = fmaxf(fmaxf(a, C1[2]), C1[3]); \
      _Pragma("unroll") for (int r = 4; r < 16; r += 4) { a = fmaxf(fmaxf(a, C0[r]), C0[r + 1]); bb = fmaxf(fmaxf(bb, C0[r + 2]), C0[r + 3]); a = fmaxf(fmaxf(a, C1[r]), C1[r + 1]); bb = fmaxf(fmaxf(bb, C1[r + 2]), C1[r + 3]); } \
      const float rm = xor32_max(fmaxf(a, bb)); \
      resc = false; const bool mv = (rm > 8.f) | (!seen & (rm > -INFINITY)); \
      if (__builtin_expect(__any(mv), 0)) { const float dl = mv ? rm : 0.f; m += dl; \
        _Pragma("unroll") for (int r = 0; r < 16; ++r) { C0[r] -= dl; C1[r] -= dl; } \
        _Pragma("unroll") for (int r = 0; r < 16; ++r) negm[r] = -m; asm volatile("" : "+v"(negm)); \
        fsc = __builtin_amdgcn_exp2f(-dl); l *= fsc; resc = true; } \
      seen = seen | (rm > -INFINITY); } \
    SBAR(); \
    GAPB(o[0] = mfma32(VFR(0), PAF(0), o[0]), C0, 0, mwv.x); \
    GAPB(o[1] = mfma32(VFR(4), PAF(0), o[1]), C0, 4, mwv.x); \
    KRD(0); GAPB(o[0] = mfma32(VFR(1), PAF(1), o[0]), C0, 8, mwv.x); \
    KRD(1); GAPB(o[1] = mfma32(VFR(5), PAF(1), o[1]), C0, 12, mwv.x); \
    KRD(2); GAPB(o[0] = mfma32(VFR(2), PAF(2), o[0]), C1, 0, mwv.y); \
    KRD(3); GAPB(o[1] = mfma32(VFR(6), PAF(2), o[1]), C1, 4, mwv.y); \
    GAPB(o[0] = mfma32(VFR(3), PAF(3), o[0]), C1, 8, mwv.y); \
    GAPB(o[1] = mfma32(VFR(7), PAF(3), o[1]), C1, 12, mwv.y); \
    AT_WAIT_STEP(); \
    if (resc) { _Pragma("unroll") for (int r = 0; r < 16; ++r) { o[0][r] *= fsc; o[1][r] *= fsc; } }        \
    AT_ROT(); ++tq; } while (0)
    int tq = H0 + 1;
    { const int npair = (H1 - H0 - 1) >> 1; const int ndiag = npair < 2 ? npair : 2; const int nlow = (MODE == 3 && qb >= 2) ? 2 : 0; const int nplain = npair - ndiag - nlow;
      if (MODE == 3) for (int i = 0; i < nlow; ++i) { AT_STEP(pB0, pB1, pA0, pA1, false, true); AT_STEP(pA0, pA1, pB0, pB1, false, true); }
      for (int i = 0; i < nplain; ++i) { AT_STEP(pB0, pB1, pA0, pA1, false, false); AT_STEP(pA0, pA1, pB0, pB1, false, false); }
      for (int i = 0; i < ndiag; ++i) { AT_STEP(pB0, pB1, pA0, pA1, true, false); AT_STEP(pA0, pA1, pB0, pB1, true, false); } }
    AT_STEP(pB0, pB1, pA0, pA1, true, false);
    { const bool sel = (MODE != 1) || (((bmask >> H1) & 1ull) != 0ull); const unsigned km = sel ? 0xffffffffu : 0u;
      float sacc = pB0[0] + pB0[1];
#pragma unroll
      for (int r = 2; r < 16; ++r) sacc += pB0[r];
#pragma unroll
      for (int r = 0; r < 16; ++r) sacc += pB1[r];
      l += sel ? sacc : 0.f;
      pw0 = (u32x4){PKW(pB0, 0), PKW(pB0, 2), PKW(pB0, 4), PKW(pB0, 6)}; pw1 = (u32x4){PKW(pB0, 8), PKW(pB0, 10), PKW(pB0, 12), PKW(pB0, 14)};
      pw2 = (u32x4){PKW(pB1, 0), PKW(pB1, 2), PKW(pB1, 4), PKW(pB1, 6)}; pw3 = (u32x4){PKW(pB1, 8), PKW(pB1, 10), PKW(pB1, 12), PKW(pB1, 14)};
      const LAS unsigned char* vp_ = vp0 + sl_prev;
#pragma unroll
      for (int i = 0; i < 8; ++i) VRD(i);
      o[0] = mfma32(VFR(0), PAF(0), o[0]); o[1] = mfma32(VFR(4), PAF(0), o[1]); o[0] = mfma32(VFR(1), PAF(1), o[0]); o[1] = mfma32(VFR(5), PAF(1), o[1]);
      o[0] = mfma32(VFR(2), PAF(2), o[0]); o[1] = mfma32(VFR(6), PAF(2), o[1]); o[0] = mfma32(VFR(3), PAF(3), o[0]); o[1] = mfma32(VFR(7), PAF(3), o[1]); }
    l += SHFL_XOR(l, 32);
    asm volatile("s_nop 15\n\ts_nop 7" : "+v"(o[0]), "+v"(o[1]));
#undef AT_STEP
#undef KRD
#undef VRD
#undef GAPB
#undef GAPA
#undef PIN
#undef VFR
#undef PAF
#undef PKW
#undef AT_EXM
#undef AT_CMASK
#undef AT_KV
#undef AT_ROT
#undef AT_WAIT_STEP
#undef AT_WAIT_BAR
#undef AT_DMA_K
#undef AT_DMA_V
#undef AT_DMA_M
#undef AT_CL
#undef AT_QR
    const float inv = l > 0.f ? 1.f / l : 0.f;
    LAS u16* stg = (LAS u16*)(lds + AT_O + wid * 4608);
    stage_o(stg, o, inv, r32, hi);
#pragma unroll
    for (int i = 0; i < 4; ++i) { const int rw = i * 8 + (lane >> 3), ch = lane & 7; u32x4 v = *(const LAS u32x4*)(stg + rw * 72 + ch * 8);
        const size_t orow = (size_t)b * SEQ + q0 + wid * 32 + rw;
        if (MODE == 1) {
            const u16* zg = (const u16*)(p.ws + OFF_RZ) + orow * ZP + ZG + h * 3; const float g0 = bf2f(zg[0]), g1 = bf2f(zg[1]), g2 = bf2f(zg[2]);
            const u32x4 c = *(const u32x4*)((const u16*)(p.ws + OFF_OC) + orow * 384 + h * 64 + ch * 8), w = *(const u32x4*)((const u16*)(p.ws + OFF_OW) + orow * 384 + h * 64 + ch * 8);
            u32x4 r;
#define CMB(F) r.F = cvt_pk_bf16(g0 * bflo(c.F) + g1 * bflo(v.F) + g2 * bflo(w.F), g0 * bfhi(c.F) + g1 * bfhi(v.F) + g2 * bfhi(w.F))
            CMB(x); CMB(y); CMB(z); CMB(w);
#undef CMB
            v = r; }
        *(u32x4*)(A.O + orow * A.op + A.oc + h * 64 + ch * 8) = v; }
    asm volatile("s_waitcnt lgkmcnt(0)" ::: "memory");
    __syncthreads();
}
constexpr int DS_HP = 260;
constexpr int DS_HIST = 0, DS_PREF = 32 * 260 * 4, DS_KREM = DS_PREF + 128, DS_THR = DS_KREM + 128, DS_NTK = DS_THR + 128, DS_PART = DS_NTK + 128, DS_ANY = DS_PART + 128, DS_TCNT = DS_ANY + 128, DS_LCNT = DS_TCNT + 32 * 128 * 4, DS_LU = DS_LCNT + 128, DS_LK = DS_LU + 32 * 64 * 4, DS_MWL = DS_LK + 32 * 64 * 4, DS_ZW = DS_MWL + 32 * 128 * 4, DS_HIST2 = DS_ZW + 32 * 128 * 4, DS_BYTES = DS_HIST2 + 32 * 260 * 4;
__device__ __forceinline__ unsigned ordkey(float f) { const int u = __float_as_int(f); return (unsigned)(u ^ ((u >> 31) | (int)0x80000000)); }
struct IdxQ { bf16x8 bq[4][2]; float w[4]; };
__device__ __forceinline__ void idx_scores(const bf16x8 ka0, const bf16x8 ka1, const IdxQ& Q, unsigned (&u)[16]) {
    float I[16];
#pragma unroll
    for (int r = 0; r < 16; ++r) I[r] = 0.f;
    f32x16 sa = {}, sb = {};
    sa = mfma32(ka0, Q.bq[0][0], sa); sa = mfma32(ka1, Q.bq[0][1], sa);
#pragma unroll
    for (int h = 0; h < 4; ++h) {
        if (h < 3) { sb = (f32x16){}; sb = mfma32(ka0, Q.bq[h + 1][0], sb); sb = mfma32(ka1, Q.bq[h + 1][1], sb); }
        __builtin_amdgcn_sched_barrier(0);
#pragma unroll
        for (int r = 0; r < 16; ++r) I[r] = fmaf(Q.w[h], fmaxf(sa[r], 0.f), I[r]);
#pragma unroll
        for (int r = 0; r < 16; ++r) asm volatile("" : "+v"(I[r]));
        __builtin_amdgcn_sched_barrier(0);
        sa = sb; }
#pragma unroll
    for (int r = 0; r < 16; ++r) u[r] = ordkey(I[r]);
}
__device__ __forceinline__ unsigned lowbits(unsigned w, unsigned k) {
    if (k >= (unsigned)__popc(w)) return w;
    unsigned lo = 0u, hi = 32u;
#pragma unroll
    for (int it = 0; it < 6; ++it) { const unsigned mid = (lo + hi) >> 1; const unsigned msk = mid >= 32u ? 0xffffffffu : ((1u << mid) - 1u); if ((unsigned)__popc(w & msk) >= k) hi = mid; else lo = mid + 1u; }
    return w & (hi >= 32u ? 0xffffffffu : ((1u << hi) - 1u));
}
__device__ __forceinline__ void dsa_select_task(const Params& p, int b, int qt, LAS unsigned char* lds) {
    const int tid = tid_fresh(p.wave), lane = tid & 63, wid = tid >> 6, r32 = lane & 31, hi = lane >> 5;
    LAS unsigned* hist = (LAS unsigned*)(lds + DS_HIST); LAS unsigned* pref = (LAS unsigned*)(lds + DS_PREF); LAS unsigned* krem = (LAS unsigned*)(lds + DS_KREM);
    LAS unsigned* thrv = (LAS unsigned*)(lds + DS_THR); LAS unsigned* ntk = (LAS unsigned*)(lds + DS_NTK); LAS unsigned* part = (LAS unsigned*)(lds + DS_PART); LAS unsigned* anyp = (LAS unsigned*)(lds + DS_ANY);
    LAS unsigned* tcnt = (LAS unsigned*)(lds + DS_TCNT);
    const u16* Z = (const u16*)(p.ws + OFF_RZ);
    const int t0 = qt * 32, t = t0 + r32, ntile = qt + 1; const size_t row = (size_t)b * SEQ + t;
    const u16* kbase = Z + ((size_t)b * SEQ + r32) * ZP + ZIK + hi * 8; bf16x8 na0, na1;
#define DS_KLOAD0() do { const int k0_ = wid < ntile ? wid : 0; const u16* kp_ = kbase + (size_t)k0_ * 32 * ZP; na0 = *(const bf16x8*)kp_; na1 = *(const bf16x8*)(kp_ + 16); } while (0)
    IdxQ Q;
#pragma unroll
    for (int h = 0; h < 4; ++h) { Q.bq[h][0] = *(const bf16x8*)(Z + row * ZP + ZIQ + h * 32 + hi * 8); Q.bq[h][1] = *(const bf16x8*)(Z + row * ZP + ZIQ + h * 32 + 16 + hi * 8); Q.w[h] = bf2f(Z[row * ZP + ZIW + h]); }
    if (tid < 32) { pref[tid] = 0u; krem[tid] = 256u; }
    if (tid == 0) anyp[0] = 0u;
#define DS_DPPADD(v, ctrl) ((v) + (unsigned)__builtin_amdgcn_update_dpp(0, (int)(v), (ctrl), 0xF, 0xF, true))
#define DS_RADIX(PLO, PHI) _Pragma("unroll 1") \
    for (int pass = (PLO); pass < (PHI); ++pass) { const int shift = 24 - 8 * pass; \
        for (int i = tid; i < 32 * DS_HP / 4; i += NTHR) { ((LAS u32x4*)hist)[i] = (u32x4){0u, 0u, 0u, 0u}; ((LAS u32x4*)(hist + (DS_HIST2 - DS_HIST) / 4))[i] = (u32x4){0u, 0u, 0u, 0u}; } \
        __syncthreads(); \
        const unsigned mypref = pref[r32]; \
        DS_KLOAD0(); \
        _Pragma("unroll 1") \
        for (int kt = wid; kt < ntile; kt += 8) { unsigned u[16]; const bf16x8 ka0 = na0, ka1 = na1; { const int kn = (kt + 8 < ntile) ? kt + 8 : kt; const u16* kp = kbase + (size_t)kn * 32 * ZP; na0 = *(const bf16x8*)kp; na1 = *(const bf16x8*)(kp + 16); } idx_scores(ka0, ka1, Q, u); \
            const unsigned px = pass == 0 ? 0u : (mypref << 8); LAS unsigned* hrow = hist + hi * ((DS_HIST2 - DS_HIST) / 4) + r32 * DS_HP; \
            if (kt < qt) { \
        _Pragma("unroll") \
                for (int r = 0; r < 16; ++r) { const unsigned y = (u[r] >> shift) ^ px; if (y < 256u) __hip_atomic_fetch_add(hrow + y, 1u, __ATOMIC_RELAXED, __HIP_MEMORY_SCOPE_WORKGROUP); }        \
            } else { \
        _Pragma("unroll") \
                for (int r = 0; r < 16; ++r) { const bool valid = (32 * kt + crow(r, hi)) <= t; const unsigned y = (u[r] >> shift) ^ px; if (valid && y < 256u) __hip_atomic_fetch_add(hrow + y, 1u, __ATOMIC_RELAXED, __HIP_MEMORY_SCOPE_WORKGROUP); } } } \
        __syncthreads(); \
        {   \
          const int sq = lane >> 4, sj = lane & 15, q = wid * 4 + sq; const unsigned need = krem[q]; \
          const LAS unsigned* hr = hist + q * DS_HP + 4 * sj; const LAS unsigned* hr2 = hr + (DS_HIST2 - DS_HIST) / 4; \
          u32x4 c4[4]; unsigned s4[4], S4[4], T4[4]; \
          _Pragma("unroll") for (int i = 0; i < 4; ++i) { c4[i] = *(const LAS u32x4*)(hr + 64 * i) + *(const LAS u32x4*)(hr2 + 64 * i); s4[i] = (c4[i].x + c4[i].y) + (c4[i].z + c4[i].w); \
              unsigned v = s4[i]; v = DS_DPPADD(v, 0x101); v = DS_DPPADD(v, 0x102); v = DS_DPPADD(v, 0x104); v = DS_DPPADD(v, 0x108); S4[i] = v;        \
              unsigned w = s4[i]; w = DS_DPPADD(w, 0x128); w = DS_DPPADD(w, 0x124); w = DS_DPPADD(w, 0x122); w = DS_DPPADD(w, 0x121); T4[i] = w; }     \
          const unsigned A3 = 0u, A2 = T4[3], A1 = A2 + T4[2], A0 = A1 + T4[1]; \
          const unsigned b3 = A3 + S4[3] - s4[3], b2 = A2 + S4[2] - s4[2], b1 = A1 + S4[1] - s4[1], b0 = A0 + S4[0] - s4[0]; \
          const bool f3 = (b3 < need) && (need <= b3 + s4[3]), f2 = (b2 < need) && (need <= b2 + s4[2]), f1 = (b1 < need) && (need <= b1 + s4[1]), f0 = (b0 < need) && (need <= b0 + s4[0]); \
          const bool found = f3 | f2 | f1 | f0; const int fi = f3 ? 3 : (f2 ? 2 : (f1 ? 1 : 0)); const unsigned sufx = f3 ? b3 : (f2 ? b2 : (f1 ? b1 : b0)); \
          const u32x4 cc = f3 ? c4[3] : (f2 ? c4[2] : (f1 ? c4[1] : c4[0])); \
          const unsigned a3 = sufx, a2 = a3 + cc.w, a1 = a2 + cc.z, a0 = a1 + cc.y; const bool t3 = a3 + cc.w >= need, t2 = a2 + cc.z >= need, t1 = a1 + cc.y >= need; \
          unsigned digit = 64 * fi + 4 * sj + (t3 ? 3 : (t2 ? 2 : (t1 ? 1 : 0))), above = t3 ? a3 : (t2 ? a2 : (t1 ? a1 : a0)), cd = t3 ? cc.w : (t2 ? cc.z : (t1 ? cc.y : cc.x)); \
          const unsigned long long bm = __ballot(found); const unsigned seg = (unsigned)(bm >> (16 * sq)) & 0xffffu; const bool any = seg != 0u; const int src = 16 * sq + (any ? __builtin_ctz(seg) : 0); \
          { const unsigned d_ = SHFL_IDX(digit, src), a_ = SHFL_IDX(above, src), c_ = SHFL_IDX(cd, src); digit = any ? d_ : 0u; above = any ? a_ : 0u; cd = any ? c_ : 0u; } \
          if (sj == 0) { pref[q] = (pass == 0 ? 0u : (pref[q] << 8)) | digit; krem[q] = need - above; if (pass == 3) { const int tq = t0 + q; const bool all = tq < 256; \
                    thrv[q] = all ? 0u : ((pref[q])); ntk[q] = need - above; const unsigned pt = (!all && cd > need - above) ? 1u : 0u; part[q] = pt; if (pt) anyp[0] = 1u; } } \
        } \
        __syncthreads(); \
    }
    DS_RADIX(0, 2);
    LAS unsigned* lcnt = (LAS unsigned*)(lds + DS_LCNT); LAS unsigned* lu = (LAS unsigned*)(lds + DS_LU); LAS unsigned* lk = (LAS unsigned*)(lds + DS_LK); LAS unsigned* mwl = (LAS unsigned*)(lds + DS_MWL); LAS unsigned* zwl = (LAS unsigned*)(lds + DS_ZW);
    if (tid < 32) lcnt[tid] = 0u;
    __syncthreads();
    { const unsigned p16 = pref[r32]; const bool all = t < 256;
      DS_KLOAD0();
#pragma unroll 1
      for (int kt = wid; kt < ntile; kt += 8) { unsigned u[16]; const bf16x8 ka0 = na0, ka1 = na1; { const int kn = (kt + 8 < ntile) ? kt + 8 : kt; const u16* kp = kbase + (size_t)kn * 32 * ZP; na0 = *(const bf16x8*)kp; na1 = *(const bf16x8*)(kp + 16); } idx_scores(ka0, ka1, Q, u);
          unsigned bits = 0u, zb = 0u;
#pragma unroll
          for (int r = 0; r < 16; ++r) { const int ps = crow(r, hi); const bool valid = (kt < qt) || ((32 * kt + ps) <= t); const unsigned y = u[r] >> 16;
              if (valid && (all || y > p16)) bits |= 1u << ps;
              const bool und = valid && !all && y == p16;
              if (und && u[r] == 0x80000000u) zb |= 1u << ps;
              if (und && u[r] != 0x80000000u) { const unsigned ix = __hip_atomic_fetch_add(lcnt + r32, 1u, __ATOMIC_RELAXED, __HIP_MEMORY_SCOPE_WORKGROUP); if (ix < 64u) { lu[r32 * 64 + ix] = u[r]; lk[r32 * 64 + ix] = (unsigned)(32 * kt + ps); } } }
          bits |= SHFL_XOR(bits, 32); zb |= SHFL_XOR(zb, 32);
          if (hi == 0) { mwl[r32 * 128 + kt] = bits; zwl[r32 * 128 + kt] = zb; } } }
    __syncthreads();
    bool ovf = false;
#pragma unroll
    for (int q = 0; q < 32; ++q) ovf = ovf || (lcnt[q] > 64u);
    if (!ovf) {
#pragma unroll 1
        for (int qi = 0; qi < 4; ++qi) { const int q = wid * 4 + qi; const unsigned n = (unsigned)__builtin_amdgcn_readfirstlane((int)lcnt[q]), need = krem[q]; const bool act = (unsigned)lane < n;
            const unsigned mu = act ? lu[q * 64 + lane] : 0u, mk = act ? lk[q * 64 + lane] : 0xffffffffu; unsigned rank = 0u;
            for (unsigned j = 0; j < n; ++j) { const unsigned uj = (unsigned)__builtin_amdgcn_readlane((int)mu, (int)j), kj = (unsigned)__builtin_amdgcn_readlane((int)mk, (int)j); rank += (uj > mu || (uj == mu && kj < mk)) ? 1u : 0u; }
            if (act && rank < need) __hip_atomic_fetch_or(mwl + q * 128 + (mk >> 5), 1u << (mk & 31u), __ATOMIC_RELAXED, __HIP_MEMORY_SCOPE_WORKGROUP);
            const unsigned nz = need > n ? need - n : 0u;
            const int k0 = 2 * lane, k1 = 2 * lane + 1; const unsigned z0 = k0 < ntile ? zwl[q * 128 + k0] : 0u, z1 = k1 < ntile ? zwl[q * 128 + k1] : 0u;
            const unsigned c0 = __popc(z0), c1 = __popc(z1), sm = c0 + c1; unsigned v = sm;
#pragma unroll
            for (int off = 1; off < 64; off <<= 1) { const unsigned tmp = SHFL_UP(v, off); if (lane >= off) v += tmp; }
            const unsigned ex = v - sm;
            { const unsigned take0 = nz > ex ? (nz - ex < c0 ? nz - ex : c0) : 0u, take1 = nz > ex + c0 ? (nz - ex - c0 < c1 ? nz - ex - c0 : c1) : 0u;
              if (take0) mwl[q * 128 + k0] |= lowbits(z0, take0);
              if (take1) mwl[q * 128 + k1] |= lowbits(z1, take1); } }
        __syncthreads();
        unsigned* MWg = (unsigned*)(p.ws + OFF_MASKW) + ((size_t)b * SEQ + t0) * 128;
        for (int i = tid; i < 32 * ntile; i += NTHR) { const int q = i / ntile, kt = i - q * ntile; MWg[(size_t)q * 128 + kt] = mwl[q * 128 + kt]; }
        __syncthreads();
        return;
    }
    __syncthreads();
    DS_RADIX(2, 4);
#undef DS_RADIX
    const unsigned thr = thrv[r32], ntake = ntk[r32], ptl = part[r32]; const bool anyPartial = anyp[0] != 0u;
    if (anyPartial) {
        DS_KLOAD0();
#pragma unroll 1
        for (int kt = wid; kt < ntile; kt += 8) { unsigned u[16]; const bf16x8 ka0 = na0, ka1 = na1; { const int kn = (kt + 8 < ntile) ? kt + 8 : kt; const u16* kp = kbase + (size_t)kn * 32 * ZP; na0 = *(const bf16x8*)kp; na1 = *(const bf16x8*)(kp + 16); } idx_scores(ka0, ka1, Q, u); unsigned tb = 0u;
#pragma unroll
            for (int r = 0; r < 16; ++r) { const bool valid = (32 * kt + crow(r, hi)) <= t; if (valid && u[r] == thr) tb |= 1u << crow(r, hi); }
            tb |= SHFL_XOR(tb, 32); if (hi == 0) tcnt[r32 * 128 + kt] = __popc(tb); }
        __syncthreads();
#pragma unroll 1
        for (int qi = 0; qi < 4; ++qi) { const int q = wid * 4 + qi; const unsigned a0 = (2 * lane < ntile) ? tcnt[q * 128 + 2 * lane] : 0u, a1 = (2 * lane + 1 < ntile) ? tcnt[q * 128 + 2 * lane + 1] : 0u;
            const unsigned s = a0 + a1; unsigned v = s;
#pragma unroll
            for (int off = 1; off < 64; off <<= 1) { const unsigned tmp = SHFL_UP(v, off); if (lane >= off) v += tmp; }
            const unsigned ex = v - s; tcnt[q * 128 + 2 * lane] = ex; tcnt[q * 128 + 2 * lane + 1] = ex + a0; }
        __syncthreads();
    }
    unsigned* MW = (unsigned*)(p.ws + OFF_MASKW);
    DS_KLOAD0();
#pragma unroll 1
    for (int kt = wid; kt < ntile; kt += 8) { unsigned u[16]; const bf16x8 ka0 = na0, ka1 = na1; { const int kn = (kt + 8 < ntile) ? kt + 8 : kt; const u16* kp = kbase + (size_t)kn * 32 * ZP; na0 = *(const bf16x8*)kp; na1 = *(const bf16x8*)(kp + 16); } idx_scores(ka0, ka1, Q, u); unsigned bits = 0u, tb = 0u, base = 0u;
        if (anyPartial) {
#pragma unroll
            for (int r = 0; r < 16; ++r) { const bool valid = (32 * kt + crow(r, hi)) <= t; if (valid && u[r] == thr) tb |= 1u << crow(r, hi); }
            tb |= SHFL_XOR(tb, 32); base = tcnt[r32 * 128 + kt]; }
#pragma unroll
        for (int r = 0; r < 16; ++r) { const int ps = crow(r, hi); const bool valid = (32 * kt + ps) <= t; const bool tie = u[r] == thr;
            const bool tieok = !ptl || ((base + __popc(tb & ((1u << ps) - 1u))) < ntake);
            if (valid && (u[r] > thr || (tie && tieok))) bits |= 1u << ps; }
        bits |= SHFL_XOR(bits, 32);
        if (hi == 0) MW[row * 128 + kt] = bits; }
    __syncthreads();
}
#undef DS_KLOAD0
#ifndef DBG_REP
#define DBG_REP 0
#endif
#define REP(g) for (int rep_ = 0; rep_ < (((DBG_REP >> (g)) & 1) ? 2 : 1); ++rep_)
__device__ __forceinline__ void sgu_task(const Params& p, int layer, int b, int n, int g, LAS unsigned char* lds) {
    const int tid = tid_fresh(p.wave), lane = tid & 63, wid = tid >> 6, fr = lane & 15, fq = lane >> 4;
    LAS u16* vt = (LAS u16*)lds; const u16* Z = (const u16*)(p.ws + OFF_RZ); u16* MC = (u16*)(p.ws + OFF_RH);
    const size_t row0 = (size_t)b * SEQ + 128 * n;
    { const int s = tid >> 2, ch = tid & 3; const u16* src = Z + (row0 + s) * ZP + ZSG + 256 + g * 64 + ch * 16; const u32x4 a = *(const u32x4*)src, c = *(const u32x4*)(src + 8);
      LAS u16* d = vt + (ch * 16) * 136 + s;
      d[0 * 136] = (u16)(a.x & 0xffff); d[1 * 136] = (u16)(a.x >> 16); d[2 * 136] = (u16)(a.y & 0xffff); d[3 * 136] = (u16)(a.y >> 16); d[4 * 136] = (u16)(a.z & 0xffff); d[5 * 136] = (u16)(a.z >> 16); d[6 * 136] = (u16)(a.w & 0xffff); d[7 * 136] = (u16)(a.w >> 16);
      d[8 * 136] = (u16)(c.x & 0xffff); d[9 * 136] = (u16)(c.x >> 16); d[10 * 136] = (u16)(c.y & 0xffff); d[11 * 136] = (u16)(c.y >> 16); d[12 * 136] = (u16)(c.z & 0xffff); d[13 * 136] = (u16)(c.z >> 16); d[14 * 136] = (u16)(c.w & 0xffff); d[15 * 136] = (u16)(c.w >> 16); }
    const u16* W = (const u16*)(p.ws + OFF_SGW) + ((size_t)(layer * 4 + g) * 128 + 16 * wid + fr) * 128 + fq * 8;
    bf16x8 af[4];
#pragma unroll
    for (int ks = 0; ks < 4; ++ks) af[ks] = *(const bf16x8*)(W + ks * 32);
    __syncthreads();
    f32x4 acc[4];
#pragma unroll
    for (int c = 0; c < 4; ++c) acc[c] = (f32x4){0.f, 0.f, 0.f, 0.f};
    const int nks = ((16 * wid + 15) >> 5) + 1;
#pragma unroll
    for (int ks = 0; ks < 4; ++ks) if (ks < nks) { const bf16x8 a = af[ks];
#pragma unroll
        for (int c = 0; c < 4; ++c) { const bf16x8 bb = *(const LAS bf16x8*)(vt + (16 * c + fr) * 136 + 32 * ks + fq * 8); acc[c] = __builtin_amdgcn_mfma_f32_16x16x32_bf16(a, bb, acc[c], 0, 0, 0); } }
#pragma unroll
    for (int r = 0; r < 4; ++r) { const int t = 16 * wid + 4 * fq + r; const float bias = p.sgu_b[(layer * 4 + g) * 128 + t];
#pragma unroll
        for (int c = 0; c < 4; ++c) { const int d = 16 * c + fr; const float u = bf2f(Z[(row0 + t) * ZP + ZSG + g * 64 + d]); MC[(row0 + t) * D + 768 + g * 64 + d] = f2bf(u * (acc[c][r] + bias)); } }
    __syncthreads();
}

constexpr int PH_L0 = 2;
constexpr int PH_PER_L0 = 9;
constexpr int PH_L1 = PH_L0 + PH_PER_L0;
constexpr int PH_END = PH_L1 + 7 + 2 * MOE_NCHUNK + 1;

__device__ __forceinline__ void mixer_phase1(const Params& p, int layer, LAS unsigned char* lds) {
    REP(4) phase_cmpattn(p, layer, lds);
    const u16* Z = (const u16*)(p.ws + OFF_RZ);
    REP(5) { AttnArgs A{(const u16*)(p.ws + OFF_QROT), 384, 0, Z, ZP, ZKV + 4 * 128, Z, ZP, ZKV + 5 * 128, (u16*)(p.ws + OFF_OW), 384, 0};
      for (int u = blockIdx.x; u < 768; u += gridDim.x) { const int qb = u & 15, h = (u >> 4) % 6, b = u / 96; AttnArgs B = A; B.kc += (h / 3) * 64; B.vc += (h / 3) * 64; attn_unit<3>(p, B, b, h, h / 3, qb, lds); } }
    REP(6) for (int pr = blockIdx.x; pr < 512; pr += gridDim.x) { const int b = pr >> 6, s = pr & 63; dsa_select_task(p, b, s, lds); dsa_select_task(p, b, 127 - s, lds); }
    REP(7) for (int u = blockIdx.x; u < 1024; u += gridDim.x) sgu_task(p, layer, u >> 7, (u >> 2) & 31, u & 3, lds);
}
__device__ __forceinline__ void mixer_phase2(const Params& p, int layer, LAS unsigned char* lds) {
    const u16* Z = (const u16*)(p.ws + OFF_RZ); u16* MC = (u16*)(p.ws + OFF_RH);
    for (int pr = blockIdx.x; pr < 768; pr += gridDim.x) {
        const bool dsa = pr >= 384; const int q = dsa ? pr - 384 : pr; const int s = q & 7, h = (q >> 3) % 6, b = q / 48;
        REP(dsa ? 9 : 8) for (int k = 0; k < 2; ++k) { const int qb = k ? 15 - s : s;
            if (!dsa) { AttnArgs A{(const u16*)(p.ws + OFF_QROT), 384, 0, Z, ZP, ZKV + 2 * 128 + (h / 3) * 64, Z, ZP, ZKV + 3 * 128 + (h / 3) * 64, MC, D, 0};
#ifdef DBG_VAR
                { AttnArgs Bd = A; Bd.O = (u16*)(p.ws + WS_END); attn_unit<1, DBG_VAR>(p, Bd, b, h, h / 3, qb, lds); }
#endif
                attn_unit<1>(p, A, b, h, h / 3, qb, lds); }
            else { AttnArgs A{Z, ZP, ZDQ, Z, ZP, ZCKV, Z, ZP, ZCKV + 64, MC, D, 384}; attn_unit<2>(p, A, b, h, 0, qb, lds); } }
    }
}

__device__ __forceinline__ Params fresh_params(const Params& p) { Params q = p; asm volatile("" : "+s"(q.ws)); return q; }
__global__ void __launch_bounds__(NTHR, 2) k_main(Params p_in) {
    Params p = p_in; p.wave = __builtin_amdgcn_readfirstlane((int)(threadIdx.x >> 6));
    extern __shared__ __attribute__((aligned(16))) unsigned char shm[];
    LAS unsigned char* lds = (LAS unsigned char*)shm;
    unsigned* bar = (unsigned*)(p.ws + OFF_BAR);
    LAS u32x4* xbw = (LAS u32x4*)(lds + LDS_BYTES - 16);
    XcdBarrier xb; xb.bar = bar; xb.x = 0; xb.wave = p.wave; xb.st = (volatile LAS unsigned*)xbw;
    if (p.use_bar) { if (tid_fresh(p.wave) == 0) *xbw = (u32x4){0u, 0u, 0u, 0u}; __syncthreads(); xb = xcd_barrier_post(bar, (volatile LAS unsigned*)xbw); xb.wave = p.wave; }
    const int G = gridDim.x, c = blockIdx.x;
#define PHASE(id) if ((id) >= p.phase_lo && (id) < p.phase_hi)
#define SEAM(id) do { if (p.use_bar && (id) >= p.phase_lo && (id) + 1 < p.phase_hi) xcd_barrier(xb); } while (0)
    PHASE(0) { const Params q = fresh_params(p); REP(0) for (int j = c; j < PJ_END; j += G) prologue_job(q, j, lds); }
    SEAM(0);
    PHASE(1) { const Params q = fresh_params(p); REP(1) phase_lnmod0(q); }
    SEAM(1);
    for (int layer = 0; layer < DEPTH; ++layer) {
        const int base = layer == 0 ? PH_L0 : PH_L1;
        PHASE(base + 0) REP(2) { const Params q = fresh_params(p); pg8::SchedDense S; S.init(q.ws + OFF_RH, q.ws + OFF_WIN + (size_t)layer * ZP * D * 2, M, ZP, D, G, c); pg8::EpiBf16 E{(u16*)(q.ws + OFF_RZ), ZP}; pg8::gemm_phase(lds, D, S, E, q.wave); }
        SEAM(base + 0);
#ifndef DBG_NOMIX
        PHASE(base + 1) { const Params q = fresh_params(p); if ((DBG_REP >> 18) & 1) phase_prep<true>(q, layer, lds); phase_prep(q, layer, lds); REP(3) phase_compress(q, layer, lds); }
        SEAM(base + 1);
        PHASE(base + 2) { const Params q = fresh_params(p); mixer_phase1(q, layer, lds); }
        SEAM(base + 2);
        PHASE(base + 3) { const Params q = fresh_params(p); mixer_phase2(q, layer, lds); }
        SEAM(base + 3);
#else
        PHASE(base + 3) { const Params q = fresh_params(p); u32x4* mc = (u32x4*)(q.ws + OFF_RH); for (size_t i = (size_t)c * NTHR + tid_fresh(q.wave); i < (size_t)M * D / 8; i += (size_t)G * NTHR) mc[i] = (u32x4){0u, 0u, 0u, 0u}; }
        SEAM(base + 3);
#endif
        PHASE(base + 4) REP(10) { const Params q = fresh_params(p); pg8::SchedDense S; S.init(q.ws + OFF_RH, q.ws + OFF_WOUT + (size_t)layer * D * D * 2, M, D, D, G, c); pg8::EpiBf16 E{(u16*)(q.ws + OFF_RZ), D}; pg8::gemm_phase(lds, D, S, E, q.wave); }
        SEAM(base + 4);
        PHASE(base + 5) { const Params q = fresh_params(p); REP(layer == 0 ? 17 : 31) phase_ln1(q, layer, lds); }
        SEAM(base + 5);
        if (layer == 0) {
            PHASE(base + 6) REP(11) { const Params q = fresh_params(p);
#if FFN0_FP8 == 2
                pg8::SchedDense S; S.init(q.ws + OFF_RH, q.ws + OFF_WGU, M, 2 * DFF, D / 2, G, c); pg8::EpiSwiglu8 E{(unsigned char*)(q.ws + OFF_RZ), DFF, 0, ASC, 1.f / (WSC_UP * ASC)}; pg8::gemm_phase<pg8::EpiSwiglu8, pg8::SchedDense, true, SCB_UP, SCB_ACT>(lds, D / 2, S, E, q.wave);
#elif FFN0_FP8
                pg8::SchedDense S; S.init(q.ws + OFF_RH, q.ws + OFF_WGU, M, 2 * DFF, D / 2, G, c); pg8::EpiSwiglu E{(u16*)(q.ws + OFF_RZ), DFF, 0, 1.f / (WSC_UP * ASC)}; pg8::gemm_phase<pg8::EpiSwiglu, pg8::SchedDense, true, SCB_UP, SCB_ACT>(lds, D / 2, S, E, q.wave);
#else
                pg8::SchedDense S; S.init(q.ws + OFF_RH, q.ws + OFF_WGU, M, 2 * DFF, D, G, c); pg8::EpiSwiglu E{(u16*)(q.ws + OFF_RZ), DFF, 0}; pg8::gemm_phase(lds, D, S, E, q.wave);
#endif
            }
            SEAM(base + 6);
            PHASE(base + 7) REP(12) { const Params q = fresh_params(p);
#if FFN0_FP8 == 2
                pg8::SchedDense S; S.init(q.ws + OFF_RZ, q.ws + OFF_WDN, M, D, DFF / 2, G, c); pg8::EpiBf16 E{(u16*)(q.ws + OFF_RH), D, 1.f / (WSC_DN * ASC)}; pg8::gemm_phase<pg8::EpiBf16, pg8::SchedDense, true, SCB_DN, SCB_ACT>(lds, DFF / 2, S, E, q.wave);
#else
                pg8::SchedDense S; S.init(q.ws + OFF_RZ, q.ws + OFF_WDN, M, D, DFF, G, c); pg8::EpiBf16 E{(u16*)(q.ws + OFF_RH), D}; pg8::gemm_phase(lds, DFF, S, E, q.wave);
#endif
            }
            SEAM(base + 7);
            PHASE(base + 8) { const Params q = fresh_params(p); phase_ln2(q, layer); }
            SEAM(base + 8);
        } else {
            PHASE(base + 6) { const Params q = fresh_params(p); REP(16) phase_moe_slots(q, layer, lds); REP(13) moe_conv_all(q, lds); }
            SEAM(base + 6);
            PHASE(base + 7) REP(14) { const Params q = fresh_params(p); LAS int* tab = (LAS int*)(lds + LDS_TAB); moe_tables(q, 0, tab); const int T = tab[8]; const int ntl = T - 256;
                if (ntl > 0) { pg8::SchedMoe S{q.ws + OFF_HG8, q.ws + OFF_MW1, (size_t)256 * D, (size_t)2 * EFF * D, 256, ntl, 2 * EFF / 256, G, c, tab + 16};
                    pg8::EpiSwiglu8 E{(unsigned char*)(q.ws + OFF_HT), EFF, 256 * 256, ASC, 1.f / (WSC_UP * ASC)}; pg8::gemm_phase<pg8::EpiSwiglu8, pg8::SchedMoe, true, SCB_UP, SCB_ACT>(lds, D / 2, S, E, q.wave); }
                { pg8::SchedMoe S{q.ws + OFF_HG8, q.ws + OFF_MW1, (size_t)256 * D, (size_t)2 * EFF * D, 0, 128, 2 * EFF / 256, G, c, tab + 16};
                    pg8::EpiSwiglu8 E{(unsigned char*)(q.ws + OFF_RO), EFF, 0, ASC, 1.f / (WSC_UP * ASC)}; pg8::gemm_phase<pg8::EpiSwiglu8, pg8::SchedMoe, true, SCB_UP, SCB_ACT>(lds, D / 2, S, E, q.wave); } }
            SEAM(base + 7);
            PHASE(base + 8) REP(15) { const Params q = fresh_params(p); LAS int* tab = (LAS int*)(lds + LDS_TAB); moe_tables(q, 0, tab);
                pg8::SchedMoe S{q.ws + OFF_RO, q.ws + OFF_MW2, (size_t)256 * EFF, (size_t)D * EFF, 0, 128, D / 256, G, c, tab + 16};
                pg8::EpiBf16 E{(u16*)(q.ws + OFF_RH), D, 1.f / (WSC_DN * ASC)}; pg8::gemm_phase<pg8::EpiBf16, pg8::SchedMoe, true, SCB_DN, SCB_ACT>(lds, EFF / 2, S, E, q.wave); }
            SEAM(base + 8);
            PHASE(base + 9) REP(14) { const Params q = fresh_params(p); LAS int* tab = (LAS int*)(lds + LDS_TAB); moe_tables(q, 0, tab); const int T = tab[8]; const int ntl = T - 256;
                if (ntl > 0) { pg8::SchedMoe S{q.ws + OFF_HT - (size_t)256 * 256 * EFF, q.ws + OFF_MW2, (size_t)256 * EFF, (size_t)D * EFF, 256, ntl, D / 256, G, c, tab + 16};
                    pg8::EpiBf16 E{(u16*)(q.ws + OFF_RH), D, 1.f / (WSC_DN * ASC)}; pg8::gemm_phase<pg8::EpiBf16, pg8::SchedMoe, true, SCB_DN, SCB_ACT>(lds, EFF / 2, S, E, q.wave); }
                { pg8::SchedMoeSkip S{q.ws + OFF_HG8, q.ws + OFF_MW1, (size_t)256 * D, (size_t)2 * EFF * D, 128, 128, 2 * EFF / 256, G, c, tab + 16, ntl > 0 ? 4 * ntl : 0, 3};
                    pg8::EpiSwiglu8 E{(unsigned char*)(q.ws + OFF_RO), EFF, 128 * 256, ASC, 1.f / (WSC_UP * ASC)}; pg8::gemm_phase<pg8::EpiSwiglu8, pg8::SchedMoeSkip, true, SCB_UP, SCB_ACT>(lds, D / 2, S, E, q.wave); } }
            SEAM(base + 9);
            PHASE(base + 10) REP(15) { const Params q = fresh_params(p); LAS int* tab = (LAS int*)(lds + LDS_TAB); moe_tables(q, 0, tab);
                pg8::SchedMoe S{q.ws + OFF_RO - (size_t)128 * 256 * EFF, q.ws + OFF_MW2, (size_t)256 * EFF, (size_t)D * EFF, 128, 128, D / 256, G, c, tab + 16};
                pg8::EpiBf16 E{(u16*)(q.ws + OFF_RH), D, 1.f / (WSC_DN * ASC)}; pg8::gemm_phase<pg8::EpiBf16, pg8::SchedMoe, true, SCB_DN, SCB_ACT>(lds, EFF / 2, S, E, q.wave); }
            SEAM(base + 10);
            PHASE(base + 7 + 2 * MOE_NCHUNK) { const Params q = fresh_params(p); phase_ln2(q, layer); }
        }
    }
#undef PHASE
#undef SEAM
}

#include <cstdio>
#include <cstring>
#ifndef MK_LAUNCHES
#define MK_LAUNCHES 1
#endif
extern "C" void kernel_launch(void* const* d_in, const int* in_sizes, int n_in, void* d_out, int out_size, void* d_ws, size_t ws_size, hipStream_t stream) {
    static int grid = 0;
    if (grid == 0) {
        if (n_in != 29 || ws_size < WS_END) { fprintf(stderr, "kernel_launch: n_in %d ws %zu (need %zu)\n", n_in, ws_size, (size_t)WS_END); grid = -1; return; }
        int dev = 0, cus = 0, per_cu = 0;
        if (hipGetDevice(&dev) != hipSuccess || hipDeviceGetAttribute(&cus, hipDeviceAttributeMultiprocessorCount, dev) != hipSuccess) { grid = -1; return; }
        if (hipFuncSetAttribute((const void*)k_main, hipFuncAttributeMaxDynamicSharedMemorySize, LDS_BYTES) != hipSuccess) { fprintf(stderr, "kernel_launch: hipFuncSetAttribute failed\n"); grid = -1; return; }
        if (hipOccupancyMaxActiveBlocksPerMultiprocessor(&per_cu, (const void*)k_main, NTHR, LDS_BYTES) != hipSuccess || per_cu < 1) { fprintf(stderr, "kernel_launch: occupancy query says %d\n", per_cu); }
        grid = cus;
    }
    if (grid < 0) return;
    hipMemsetAsync((char*)d_ws + OFF_BAR, 0, 65536, stream);
    Params p; memset(&p, 0, sizeof(p));
    p.x = (const float*)d_in[0]; p.c = (const float*)d_in[1]; p.pos = (const int*)d_in[2]; p.w_ada = (const float*)d_in[3]; p.b_ada = (const float*)d_in[4]; p.w_in = (const float*)d_in[5];
    p.cmp_pos = (const float*)d_in[6]; p.cmp_w1 = (const float*)d_in[7]; p.cmp_w2 = (const float*)d_in[8]; p.kvn = (const float*)d_in[9]; p.w_uk = (const float*)d_in[10]; p.w_uv = (const float*)d_in[11];
    p.sgu_g = (const float*)d_in[12]; p.sgu_bn = (const float*)d_in[13]; p.sgu_w = (const float*)d_in[14]; p.sgu_b = (const float*)d_in[15]; p.w_out = (const float*)d_in[16];
    p.ln1g = (const float*)d_in[17]; p.ln1b = (const float*)d_in[18]; p.ln2g = (const float*)d_in[19]; p.ln2b = (const float*)d_in[20];
    p.fg = (const float*)d_in[21]; p.fu = (const float*)d_in[22]; p.fd = (const float*)d_in[23]; p.mr = (const float*)d_in[24]; p.mbr = (const float*)d_in[25]; p.mg = (const float*)d_in[26]; p.mu = (const float*)d_in[27]; p.md = (const float*)d_in[28];
    p.out = (float*)d_out; p.ws = (char*)d_ws;
#if MK_LAUNCHES == 1
    p.phase_lo = 0; p.phase_hi = PH_END; p.use_bar = 1;
    hipLaunchKernelGGL(k_main, dim3(grid), dim3(NTHR), LDS_BYTES, stream, p);
#else
    for (int ph = 0; ph < PH_END; ++ph) { p.phase_lo = ph; p.phase_hi = ph + 1; p.use_bar = 0; hipLaunchKernelGGL(k_main, dim3(grid), dim3(NTHR), LDS_BYTES, stream, p); }
#endif
}
```

```cpp
#include <hip/hip_runtime.h>
#include <stdint.h>
#include <math.h>

#define LAS __attribute__((address_space(3)))
typedef unsigned short u16;
typedef short bf16x8 __attribute__((ext_vector_type(8)));
typedef short s16x4 __attribute__((ext_vector_type(4)));
typedef float f32x4 __attribute__((ext_vector_type(4)));
typedef float f32x2 __attribute__((ext_vector_type(2)));
typedef float f32x16 __attribute__((ext_vector_type(16)));
typedef unsigned u32x4 __attribute__((ext_vector_type(4)));
typedef unsigned u32x2 __attribute__((ext_vector_type(2)));

constexpr int D = 1024, NB = 8, SEQ = 4096, M = NB * SEQ, DEPTH = 2;
constexpr int ZP = 2560;
constexpr int ZQ = 0, ZKV = 384, ZDQ = 1152, ZCKV = 1536, ZIQ = 1664, ZIK = 1792, ZSG = 1824, ZG = 2336, ZIW = 2360;
constexpr int INW = 2358;
constexpr int DFF = 2816, EFF = 3584, NEXP = 8;
constexpr float ALPHA = 1.41421356237309515f;
constexpr float C2 = 0.125f * 1.4426950408889634f;
constexpr int NTHR = 512;
constexpr int LDS_BYTES = 147456;
constexpr int LDS_TAB = 131072;
constexpr int MOE_ROWS = 65536 + 8 * 256;
constexpr int MOE_TILES = MOE_ROWS / 256;
constexpr int MOE_CHUNK = 128;
constexpr int MOE_NCHUNK = 2;

constexpr size_t al256(size_t x) { return (x + 255) & ~(size_t)255; }
constexpr size_t OFF_BAR = 0;
constexpr size_t OFF_MOD = 65536;
constexpr size_t OFF_COSH = OFF_MOD + (size_t)2 * 8 * 6144 * 4;
constexpr size_t OFF_SINH = OFF_COSH + (size_t)M * 32 * 4;
constexpr size_t OFF_COSI = OFF_SINH + (size_t)M * 32 * 4;
constexpr size_t OFF_SINI = OFF_COSI + (size_t)M * 16 * 4;
constexpr size_t OFF_WIN = OFF_SINI + (size_t)M * 16 * 4;
constexpr size_t OFF_WOUT = OFF_WIN + (size_t)2 * ZP * D * 2;
constexpr size_t OFF_WGU = OFF_WOUT + (size_t)2 * D * D * 2;
constexpr size_t OFF_WDN = OFF_WGU + (size_t)2 * DFF * D * 2;
constexpr size_t OFF_CW1T = OFF_WDN + (size_t)D * DFF * 2;
constexpr size_t OFF_CB1 = OFF_CW1T + (size_t)4 * 64 * 2048 * 2;
constexpr size_t OFF_SGW = OFF_CB1 + 1024;
constexpr size_t OFF_KC = OFF_SGW + (size_t)2 * 4 * 128 * 128 * 2;
constexpr size_t OFF_VCT = OFF_KC + (size_t)8 * 2 * 256 * 64 * 2;
constexpr size_t OFF_BLK = OFF_VCT + (size_t)8 * 2 * 256 * 64 * 2;
constexpr size_t OFF_TOK = OFF_BLK + (size_t)M * 2 * 8;
constexpr size_t OFF_SLOT = OFF_TOK + (size_t)M * 16;
constexpr size_t OFF_HIST = OFF_SLOT + (size_t)M * 8;
constexpr size_t OFF_RZ = al256(OFF_HIST + 256 * 8 * 4);
constexpr size_t SZ_RZ = (size_t)M * DFF * 2;
constexpr size_t OFF_RH = OFF_RZ + SZ_RZ;
constexpr size_t SZ_RH = (size_t)MOE_ROWS * D * 2;
constexpr size_t OFF_RO = OFF_RH + SZ_RH;
constexpr size_t SZ_RO = (size_t)MOE_CHUNK * 256 * EFF;
constexpr size_t OFF_OC = OFF_RO, OFF_OW = OFF_OC + (size_t)M * 384 * 2, OFF_QROT = OFF_OW + (size_t)M * 384 * 2;
constexpr size_t OFF_MASKW = OFF_QROT + (size_t)M * 384 * 2;
static_assert(OFF_MASKW + (size_t)M * 128 * 4 <= OFF_RO + SZ_RO, "R_O map");
constexpr size_t OFF_XR = OFF_RO + SZ_RO;
constexpr size_t OFF_HT = OFF_XR + (size_t)M * D * 2;
constexpr size_t WS_END = OFF_HT + (size_t)8 * 256 * EFF;
constexpr size_t OFF_MW1 = OFF_RZ;
constexpr size_t OFF_MW2 = OFF_RZ + (size_t)NEXP * 2 * EFF * D;
constexpr size_t OFF_HG8 = OFF_RZ + ((size_t)96 << 20);
static_assert(OFF_MW2 + (size_t)NEXP * D * EFF <= OFF_HG8 && OFF_HG8 + (size_t)MOE_ROWS * D <= OFF_RZ + SZ_RZ, "R_Z map");
#ifndef FFN0_FP8
#define FFN0_FP8 1
#endif
constexpr float WSC_UP = 64.f, WSC_DN = 128.f, ASC = 8.f;
constexpr int SCB_UP = 0x79797979, SCB_DN = 0x78787878, SCB_ACT = 0x7C7C7C7C;
constexpr int CTL_Q = 4096;

__device__ __forceinline__ unsigned cvt_pk_bf16(float lo, float hi) { unsigned r; asm volatile("v_cvt_pk_bf16_f32 %0, %1, %2" : "=v"(r) : "v"(lo), "v"(hi)); return r; }
__device__ __forceinline__ u16 f2bf(float f) { return (u16)(cvt_pk_bf16(f, 0.f) & 0xffffu); }
__device__ __forceinline__ float bf2f(u16 b) { return __uint_as_float(((unsigned)b) << 16); }
__device__ __forceinline__ float bflo(unsigned w) { return __uint_as_float(w << 16); }
__device__ __forceinline__ float bfhi(unsigned w) { return __uint_as_float(w & 0xffff0000u); }
__device__ __forceinline__ int lane_fresh() { unsigned z = 0u; asm volatile("" : "+v"(z)); return (int)__builtin_amdgcn_mbcnt_hi(~0u, __builtin_amdgcn_mbcnt_lo(~0u, z)); }
template <class T> __device__ __forceinline__ T bperm(T v, int src) { return __builtin_bit_cast(T, __builtin_amdgcn_ds_bpermute(src << 2, __builtin_bit_cast(int, v))); }
#define SHFL_XOR(v, m) bperm((v), lane_fresh() ^ (m))
#define SHFL_DOWN(v, o) bperm((v), lane_fresh() + (o))
#define SHFL_UP(v, o) bperm((v), lane_fresh() - (o))
#define SHFL_IDX(v, s) bperm((v), (s))
#define DPP_ADD(v, ctrl, row_mask) ((v) + __int_as_float(__builtin_amdgcn_update_dpp(0, __float_as_int(v), (ctrl), (row_mask), 0xF, false)))
__device__ __forceinline__ float wave_sum(float v) {
    v = DPP_ADD(v, 0xB1, 0xF);
    v = DPP_ADD(v, 0x4E, 0xF);
    v = DPP_ADD(v, 0x141, 0xF);
    v = DPP_ADD(v, 0x140, 0xF);
    v = DPP_ADD(v, 0x142, 0xA);
    v = DPP_ADD(v, 0x143, 0xC);
    return __int_as_float(__builtin_amdgcn_readlane(__float_as_int(v), 63)); }
__device__ __forceinline__ float gelu_tanh(float x) { const float y = 0.7978845608028654f * (x + 0.044715f * x * x * x); const float e = __expf(2.f * y); const float t = 1.f - 2.f / (e + 1.f); return 0.5f * x * (1.f + t); }
__device__ __forceinline__ int crow(int r, int hi) { return (r & 3) + 8 * (r >> 2) + 4 * hi; }

struct Params {
    const float *x, *c; const int* pos;
    const float *w_ada, *b_ada, *w_in, *cmp_pos, *cmp_w1, *cmp_w2, *kvn, *w_uk, *w_uv, *sgu_g, *sgu_bn, *sgu_w, *sgu_b, *w_out, *ln1g, *ln1b, *ln2g, *ln2b;
    const float *fg, *fu, *fd, *mr, *mbr, *mg, *mu, *md;
    float* out; char* ws;
    int phase_lo, phase_hi, use_bar, wave;
};
__device__ __forceinline__ int tid_fresh(int wave) { unsigned z = 0u; asm volatile("" : "+v"(z)); const int l = (int)__builtin_amdgcn_mbcnt_hi(~0u, __builtin_amdgcn_mbcnt_lo(~0u, z)); return (wave << 6) | l; }
#define XB_TMO      128
#define XB_XCNT(j)  (256  + 64 * (j))
#define XB_XSUB(j)  (1280 + 64 * (j))
#define XB_XGEN(j)  (2304 + 64 * (j))
#define XB_TOP      3328
#define XB_TOPGEN   3392
#define XCD_BAR_WORDS 3456
#define XB_SPIN_CAP (1u << 18)

__device__ __forceinline__ unsigned xb_ld(unsigned* p)              { return __hip_atomic_load(p, __ATOMIC_RELAXED, __HIP_MEMORY_SCOPE_AGENT); }
__device__ __forceinline__ unsigned xb_add(unsigned* p, unsigned v) { return __hip_atomic_fetch_add(p, v, __ATOMIC_RELAXED, __HIP_MEMORY_SCOPE_AGENT); }
__device__ __forceinline__ unsigned xb_xcc_id() { return (unsigned)__builtin_amdgcn_s_getreg((3 << 11) | 20) & 0xFu; }
#define XB_SPIN(cond, bar) do { unsigned _sp = 0; while (cond) { __builtin_amdgcn_s_sleep(1); \
    if ((++_sp & 255u) == 0u) { if (xb_ld(&(bar)[XB_TMO])) break; if (_sp > XB_SPIN_CAP) { atomicAdd(&(bar)[XB_TMO], 1u); break; } } } } while (0)

struct XcdBarrier {
    unsigned* bar; unsigned x; int wave;
    volatile LAS unsigned* st;
};

__device__ __forceinline__ XcdBarrier xcd_barrier_post(unsigned* bar, volatile LAS unsigned* st) {
    XcdBarrier b; b.bar = bar; b.x = xb_xcc_id(); b.st = st;
    if (threadIdx.x == 0) (void)xb_add(&bar[XB_XCNT(b.x)], 1u);
    return b;
}
__device__ __forceinline__ void xcd_barrier_complete(unsigned* bar, unsigned x, unsigned& nloc, unsigned& nx) {
    const unsigned G = gridDim.x * gridDim.y * gridDim.z;
    unsigned sum, cnt, mine, sp = 0u;
    for (;;) {
        sum = 0u; cnt = 0u; mine = 0u;
#pragma unroll
        for (unsigned j = 0; j < 16; ++j) { const unsigned c = xb_ld(&bar[XB_XCNT(j)]); sum += c; cnt += (c > 0u) ? 1u : 0u; mine = (j == x) ? c : mine; }
        if (sum == G) break;
        __builtin_amdgcn_s_sleep(1);
        if ((++sp & 255u) == 0u) { if (xb_ld(&bar[XB_TMO])) break; if (sp > XB_SPIN_CAP) { atomicAdd(&bar[XB_TMO], 1u); break; } }
    }
    nloc = mine > 0u ? mine : 1u; nx = cnt > 0u ? cnt : 1u;
}

__device__ __forceinline__ void xcd_barrier(const XcdBarrier& b) {
    asm volatile("s_waitcnt vmcnt(0)" ::: "memory");
    __syncthreads();
    if (tid_fresh(b.wave) == 0) {
        unsigned* bar = b.bar;
        __builtin_amdgcn_s_waitcnt(0);
        unsigned nloc = b.st[0], nx = b.st[1];
        if (nloc == 0u) { xcd_barrier_complete(bar, b.x, nloc, nx); b.st[0] = nloc; b.st[1] = nx; }
        const unsigned old = xb_add(&bar[XB_XSUB(b.x)], 1u);
        const unsigned gen = old / nloc;
        if (old + 1u == (gen + 1u) * nloc) {
            __builtin_amdgcn_fence(__ATOMIC_RELEASE, "agent");
            asm volatile("s_waitcnt vmcnt(0)" ::: "memory");
            const unsigned og = xb_add(&bar[XB_TOP], 1u);
            const unsigned tg = og / nx;
            if (og + 1u == (tg + 1u) * nx) xb_add(&bar[XB_TOPGEN], 1u);
            else XB_SPIN(xb_ld(&bar[XB_TOPGEN]) == tg, bar);
            __builtin_amdgcn_fence(__ATOMIC_ACQUIRE, "agent");
            xb_add(&bar[XB_XGEN(b.x)], 1u);
            asm volatile("s_waitcnt vmcnt(0)" ::: "memory");
        } else {
            XB_SPIN(xb_ld(&bar[XB_XGEN(b.x)]) == gen, bar);
            __builtin_amdgcn_fence(__ATOMIC_ACQUIRE, "agent");
            asm volatile("s_waitcnt vmcnt(0)" ::: "memory");
        }
    }
    __syncthreads();
}
namespace pg8 {
constexpr int BM = 256, BK = 64, HALF = 128, HTB = HALF * BK * 2, STAGE_BYTES = 8 * HTB, NXCD = 8, WGM = 8;
__host__ __device__ __forceinline__ int lds_byte(int r, int c) { const int st = (r >> 4) * 2 + (c >> 5), rr = r & 15, cc = c & 31, ob = rr * 64 + cc * 2; return st * 1024 + (ob ^ (((ob >> 9) & 1) << 5)); }
__host__ __device__ __forceinline__ void stage_rc(int b, int& R, int& C) { const int st = b / 1024, sb = b % 1024, swz = sb ^ (((sb >> 9) & 1) << 5); R = (st >> 1) * 16 + swz / 64; C = (st & 1) * 32 + (swz % 64) / 2; }
__host__ __device__ __forceinline__ int perm32(int rho) { const int n = rho >> 4, i = rho & 15; return 8 * (i >> 2) + 4 * n + (i & 3); }

struct Unit { int pm, pn; };

struct SchedDense {
    const char* A; const char* B; size_t tstep;
    int nM, nN, nwg, G, c;
    __device__ void init(const void* A_, const void* B_, int Mr, int N, int K, int G_, int c_) { A = (const char*)A_; B = (const char*)B_; tstep = (size_t)256 * K * 2; nM = Mr / BM; nN = N / BM; nwg = nM * nN; G = G_; c = c_; }
    __device__ bool next(int i, Unit& u) const {
        const long L = (long)i * G + c; if (L >= nwg) return false;
        int wgid = (int)L; { const int q = nwg / NXCD, r = nwg % NXCD, xcd = wgid % NXCD, off = wgid / NXCD; wgid = (xcd < r ? xcd * (q + 1) : r * (q + 1) + (xcd - r) * q) + off; }
        const int nig = WGM * nN, gid = wgid / nig, fm = gid * WGM, gsz = (nM - fm) < WGM ? (nM - fm) : WGM;
        u.pm = fm + ((wgid % nig) % gsz); u.pn = (wgid % nig) / gsz; return true;
    }
    __device__ __forceinline__ const char* a_ptr(const Unit& u) const { return A + (size_t)u.pm * tstep; }
    __device__ __forceinline__ const char* b_ptr(const Unit& u) const { return B + (size_t)u.pn * tstep; }
};
struct SchedMoe {
    const char* A; const char* B; size_t tstep, estride; int tile0, ntile, nN, G, c; const LAS int* texp;
    __device__ bool next(int i, Unit& u) const { const long L = (long)i * G + c; if (L >= (long)ntile * nN) return false; u.pm = tile0 + (int)(L % ntile); u.pn = (int)(L / ntile); return true; }
    __device__ __forceinline__ const char* a_ptr(const Unit& u) const { return A + (size_t)u.pm * tstep; }
    __device__ __forceinline__ const char* b_ptr(const Unit& u) const { return B + (size_t)texp[u.pm] * estride + (size_t)u.pn * tstep; }
};

struct SchedMoeSkip {
    const char* A; const char* B; size_t tstep, estride; int tile0, ntile, nN, G, c; const LAS int* texp; int nlong, skip;
    __device__ bool next(int i, Unit& u) const { const long tot = (long)ntile * nN; long L;
        if (c < nlong) L = (long)(i + skip) * G + c;
        else { const long nreg = (tot - c + G - 1) / G; if (i < nreg) L = (long)i * G + c; else { const int a = c - nlong; if (i > nreg || a >= nlong * skip) return false; L = (long)(a / nlong) * G + (a % nlong); } }
        if (L >= tot) return false; u.pm = tile0 + (int)(L % ntile); u.pn = (int)(L / ntile); return true; }
    __device__ __forceinline__ const char* a_ptr(const Unit& u) const { return A + (size_t)u.pm * tstep; }
    __device__ __forceinline__ const char* b_ptr(const Unit& u) const { return B + (size_t)texp[u.pm] * estride + (size_t)u.pn * tstep; }
};

struct EpiBf16 {
    u16* O; int ldc; float sc = 1.f;
    __device__ __forceinline__ void operator()(const f32x4 (&acc)[2][2][4][2], const Unit& u, int wr, int wc, int fr, int fq) const {
        const int row0 = u.pm * BM + wr * 64 + fr; const int col0 = u.pn * BM + wc * 32 + 8 * fq;
#pragma unroll
        for (int ai = 0; ai < 2; ++ai)
#pragma unroll
            for (int m = 0; m < 4; ++m) { u16* rowp = O + (size_t)(row0 + ai * HALF + m * 16) * ldc + col0;
#pragma unroll
                for (int bj = 0; bj < 2; ++bj) { const f32x4 v0 = acc[ai][bj][m][0] * sc, v1 = acc[ai][bj][m][1] * sc;
                    u32x4 w; w.x = cvt_pk_bf16(v0[0], v0[1]); w.y = cvt_pk_bf16(v0[2], v0[3]); w.z = cvt_pk_bf16(v1[0], v1[1]); w.w = cvt_pk_bf16(v1[2], v1[3]);
                    *(u32x4*)(rowp + bj * HALF) = w; } }
    }
};
struct EpiSwiglu {
    u16* H; int ldc; int row_off; float isc = 1.f;
    __device__ __forceinline__ void operator()(const f32x4 (&acc)[2][2][4][2], const Unit& u, int wr, int wc, int fr, int fq) const {
        const int row0 = u.pm * BM - row_off + wr * 64 + fr; const int col0 = u.pn * HALF + wc * 32 + 8 * fq;
#pragma unroll
        for (int ai = 0; ai < 2; ++ai)
#pragma unroll
            for (int m = 0; m < 4; ++m) { u16* rowp = H + (size_t)(row0 + ai * HALF + m * 16) * ldc + col0;
                float o[8];
#pragma unroll
                for (int n = 0; n < 2; ++n)
#pragma unroll
                    for (int j = 0; j < 4; ++j) { const float g = acc[ai][0][m][n][j] * isc, up = acc[ai][1][m][n][j] * isc; o[n * 4 + j] = g * __builtin_amdgcn_rcpf(1.f + __expf(-g)) * up; }
                u32x4 w; w.x = cvt_pk_bf16(o[0], o[1]); w.y = cvt_pk_bf16(o[2], o[3]); w.z = cvt_pk_bf16(o[4], o[5]); w.w = cvt_pk_bf16(o[6], o[7]);
                *(u32x4*)rowp = w; }
    }
};

typedef int i32x8 __attribute__((ext_vector_type(8)));
typedef int i32x4 __attribute__((ext_vector_type(4)));
__device__ __forceinline__ i32x8 cat8(bf16x8 a, bf16x8 b) { const i32x4 x = __builtin_bit_cast(i32x4, a), y = __builtin_bit_cast(i32x4, b); return __builtin_shufflevector(x, y, 0, 1, 2, 3, 4, 5, 6, 7); }
__device__ __forceinline__ float clamp448(float x) { return __builtin_fminf(__builtin_fmaxf(x, -448.f), 448.f); }
__device__ __forceinline__ unsigned pk4_fp8(float a, float b, float c, float d) { int w = 0; w = __builtin_amdgcn_cvt_pk_fp8_f32(clamp448(a), clamp448(b), w, false); w = __builtin_amdgcn_cvt_pk_fp8_f32(clamp448(c), clamp448(d), w, true); return (unsigned)w; }
struct EpiSwiglu8 {
    unsigned char* H; int ldc; int row_off; float hsc; float isc;
    __device__ __forceinline__ void operator()(const f32x4 (&acc)[2][2][4][2], const Unit& u, int wr, int wc, int fr, int fq) const {
        const int row0 = u.pm * BM - row_off + wr * 64 + fr; const int col0 = u.pn * HALF + wc * 32 + 8 * fq;
#pragma unroll
        for (int ai = 0; ai < 2; ++ai)
#pragma unroll
            for (int m = 0; m < 4; ++m) { unsigned char* rowp = H + (size_t)(row0 + ai * HALF + m * 16) * ldc + col0;
                float o[8];
#pragma unroll
                for (int n = 0; n < 2; ++n)
#pragma unroll
                    for (int j = 0; j < 4; ++j) { const float g = acc[ai][0][m][n][j] * isc, up = acc[ai][1][m][n][j] * isc; o[n * 4 + j] = g * __builtin_amdgcn_rcpf(1.f + __expf(-g)) * up * hsc; }
                u32x2 w; w.x = pk4_fp8(o[0], o[1], o[2], o[3]); w.y = pk4_fp8(o[4], o[5], o[6], o[7]);
                *(u32x2*)rowp = w; }
    }
};

template <class Epi, class Sched, bool FP8 = false, int SCW = 0x7F7F7F7F, int SCA = 0x7F7F7F7F>
__device__ __forceinline__ void gemm_phase(LAS unsigned char* lds, const int K, const Sched& S, const Epi& E, const int wave) {
    const int tid = tid_fresh(wave), wid = __builtin_amdgcn_readfirstlane(tid >> 6), lane = tid & 63, wr = wid >> 2, wc = wid & 3, fr = lane & 15, fq = lane >> 4;
    const int nt = K / BK;
    unsigned voffA[2], voffB[2];
#pragma unroll
    for (int i = 0; i < 2; ++i) { int R, C; stage_rc(tid * 16 + i * 8192, R, C); const int Rb = (R & ~31) + perm32(R & 31);
        voffA[i] = (unsigned)(R * K + C) * 2u; voffB[i] = (unsigned)(Rb * K + C) * 2u; }
    const size_t kstep = (size_t)(BK * 2);
    const size_t hstep = (size_t)HALF * K * 2;
    const unsigned ldsw = (unsigned)wid * 1024u;
    const int aoff = lds_byte(wr * 64 + fr, fq * 8), boff = lds_byte(wc * 32 + fr, fq * 8);
#define PG8_SA(b, h) (((b) * 2 + (h)) * HTB)
#define PG8_SB(b, h) ((4 + (b) * 2 + (h)) * HTB)
#define PG8_STAGE(bufoff, gbase, voff) do { _Pragma("unroll") for (int _i = 0; _i < 2; ++_i) \
        __builtin_amdgcn_global_load_lds((const unsigned*)((const char*)(gbase) + (voff)[_i]), (LAS unsigned*)(lds + (bufoff) + ldsw + _i * 8192), 16, 0, 0); } while (0)
#define PG8_LDA(dst, b, h) do { if (FP8) { _Pragma("unroll") for (int m = 0; m < 4; ++m) dst##8[m] = cat8(*(const LAS bf16x8*)(lds + PG8_SA(b, h) + aoff + m * 2048), *(const LAS bf16x8*)(lds + PG8_SA(b, h) + aoff + m * 2048 + 1024)); } \
        else { _Pragma("unroll") for (int m = 0; m < 4; ++m) _Pragma("unroll") for (int k = 0; k < 2; ++k) dst[m][k] = *(const LAS bf16x8*)(lds + PG8_SA(b, h) + aoff + m * 2048 + k * 1024); } } while (0)
#define PG8_LDB(dst, b, h) do { if (FP8) { _Pragma("unroll") for (int n = 0; n < 2; ++n) dst##8[n] = cat8(*(const LAS bf16x8*)(lds + PG8_SB(b, h) + boff + n * 2048), *(const LAS bf16x8*)(lds + PG8_SB(b, h) + boff + n * 2048 + 1024)); } \
        else { _Pragma("unroll") for (int n = 0; n < 2; ++n) _Pragma("unroll") for (int k = 0; k < 2; ++k) dst[n][k] = *(const LAS bf16x8*)(lds + PG8_SB(b, h) + boff + n * 2048 + k * 1024); } } while (0)
#define PG8_MMA(ai, bj, At, Bt) do { __builtin_amdgcn_s_setprio(1); \
        if (FP8) { _Pragma("unroll") for (int m = 0; m < 4; ++m) _Pragma("unroll") for (int n = 0; n < 2; ++n) \
            asm volatile("v_mfma_f32_16x16x128_f8f6f4 %0, %1, %2, %0" : "+v"(acc[ai][bj][m][n]) : "v"(Bt##8[n]), "v"(At##8[m])); } \
        else { _Pragma("unroll") for (int m = 0; m < 4; ++m) _Pragma("unroll") for (int n = 0; n < 2; ++n) _Pragma("unroll") for (int k = 0; k < 2; ++k) \
            acc[ai][bj][m][n] = __builtin_amdgcn_mfma_f32_16x16x32_bf16(Bt[n][k], At[m][k], acc[ai][bj][m][n], 0, 0, 0); } \
        __builtin_amdgcn_s_setprio(0); } while (0)
#define PG8_WAIT_V(n) asm volatile("s_waitcnt vmcnt(" #n ")" ::: "memory")
#define PG8_WAIT_L(n) asm volatile("s_waitcnt lgkmcnt(" #n ")" ::: "memory")
#define PG8_BAR __builtin_amdgcn_s_barrier()
#define PG8_SCHED __builtin_amdgcn_sched_barrier(0)
    Unit cur, nxt; int ui = 0;
    if (!S.next(0, cur)) return;
    f32x4 acc[2][2][4][2];
#pragma unroll
    for (int a = 0; a < 2; ++a)
#pragma unroll
        for (int b = 0; b < 2; ++b)
#pragma unroll
            for (int m = 0; m < 4; ++m)
#pragma unroll
                for (int n = 0; n < 2; ++n) acc[a][b][m][n] = (f32x4){0.f, 0.f, 0.f, 0.f};
    bf16x8 At[4][2], B0[2][2], B1[2][2]; i32x8 At8[4], B08[2], B18[2];
    const char* cA = S.a_ptr(cur); const char* cB = S.b_ptr(cur);
    PG8_STAGE(PG8_SB(0, 0), cB, voffB); PG8_STAGE(PG8_SA(0, 0), cA, voffA); PG8_STAGE(PG8_SB(0, 1), cB + hstep, voffB); PG8_STAGE(PG8_SA(0, 1), cA + hstep, voffA);
    if (wr == 1) PG8_BAR;
    PG8_WAIT_V(4); PG8_BAR;
    PG8_STAGE(PG8_SB(1, 0), cB + kstep, voffB); PG8_STAGE(PG8_SA(1, 0), cA + kstep, voffA); PG8_STAGE(PG8_SB(1, 1), cB + hstep + kstep, voffB);
    PG8_WAIT_V(6); PG8_BAR;
    for (;;) {
        const bool has_next = S.next(ui + 1, nxt);
        const char* nA = has_next ? S.a_ptr(nxt) : cA; const char* nB = has_next ? S.b_ptr(nxt) : cB;
        for (int t = 0; t < nt; t += 2) {
            const bool last = (t == nt - 2);
            const char* a1 = cA + (size_t)(t + 1) * kstep;
            const char* a2 = last ? nA : cA + (size_t)(t + 2) * kstep; const char* b2 = last ? nB : cB + (size_t)(t + 2) * kstep;
            const char* a3 = a2 + kstep; const char* b3 = b2 + kstep;
            PG8_LDB(B0, 0, 0); PG8_SCHED; PG8_LDA(At, 0, 0); PG8_STAGE(PG8_SA(1, 1), a1 + hstep, voffA);
            PG8_WAIT_L(8); PG8_BAR; PG8_WAIT_L(0); PG8_MMA(0, 0, At, B0); PG8_BAR; PG8_SCHED;
            PG8_LDB(B1, 0, 1); PG8_STAGE(PG8_SB(0, 0), b2, voffB);
            PG8_BAR; PG8_WAIT_L(0); PG8_MMA(0, 1, At, B1); PG8_BAR;
            PG8_LDA(At, 0, 1); PG8_STAGE(PG8_SA(0, 0), a2, voffA);
            PG8_BAR; PG8_WAIT_L(0); PG8_MMA(1, 0, At, B0); PG8_BAR; PG8_SCHED;
            PG8_STAGE(PG8_SB(0, 1), b2 + hstep, voffB);
            PG8_WAIT_V(6); PG8_BAR; PG8_MMA(1, 1, At, B1); PG8_BAR;
            PG8_LDB(B0, 1, 0); PG8_SCHED; PG8_LDA(At, 1, 0); PG8_STAGE(PG8_SA(0, 1), a2 + hstep, voffA);
            PG8_WAIT_L(8); PG8_BAR; PG8_WAIT_L(0); PG8_MMA(0, 0, At, B0); PG8_BAR; PG8_SCHED;
            PG8_LDB(B1, 1, 1); PG8_STAGE(PG8_SB(1, 0), b3, voffB);
            PG8_BAR; PG8_WAIT_L(0); PG8_MMA(0, 1, At, B1); PG8_BAR;
            PG8_LDA(At, 1, 1); PG8_STAGE(PG8_SA(1, 0), a3, voffA);
            PG8_BAR; PG8_WAIT_L(0); PG8_MMA(1, 0, At, B0); PG8_BAR; PG8_SCHED;
            PG8_STAGE(PG8_SB(1, 1), b3 + hstep, voffB);
            PG8_WAIT_V(6); PG8_BAR; PG8_MMA(1, 1, At, B1); PG8_BAR;
        }
        if (FP8) asm volatile("s_nop 15\n\ts_nop 7" ::: "memory");
        E(acc, cur, wr, wc, fr, fq);
        if (!has_next) break;
#pragma unroll
        for (int a = 0; a < 2; ++a)
#pragma unroll
            for (int b = 0; b < 2; ++b)
#pragma unroll
                for (int m = 0; m < 4; ++m)
#pragma unroll
                    for (int n = 0; n < 2; ++n) acc[a][b][m][n] = (f32x4){0.f, 0.f, 0.f, 0.f};
        cur = nxt; cA = nA; cB = nB; ++ui;
    }
    PG8_WAIT_V(0);
    if (wr == 0) PG8_BAR;
    PG8_BAR;
#undef PG8_SA
#undef PG8_SB
#undef PG8_STAGE
#undef PG8_LDA
#undef PG8_LDB
#undef PG8_MMA
#undef PG8_WAIT_V
#undef PG8_WAIT_L
#undef PG8_BAR
#undef PG8_SCHED
}
}
__device__ __forceinline__ int zcol_to_orig(int n) {
    if (n < 1152) return n;
    if (n < 1536) return 1170 + (n - 1152);
    if (n < 1664) return 1554 + (n - 1536);
    if (n < 1792) return 1682 + (n - 1664);
    if (n < 1824) return 1810 + (n - 1792);
    if (n < 2336) return 1846 + (n - 1824);
    if (n < 2354) return 1152 + (n - 2336);
    if (n < 2360) return -1;
    if (n < 2364) return 1842 + (n - 2360);
    return -1;
}
__constant__ float ROPE_INV[32] = {1.f, 0.749894261f, 0.562341332f, 0.421696514f, 0.316227764f, 0.237137377f, 0.177827939f, 0.133352131f, 0.100000001f, 0.0749894157f, 0.0562341325f, 0.0421696529f, 0.0316227749f, 0.0237137377f, 0.0177827943f, 0.0133352149f,
    0.00999999978f, 0.00749894185f, 0.00562341325f, 0.00421696482f, 0.00316227763f, 0.00237137359f, 0.00177827943f, 0.00133352145f, 0.00100000005f, 0.000749894243f, 0.000562341302f, 0.000421696517f, 0.000316227757f, 0.00023713737f, 0.00017782794f, 0.00013335215f};
template <class F, bool OUT8 = false> __device__ __forceinline__ void conv_tile(LAS float* tile, const F srcp, int ld, int n0, int k0, void* dstv, int K, int wave, float sc = 1.f) {
    const int tid = tid_fresh(wave);
    { const int nn = tid & 63, kk = tid >> 6; const float* p = srcp(n0 + nn); float v[16];
#pragma unroll
      for (int ps = 0; ps < 16; ++ps) v[ps] = p ? p[(size_t)(k0 + ps * 8 + kk) * ld] : 0.f;
#pragma unroll
      for (int ps = 0; ps < 16; ++ps) tile[(ps * 8 + kk) * 65 + nn] = v[ps]; }
    __syncthreads();
    if (OUT8) { const int nn = tid >> 3, kc = tid & 7; float v[16];
#pragma unroll
      for (int i = 0; i < 16; ++i) v[i] = tile[(kc * 16 + i) * 65 + nn] * sc;
      u32x4 w; w.x = pg8::pk4_fp8(v[0], v[1], v[2], v[3]); w.y = pg8::pk4_fp8(v[4], v[5], v[6], v[7]); w.z = pg8::pk4_fp8(v[8], v[9], v[10], v[11]); w.w = pg8::pk4_fp8(v[12], v[13], v[14], v[15]);
      *(u32x4*)((unsigned char*)dstv + (size_t)(n0 + nn) * K + k0 + kc * 16) = w;
    } else { u16* dst = (u16*)dstv;
#pragma unroll
    for (int hf = 0; hf < 2; ++hf) { const int nn = tid >> 3, kc = (tid & 7) + 8 * hf; float v[8];
#pragma unroll
      for (int i = 0; i < 8; ++i) v[i] = tile[(kc * 8 + i) * 65 + nn];
      u32x4 w; w.x = cvt_pk_bf16(v[0], v[1]); w.y = cvt_pk_bf16(v[2], v[3]); w.z = cvt_pk_bf16(v[4], v[5]); w.w = cvt_pk_bf16(v[6], v[7]);
      *(u32x4*)(dst + (size_t)(n0 + nn) * K + k0 + kc * 8) = w; } }
    __syncthreads();
}
struct SrcPlain { const float* base; __device__ __forceinline__ const float* operator()(int n) const { return base + n; } };
struct SrcWin { const float* base; __device__ __forceinline__ const float* operator()(int n) const { const int o = zcol_to_orig(n); return o < 0 ? nullptr : base + o; } };
struct SrcGU { const float* g; const float* u; __device__ __forceinline__ const float* operator()(int n) const { const int pn = n >> 8, bj = (n >> 7) & 1, j = n & 127; const uintptr_t a = (uintptr_t)g, d = (uintptr_t)u - (uintptr_t)g; return (const float*)(a + (uintptr_t)bj * d) + pn * 128 + j; } };

constexpr int PJ_WIN = 0, PJ_WOUT = PJ_WIN + 2 * 40 * 8, PJ_WGU = PJ_WOUT + 2 * 16 * 8, PJ_WDN = PJ_WGU + 88 * 8, PJ_CW1 = PJ_WDN + 16 * 22, PJ_MOD = PJ_CW1 + 4 * 16,
              PJ_ROPE = PJ_MOD + 192, PJ_CB1 = PJ_ROPE + 256, PJ_SGW = PJ_CB1 + 4, PJ_WKV = PJ_SGW + 64, PJ_END = PJ_WKV + 2 * 16;

__device__ __forceinline__ void prologue_job(const Params& p, int job, LAS unsigned char* lds) {
    char* ws = p.ws; const int tid = tid_fresh(p.wave);
    LAS float* tile = (LAS float*)lds;
    if (job < PJ_WOUT) { const int j = job - PJ_WIN, layer = j / 320, r = j % 320, nt = r / 8, kt = r % 8;
        if (nt == 37 || nt == 38) return;
        SrcWin s{p.w_in + (size_t)layer * D * INW}; conv_tile(tile, s, INW, nt * 64, kt * 128, (u16*)(ws + OFF_WIN) + (size_t)layer * ZP * D, D, p.wave);
    } else if (job < PJ_WGU) { const int j = job - PJ_WOUT, layer = j / 128, r = j % 128, nt = r / 8, kt = r % 8;
        SrcPlain s{p.w_out + (size_t)layer * D * D}; conv_tile(tile, s, D, nt * 64, kt * 128, (u16*)(ws + OFF_WOUT) + (size_t)layer * D * D, D, p.wave);
    } else if (job < PJ_WDN) { const int j = job - PJ_WGU, nt = j / 8, kt = j % 8;
        SrcGU s{p.fg, p.fu};
        if (FFN0_FP8) conv_tile<SrcGU, true>(tile, s, DFF, nt * 64, kt * 128, ws + OFF_WGU, D, p.wave, WSC_UP); else conv_tile(tile, s, DFF, nt * 64, kt * 128, (u16*)(ws + OFF_WGU), D, p.wave);
    } else if (job < PJ_CW1) { const int j = job - PJ_WDN, nt = j / 22, kt = j % 22;
        SrcPlain s{p.fd};
        if (FFN0_FP8 == 2) conv_tile<SrcPlain, true>(tile, s, D, nt * 64, kt * 128, ws + OFF_WDN, DFF, p.wave, WSC_DN); else conv_tile(tile, s, D, nt * 64, kt * 128, (u16*)(ws + OFF_WDN), DFF, p.wave);
    } else if (job < PJ_MOD) { const int j = job - PJ_CW1, mat = j / 16, kt = j % 16;
        SrcPlain s{p.cmp_w1 + (size_t)mat * 2048 * 64}; conv_tile(tile, s, 64, 0, kt * 128, (u16*)(ws + OFF_CW1T) + (size_t)mat * 64 * 2048, 2048, p.wave);
    } else if (job < PJ_ROPE) {
        const int j = job - PJ_MOD, layer = j / 96, cg = j % 96;
        LAS float* cact = (LAS float*)lds;
        LAS float* red = cact + 8 * 1024;
        for (int i = tid; i < 8 * 1024; i += NTHR) { const float v = p.c[i]; cact[i] = v / (1.f + __expf(-v)); }
        __syncthreads();
        const int col = tid & 63, kg = tid >> 6; float acc[8];
#pragma unroll
        for (int b = 0; b < 8; ++b) acc[b] = 0.f;
        const float* w = p.w_ada + (size_t)layer * D * 6144 + cg * 64 + col;
#pragma unroll 16
        for (int k = kg; k < 1024; k += 8) { const float wv = w[(size_t)k * 6144];
#pragma unroll
            for (int b = 0; b < 8; ++b) acc[b] = fmaf(cact[b * 1024 + k], wv, acc[b]); }
#pragma unroll
        for (int b = 0; b < 8; ++b) red[(kg * 8 + b) * 64 + col] = acc[b];
        __syncthreads();
        { const int b = tid >> 6; float s = 0.f;
#pragma unroll
          for (int g = 0; g < 8; ++g) s += red[(g * 8 + b) * 64 + col];
          ((float*)(ws + OFF_MOD))[((size_t)layer * 8 + b) * 6144 + cg * 64 + col] = s + p.b_ada[layer * 6144 + cg * 64 + col]; }
        __syncthreads();
    } else if (job < PJ_CB1) {
        const int j = job - PJ_ROPE;
        float* ch = (float*)(ws + OFF_COSH); float* sh = (float*)(ws + OFF_SINH); float* ci = (float*)(ws + OFF_COSI); float* si = (float*)(ws + OFF_SINI);
        for (int e = tid; e < 128 * 32; e += NTHR) { const int row = j * 128 + (e >> 5), i = e & 31; const float ang = (float)p.pos[row] * ROPE_INV[i];
            const double rev = (double)ang * 0.15915494309189535; const float fr = (float)(rev - floor(rev));
            ch[(size_t)row * 32 + i] = __builtin_amdgcn_cosf(fr); sh[(size_t)row * 32 + i] = __builtin_amdgcn_sinf(fr); }
        for (int e = tid; e < 128 * 16; e += NTHR) { const int row = j * 128 + (e >> 4), i = e & 15; const float ang = (float)p.pos[row] * ROPE_INV[2 * i];
            const double rev = (double)ang * 0.15915494309189535; const float fr = (float)(rev - floor(rev));
            ci[(size_t)row * 16 + i] = __builtin_amdgcn_cosf(fr); si[(size_t)row * 16 + i] = __builtin_amdgcn_sinf(fr); }
    } else if (job < PJ_SGW) {
        const int mat = job - PJ_CB1; LAS float* red = (LAS float*)lds;
        const int e = tid & 63, kg = tid >> 6; float s = 0.f;
        const float* w = p.cmp_w1 + (size_t)mat * 2048 * 64; const float* ps = p.cmp_pos + (size_t)mat * 2048;
#pragma unroll 16
        for (int k = kg * 256; k < kg * 256 + 256; ++k) s = fmaf(ps[k], w[(size_t)k * 64 + e], s);
        red[kg * 64 + e] = s; __syncthreads();
        if (tid < 64) { float t = 0.f;
#pragma unroll
            for (int g = 0; g < 8; ++g) t += red[g * 64 + tid];
            ((float*)(ws + OFF_CB1))[mat * 64 + tid] = t; }
        __syncthreads();
    } else if (job >= PJ_WKV) {
        const int j = job - PJ_WKV, layer = j / 16, kb = j % 16;
        LAS float* Aw = (LAS float*)lds; LAS float* Wg = Aw + 64 * 128;
        for (int i = tid; i < 64 * 128; i += NTHR) Aw[i] = p.w_in[((size_t)layer * D + kb * 64 + (i >> 7)) * INW + 1554 + (i & 127)];
        for (int i = tid; i < 128 * 128; i += NTHR) { const int c = i >> 7, n = i & 127; Wg[i] = p.kvn[layer * 128 + c] * (n < 64 ? p.w_uk[((size_t)layer * 128 + c) * 64 + n] : p.w_uv[((size_t)layer * 128 + c) * 64 + n - 64]); }
        __syncthreads();
        { const int n = tid & 127, kq = tid >> 7; float acc[16];
#pragma unroll
          for (int i = 0; i < 16; ++i) acc[i] = 0.f;
          for (int c = 0; c < 128; ++c) { const float w = Wg[c * 128 + n];
#pragma unroll
              for (int i = 0; i < 16; ++i) acc[i] = fmaf(Aw[(kq * 16 + i) * 128 + c], w, acc[i]); }
          u16* dst = (u16*)(ws + OFF_WIN) + (size_t)layer * ZP * D + (size_t)(2368 + n) * D + kb * 64 + kq * 16;
          u32x4 w0, w1; w0.x = cvt_pk_bf16(acc[0], acc[1]); w0.y = cvt_pk_bf16(acc[2], acc[3]); w0.z = cvt_pk_bf16(acc[4], acc[5]); w0.w = cvt_pk_bf16(acc[6], acc[7]);
          w1.x = cvt_pk_bf16(acc[8], acc[9]); w1.y = cvt_pk_bf16(acc[10], acc[11]); w1.z = cvt_pk_bf16(acc[12], acc[13]); w1.w = cvt_pk_bf16(acc[14], acc[15]);
          *(u32x4*)dst = w0; *(u32x4*)(dst + 8) = w1; }
        __syncthreads();
    } else {
        const int j = job - PJ_SGW; u16* dst = (u16*)(ws + OFF_SGW);
        for (int e = j * 2048 + tid; e < j * 2048 + 2048; e += NTHR) { const int t = (e >> 7) & 127, s = e & 127; dst[e] = f2bf(s <= t ? p.sgu_w[e] : 0.f); }
    }
}
constexpr int MJ_W1 = 0, MJ_W2 = NEXP * 112 * 4, MJ_END = MJ_W2 + NEXP * 16 * 14;
struct MoeConvJob { const float* src; unsigned char* dst; int ld, K; float sc; };
__device__ __forceinline__ MoeConvJob moe_conv_decode(const Params& p, int job, int tid) {
    MoeConvJob J; const int nn = tid & 63;
    if (job < MJ_W2) { const int e = job / 448, r = job % 448, nt = r / 4, kt = r % 4; const int n = nt * 64 + nn; const int pn = n >> 8, bj = (n >> 7) & 1, j = n & 127;
        const uintptr_t a = (uintptr_t)(p.mg + (size_t)e * D * EFF), dlt = (uintptr_t)(p.mu + (size_t)e * D * EFF) - a;
        J.src = (const float*)(a + (uintptr_t)bj * dlt) + pn * 128 + j + (size_t)(kt * 256) * EFF; J.ld = EFF; J.K = D; J.sc = WSC_UP; J.dst = (unsigned char*)(p.ws + OFF_MW1) + (size_t)e * 2 * EFF * D + (size_t)(nt * 64) * D + kt * 256;
    } else { const int jj = job - MJ_W2, e = jj / 224, r = jj % 224, nt = r / 14, kt = r % 14;
        J.src = p.md + (size_t)e * EFF * D + nt * 64 + nn + (size_t)(kt * 256) * D; J.ld = D; J.K = EFF; J.sc = WSC_DN; J.dst = (unsigned char*)(p.ws + OFF_MW2) + (size_t)e * D * EFF + (size_t)(nt * 64) * EFF + kt * 256; }
    return J;
}
__device__ __forceinline__ void moe_conv_all(const Params& p, LAS unsigned char* lds) {
    const int tid = tid_fresh(p.wave), kk = tid >> 6, nn = tid & 63, G = gridDim.x; LAS float* tile = (LAS float*)lds;
    int job = blockIdx.x; if (job >= MJ_END) return;
    MoeConvJob J = moe_conv_decode(p, job, tid); float v[32];
#pragma unroll
    for (int ps = 0; ps < 32; ++ps) v[ps] = J.src[(size_t)(ps * 8 + kk) * J.ld];
    for (;;) { const int nj = job + G; const bool more = nj < MJ_END; MoeConvJob N = J; float w[32];
        if (more) { N = moe_conv_decode(p, nj, tid);
#pragma unroll
            for (int ps = 0; ps < 32; ++ps) w[ps] = N.src[(size_t)(ps * 8 + kk) * N.ld]; }
#pragma unroll
        for (int ps = 0; ps < 32; ++ps) tile[(ps * 8 + kk) * 65 + nn] = v[ps];
        __syncthreads();
        { const int n2 = tid >> 3, kc = tid & 7;
#pragma unroll
          for (int hf = 0; hf < 2; ++hf) { float x[16];
#pragma unroll
              for (int i = 0; i < 16; ++i) x[i] = tile[(kc * 32 + hf * 16 + i) * 65 + n2] * J.sc;
              u32x4 o; o.x = pg8::pk4_fp8(x[0], x[1], x[2], x[3]); o.y = pg8::pk4_fp8(x[4], x[5], x[6], x[7]); o.z = pg8::pk4_fp8(x[8], x[9], x[10], x[11]); o.w = pg8::pk4_fp8(x[12], x[13], x[14], x[15]);
              *(u32x4*)(J.dst + (size_t)n2 * J.K + kc * 32 + hf * 16) = o; } }
        __syncthreads();
        if (!more) break;
        job = nj; J = N;
#pragma unroll
        for (int ps = 0; ps < 32; ++ps) v[ps] = w[ps];
    }
}
__device__ __forceinline__ void row_stats(const f32x4 (&v)[4], float& mu, float& rstd) {
    float s = 0.f;
#pragma unroll
    for (int i = 0; i < 4; ++i) s += (v[i][0] + v[i][1]) + (v[i][2] + v[i][3]);
    s = wave_sum(s); mu = s * (1.f / 1024.f); float q = 0.f;
#pragma unroll
    for (int i = 0; i < 4; ++i) { const f32x4 d = v[i] - mu; q += (d[0] * d[0] + d[1] * d[1]) + (d[2] * d[2] + d[3] * d[3]); }
    q = wave_sum(q); rstd = rsqrtf(q * (1.f / 1024.f) + 1e-5f);
}
__device__ __forceinline__ void ld_row_f32(const float* p, int lane, f32x4 (&v)[4]) {
#pragma unroll
    for (int i = 0; i < 4; ++i) v[i] = *(const f32x4*)(p + i * 256 + lane * 4); }
__device__ __forceinline__ void ld_row_bf16(const u16* p, int lane, f32x4 (&v)[4]) {
#pragma unroll
    for (int i = 0; i < 4; ++i) { const u32x2 w = *(const u32x2*)(p + i * 256 + lane * 4); v[i] = (f32x4){bflo(w.x), bfhi(w.x), bflo(w.y), bfhi(w.y)}; } }
__device__ __forceinline__ void st_row_bf16(u16* p, int lane, const f32x4 (&v)[4]) {
#pragma unroll
    for (int i = 0; i < 4; ++i) { u32x2 w; w.x = cvt_pk_bf16(v[i][0], v[i][1]); w.y = cvt_pk_bf16(v[i][2], v[i][3]); *(u32x2*)(p + i * 256 + lane * 4) = w; } }
__device__ __forceinline__ void st_row_fp8(unsigned char* p, int lane, const f32x4 (&v)[4]) {
#pragma unroll
    for (int i = 0; i < 4; ++i) *(unsigned*)(p + i * 256 + lane * 4) = pg8::pk4_fp8(v[i][0] * ASC, v[i][1] * ASC, v[i][2] * ASC, v[i][3] * ASC); }
template <bool BF> struct XRaw { typedef f32x4 T; };
template <> struct XRaw<true> { typedef u32x2 T; };
template <bool BF> __device__ __forceinline__ void ldx(const void* base, size_t row, int lane, typename XRaw<BF>::T (&r)[4]) {
#pragma unroll
    for (int i = 0; i < 4; ++i) { if constexpr (BF) r[i] = *(const u32x2*)((const u16*)base + row * D + i * 256 + lane * 4); else r[i] = *(const f32x4*)((const float*)base + row * D + i * 256 + lane * 4); } }
__device__ __forceinline__ f32x4 cvx(const f32x4 r) { return r; }
__device__ __forceinline__ f32x4 cvx(const u32x2 r) { return (f32x4){bflo(r.x), bfhi(r.x), bflo(r.y), bfhi(r.y)}; }
__device__ __forceinline__ void st_row_f32(float* p, int lane, const f32x4 (&v)[4]) {
#pragma unroll
    for (int i = 0; i < 4; ++i) *(f32x4*)(p + i * 256 + lane * 4) = v[i]; }
__device__ __forceinline__ void modulate_row(const f32x4 (&v)[4], const float* shift, const float* scale, int lane, f32x4 (&h)[4]) {
    float mu, rstd; row_stats(v, mu, rstd);
#pragma unroll
    for (int i = 0; i < 4; ++i) { const f32x4 sc = *(const f32x4*)(scale + i * 256 + lane * 4), sh = *(const f32x4*)(shift + i * 256 + lane * 4); h[i] = (v[i] - mu) * rstd * (sc + 1.f) + sh; } }
__device__ __forceinline__ void layernorm_row(f32x4 (&v)[4], const float* g, const float* b, int lane) {
    float mu, rstd; row_stats(v, mu, rstd);
#pragma unroll
    for (int i = 0; i < 4; ++i) { const f32x4 gg = *(const f32x4*)(g + i * 256 + lane * 4), bb = *(const f32x4*)(b + i * 256 + lane * 4); v[i] = (v[i] - mu) * rstd * gg + bb; } }

__device__ __forceinline__ void modulate_regs(const f32x4 (&v)[4], const f32x4 (&sh)[4], const f32x4 (&sc)[4], f32x4 (&h)[4]) {
    float mu, rstd; row_stats(v, mu, rstd);
#pragma unroll
    for (int i = 0; i < 4; ++i) h[i] = (v[i] - mu) * rstd * (sc[i] + 1.f) + sh[i]; }
__device__ __forceinline__ void layernorm_regs(f32x4 (&v)[4], const f32x4 (&g)[4], const f32x4 (&b)[4]) {
    float mu, rstd; row_stats(v, mu, rstd);
#pragma unroll
    for (int i = 0; i < 4; ++i) v[i] = (v[i] - mu) * rstd * g[i] + b[i]; }

__device__ __forceinline__ void phase_lnmod0(const Params& p) {
    const int tid = tid_fresh(p.wave); const int lane = tid & 63, wid = tid >> 6; u16* H = (u16*)(p.ws + OFF_RH); const float* mod = (const float*)(p.ws + OFF_MOD);
    for (int vb = blockIdx.x; vb < 256; vb += gridDim.x) { const int b = (vb * 128) / SEQ; const float* mb = mod + (size_t)b * 6144;
        f32x4 sh[4], sc[4], na[4], nb[4]; ld_row_f32(mb + 0 * 1024, lane, sh); ld_row_f32(mb + 1 * 1024, lane, sc);
        const int r0 = vb * 128 + wid; ld_row_f32(p.x + (size_t)r0 * D, lane, na); ld_row_f32(p.x + (size_t)(r0 + 8) * D, lane, nb);
        for (int i = 0; i < 16; ++i) { const int row = r0 + i * 8; f32x4 v[4], h[4];
#pragma unroll
            for (int k = 0; k < 4; ++k) { v[k] = na[k]; na[k] = nb[k]; }
            if (i + 2 < 16) ld_row_f32(p.x + (size_t)(row + 16) * D, lane, nb);
            modulate_regs(v, sh, sc, h);
            st_row_bf16(H + (size_t)row * D, lane, h); } }
}
template <bool XBF> __device__ __forceinline__ void phase_ln1_t(const Params& p, int layer, LAS unsigned char* lds) {
    const int tid = tid_fresh(p.wave); const int lane = tid & 63, wid = tid >> 6; const bool moe = (layer & 1) != 0;
    const void* xin = XBF ? (const void*)(p.ws + OFF_XR) : (const void*)p.x; u16* XR = (u16*)(p.ws + OFF_XR); const u16* mix = (const u16*)(p.ws + OFF_RZ); u16* H = (u16*)(p.ws + OFF_RH);
    const float* mod = (const float*)(p.ws + OFF_MOD) + (size_t)layer * 8 * 6144;
    LAS int* hist = (LAS int*)lds; LAS float* wrt = (LAS float*)(lds + 64);
    if (moe) { for (int i = tid; i < 8192; i += NTHR) wrt[(i & 7) * 1024 + (i >> 3)] = p.mr[i]; __syncthreads(); }
    f32x4 lg1[4], lb1[4]; ld_row_f32(p.ln1g + layer * D, lane, lg1); ld_row_f32(p.ln1b + layer * D, lane, lb1);
    for (int vb = blockIdx.x; vb < 256; vb += gridDim.x) { const int b = (vb * 128) / SEQ; const float* mb = mod + (size_t)b * 6144;
        if (moe) { if (tid < 8) hist[tid] = 0; __syncthreads(); }
        f32x4 g1[4], sh[4], sc[4]; ld_row_f32(mb + 2 * 1024, lane, g1); ld_row_f32(mb + 3 * 1024, lane, sh); ld_row_f32(mb + 4 * 1024, lane, sc);
        typename XRaw<XBF>::T nv[4], nv2[4]; u32x2 nm[4], nm2[4];
        { const int r0 = vb * 128 + wid; ldx<XBF>(xin, (size_t)r0, lane, nv); ldx<XBF>(xin, (size_t)(r0 + 8), lane, nv2);
#pragma unroll
            for (int k = 0; k < 4; ++k) { nm[k] = *(const u32x2*)(mix + (size_t)r0 * D + k * 256 + lane * 4); nm2[k] = *(const u32x2*)(mix + (size_t)(r0 + 8) * D + k * 256 + lane * 4); } }
        for (int i = 0; i < 16; ++i) { const int row = vb * 128 + i * 8 + wid;
            f32x4 v[4], h[4];
#pragma unroll
            for (int k = 0; k < 4; ++k) { const f32x4 mx = (f32x4){bflo(nm[k].x), bfhi(nm[k].x), bflo(nm[k].y), bfhi(nm[k].y)}; v[k] = cvx(nv[k]) * ALPHA + g1[k] * mx; nv[k] = nv2[k]; nm[k] = nm2[k]; }
            if (i + 2 < 16) { const int rn = row + 16; ldx<XBF>(xin, (size_t)rn, lane, nv2);
#pragma unroll
                for (int k = 0; k < 4; ++k) nm2[k] = *(const u32x2*)(mix + (size_t)rn * D + k * 256 + lane * 4); }
            layernorm_regs(v, lg1, lb1);
            st_row_bf16(XR + (size_t)row * D, lane, v);
            modulate_regs(v, sh, sc, h);
            if (!moe) { if (FFN0_FP8) st_row_fp8((unsigned char*)H + (size_t)row * D, lane, h); else st_row_bf16(H + (size_t)row * D, lane, h); }
            else {
                float lg[8];
#pragma unroll
                for (int e = 0; e < 8; ++e) { float a = 0.f;
#pragma unroll
                    for (int k = 0; k < 4; ++k) { const f32x4 w = *(const LAS f32x4*)(wrt + e * 1024 + k * 256 + lane * 4); a = fmaf(h[k][0], w[0], a); a = fmaf(h[k][1], w[1], a); a = fmaf(h[k][2], w[2], a); a = fmaf(h[k][3], w[3], a); }
                    lg[e] = wave_sum(a) + p.mbr[e]; }
                int e0 = 0; float v0 = lg[0];
#pragma unroll
                for (int e = 1; e < 8; ++e) if (lg[e] > v0) { v0 = lg[e]; e0 = e; }
                int e1 = -1; float v1 = -INFINITY;
#pragma unroll
                for (int e = 0; e < 8; ++e) if (e != e0 && (e1 < 0 || lg[e] > v1)) { v1 = lg[e]; e1 = e; }
                const float ex = __expf(v1 - v0), w0 = 1.f / (1.f + ex), w1 = ex / (1.f + ex);
                if (lane == 0) { int4 ti; ti.x = e0 | (e1 << 8); ti.y = __float_as_int(w0); ti.z = __float_as_int(w1); ti.w = 0; ((int4*)(p.ws + OFF_TOK))[row] = ti;
                    __hip_atomic_fetch_add(hist + e0, 1, __ATOMIC_RELAXED, __HIP_MEMORY_SCOPE_WORKGROUP); __hip_atomic_fetch_add(hist + e1, 1, __ATOMIC_RELAXED, __HIP_MEMORY_SCOPE_WORKGROUP); }
            }
        }
        if (moe) { __syncthreads(); if (tid < 8) ((int*)(p.ws + OFF_HIST))[vb * 8 + tid] = hist[tid]; __syncthreads(); }
    }
}
__device__ __forceinline__ void phase_ln1(const Params& p, int layer, LAS unsigned char* lds) { if (layer == 0) phase_ln1_t<false>(p, layer, lds); else phase_ln1_t<true>(p, layer, lds); }
__device__ __forceinline__ void moe_tables(const Params& p, int vb, LAS int* tab) {
    const int tid = tid_fresh(p.wave);
    const int* hist = (const int*)(p.ws + OFF_HIST);
    LAS int* cnt = tab + 300; LAS int* part = tab + 320;
    { const int e = tid & 7, j = tid >> 3; int tot = 0, pre = 0;
#pragma unroll
      for (int k = 0; k < 4; ++k) { const int b = 4 * j + k; const int h = hist[b * 8 + e]; tot += h; pre += (b < vb) ? h : 0; }
      part[j * 16 + e] = tot; part[j * 16 + 8 + e] = pre; }
    __syncthreads();
    if (tid < 16) { int s = 0;
        for (int j = 0; j < 64; ++j) s += part[j * 16 + tid];
        cnt[tid] = s; }
    __syncthreads();
    if (tid == 0) { int start = 0, t = 0;
        for (int e = 0; e < 8; ++e) { const int nt = (cnt[e] + 255) >> 8; tab[e] = start + cnt[8 + e]; int ev = e; asm volatile("" : "+v"(ev)); for (int k = 0; k < nt; ++k) tab[16 + t + k] = ev; t += nt;        start += nt * 256; }
        tab[8] = t; }
    __syncthreads();
}
__device__ __forceinline__ void phase_moe_slots(const Params& p, int layer, LAS unsigned char* lds) {
    const int tid = tid_fresh(p.wave); const int lane = tid & 63, wid = tid >> 6; LAS int* tab = (LAS int*)lds; LAS int* te = tab + 1408; LAS int* tp = tab + 1600;
    unsigned char* HG = (unsigned char*)(p.ws + OFF_HG8); const float* mod = (const float*)(p.ws + OFF_MOD) + (size_t)layer * 8 * 6144;
    for (int vb = blockIdx.x; vb < 256; vb += gridDim.x) {
        moe_tables(p, vb, tab);
        if (tid < 128) te[tid] = ((const int4*)(p.ws + OFF_TOK))[vb * 128 + tid].x;
        __syncthreads();
        if (tid < 128) { const int t = tid, e0 = te[t] & 255, e1 = te[t] >> 8; int c0 = 0, c1 = 0;
            for (int k = 0; k < t; ++k) { const int a = te[k] & 255, b = te[k] >> 8; c0 += (a == e0) + (b == e0); c1 += (a == e1) + (b == e1); }
            const int p0 = tab[e0] + c0, p1 = tab[e1] + c1; tp[2 * t] = p0; tp[2 * t + 1] = p1; ((int2*)(p.ws + OFF_SLOT))[vb * 128 + t] = make_int2(p0, p1); }
        __syncthreads();
        u32x2 nv[4], nv2[4]; f32x4 sh[4], sc[4]; { const float* mb = mod + (size_t)((vb * 128) / SEQ) * 6144; ld_row_f32(mb + 3 * 1024, lane, sh); ld_row_f32(mb + 4 * 1024, lane, sc); }
        const void* XR = (const void*)(p.ws + OFF_XR);
        ldx<true>(XR, (size_t)(vb * 128 + wid), lane, nv); ldx<true>(XR, (size_t)(vb * 128 + wid + 8), lane, nv2);
        for (int i = 0; i < 16; ++i) { const int tl = i * 8 + wid, row = vb * 128 + tl;
            f32x4 v[4], h[4];
#pragma unroll
            for (int k = 0; k < 4; ++k) { v[k] = cvx(nv[k]); nv[k] = nv2[k]; }
            if (i + 2 < 16) ldx<true>(XR, (size_t)(row + 16), lane, nv2);
            modulate_regs(v, sh, sc, h);
            st_row_fp8(HG + (size_t)tp[2 * tl] * D, lane, h); st_row_fp8(HG + (size_t)tp[2 * tl + 1] * D, lane, h); }
        __syncthreads();
    }
}
__device__ __forceinline__ void phase_ln2(const Params& p, int layer) {
    const int tid = tid_fresh(p.wave); const int lane = tid & 63, wid = tid >> 6; const bool moe = (layer & 1) != 0;
    u16* H = (u16*)(p.ws + OFF_RH); const float* mod = (const float*)(p.ws + OFF_MOD) + (size_t)layer * 8 * 6144;
    f32x4 lg2[4], lb2[4]; ld_row_f32(p.ln2g + layer * D, lane, lg2); ld_row_f32(p.ln2b + layer * D, lane, lb2);
    for (int vb = blockIdx.x; vb < 256; vb += gridDim.x) { const int b = (vb * 128) / SEQ; const float* mb = mod + (size_t)b * 6144;
        f32x4 g2[4], nsh[4], nsc[4]; ld_row_f32(mb + 5 * 1024, lane, g2);
        if (layer + 1 < DEPTH) { const float* mn = mb + (size_t)8 * 6144; ld_row_f32(mn + 0 * 1024, lane, nsh); ld_row_f32(mn + 1 * 1024, lane, nsc); }
        const int r0 = vb * 128 + wid;
        u32x2 nv[4], nv2[4]; u32x2 na[4], nb[4]; int4 ti = make_int4(0, 0, 0, 0), ti2 = ti; int2 sl = make_int2(0, 0), sl2 = sl; u16* XR = (u16*)(p.ws + OFF_XR);
#pragma unroll
        for (int k = 0; k < 4; ++k) { na[k] = (u32x2){0u, 0u}; nb[k] = (u32x2){0u, 0u}; }
        ldx<true>(XR, (size_t)r0, lane, nv); ldx<true>(XR, (size_t)(r0 + 8), lane, nv2);
        if (moe) { ti = ((const int4*)(p.ws + OFF_TOK))[r0]; sl = ((const int2*)(p.ws + OFF_SLOT))[r0];
#pragma unroll
            for (int k = 0; k < 4; ++k) { na[k] = *(const u32x2*)(H + (size_t)sl.x * D + k * 256 + lane * 4); nb[k] = *(const u32x2*)(H + (size_t)sl.y * D + k * 256 + lane * 4); }
            ti2 = ((const int4*)(p.ws + OFF_TOK))[r0 + 8]; sl2 = ((const int2*)(p.ws + OFF_SLOT))[r0 + 8]; }
        else {
#pragma unroll
            for (int k = 0; k < 4; ++k) na[k] = *(const u32x2*)(H + (size_t)r0 * D + k * 256 + lane * 4); }
        for (int i = 0; i < 16; ++i) { const int row = r0 + i * 8;
            f32x4 v[4], f[4]; const float w0 = __int_as_float(ti.y), w1 = __int_as_float(ti.z);
#pragma unroll
            for (int k = 0; k < 4; ++k) { v[k] = cvx(nv[k]); nv[k] = nv2[k]; const f32x4 a = (f32x4){bflo(na[k].x), bfhi(na[k].x), bflo(na[k].y), bfhi(na[k].y)};
                if (moe) { const f32x4 c = (f32x4){bflo(nb[k].x), bfhi(nb[k].x), bflo(nb[k].y), bfhi(nb[k].y)}; f[k] = a * w0 + c * w1; } else f[k] = a; }
            if (i + 2 < 16) ldx<true>(XR, (size_t)(row + 16), lane, nv2);
            if (i + 1 < 16) { const int nx = row + 8;
                if (moe) { ti = ti2; sl = sl2;
#pragma unroll
                    for (int k = 0; k < 4; ++k) { na[k] = *(const u32x2*)(H + (size_t)sl.x * D + k * 256 + lane * 4); nb[k] = *(const u32x2*)(H + (size_t)sl.y * D + k * 256 + lane * 4); }
                    if (i + 2 < 16) { ti2 = ((const int4*)(p.ws + OFF_TOK))[nx + 8]; sl2 = ((const int2*)(p.ws + OFF_SLOT))[nx + 8]; } }
                else {
#pragma unroll
                    for (int k = 0; k < 4; ++k) na[k] = *(const u32x2*)(H + (size_t)nx * D + k * 256 + lane * 4); } }
#pragma unroll
            for (int k = 0; k < 4; ++k) v[k] = v[k] * ALPHA + g2[k] * f[k];
            layernorm_regs(v, lg2, lb2);
            if (layer + 1 < DEPTH) st_row_bf16(XR + (size_t)row * D, lane, v); else st_row_f32(p.out + (size_t)row * D, lane, v);
            if (layer + 1 < DEPTH) { f32x4 h[4]; modulate_regs(v, nsh, nsc, h); st_row_bf16(H + (size_t)row * D, lane, h); }
        }
    }
}
template <bool DRY = false> __device__ __forceinline__ void phase_prep(const Params& p, int layer, LAS unsigned char* lds) {
    const int tid = tid_fresh(p.wave), lane = tid & 63, wid = tid >> 6;
    LAS u16* z = (LAS u16*)(lds + 65536 + wid * 6400); LAS u16* qr = z + 2560;
    u16* Z = (u16*)(p.ws + OFF_RZ); u16* QR = (u16*)(p.ws + OFF_QROT);
    const float* CH = (const float*)(p.ws + OFF_COSH); const float* SH = (const float*)(p.ws + OFF_SINH); const float* CI = (const float*)(p.ws + OFF_COSI); const float* SI = (const float*)(p.ws + OFF_SINI);
    const int d = lane & 31, half = lane >> 5, e16 = lane & 15, hh = lane >> 4;
    const int stride = gridDim.x * 8; int row = blockIdx.x * 8 + wid;
    bool ldc[5], stc[5];
#pragma unroll
    for (int i = 0; i < 5; ++i) { const int ci = lane + 64 * i; ldc[i] = !((ci >= 48 && ci < 80) || (ci >= 96 && ci < 112) || (ci >= 128 && ci < 144) || ci >= 312); stc[i] = ldc[i] && ci >= 48 && ci < 296; }
    u32x4 pf[5]; float nch = 0.f, nsh = 0.f, nci = 0.f, nsi = 0.f;
    if (row < M) {
#pragma unroll
        for (int i = 0; i < 5; ++i) if (ldc[i]) pf[i] = *(const u32x4*)(Z + (size_t)row * ZP + (lane + 64 * i) * 8);
        nch = CH[(size_t)row * 32 + d]; nsh = SH[(size_t)row * 32 + d]; nci = CI[(size_t)row * 16 + e16]; nsi = SI[(size_t)row * 16 + e16]; }
    float sgg[4], sgb[4];
#pragma unroll
    for (int g = 0; g < 4; ++g) { sgg[g] = p.sgu_g[layer * 256 + g * 64 + lane]; sgb[g] = p.sgu_bn[layer * 256 + g * 64 + lane]; }
    for (; row < M; row += stride) {
#pragma unroll
        for (int i = 0; i < 5; ++i) *(LAS u32x4*)(z + (lane + 64 * i) * 8) = pf[i];
        const float ch = nch, sh = nsh, ci = nci, si = nsi;
        { const int nx = row + stride; if (nx < M) {
#pragma unroll
            for (int i = 0; i < 5; ++i) if (ldc[i]) pf[i] = *(const u32x4*)(Z + (size_t)nx * ZP + (lane + 64 * i) * 8);
            nch = CH[(size_t)nx * 32 + d]; nsh = SH[(size_t)nx * 32 + d]; nci = CI[(size_t)nx * 16 + e16]; nsi = SI[(size_t)nx * 16 + e16]; } }
        asm volatile("s_waitcnt lgkmcnt(0)" ::: "memory");
        float q1[3], q2[3], s1[2], s2[2], e1[3], e2[3], su[4], sv[4];
#pragma unroll
        for (int k = 0; k < 3; ++k) { const int h = half + 2 * k; q1[k] = bf2f(z[ZQ + h * 64 + d]); q2[k] = bf2f(z[ZQ + h * 64 + 32 + d]); e1[k] = bf2f(z[ZDQ + h * 64 + d]); e2[k] = bf2f(z[ZDQ + h * 64 + 32 + d]); }
#pragma unroll
        for (int k = 0; k < 2; ++k) { const LAS u16* q = z + ZKV + (2 + 2 * k) * 128 + half * 64; s1[k] = bf2f(q[d]); s2[k] = bf2f(q[32 + d]); }
        const float i1 = bf2f(z[ZIQ + hh * 32 + e16]), i2 = bf2f(z[ZIQ + hh * 32 + 16 + e16]), y1 = bf2f(z[ZIK + e16]), y2 = bf2f(z[ZIK + 16 + e16]);
        const float iwv = bf2f(z[ZIW + (lane & 3)]), gtv = bf2f(z[ZG + (lane < 18 ? lane : 17)]);
        const float c0 = bf2f(z[ZCKV + lane]), c1 = bf2f(z[ZCKV + 64 + lane]), kraw = bf2f(z[2368 + lane]), vraw = bf2f(z[2432 + lane]);
#pragma unroll
        for (int g = 0; g < 4; ++g) { su[g] = bf2f(z[ZSG + g * 64 + lane]); sv[g] = bf2f(z[ZSG + 256 + g * 64 + lane]); }
        asm volatile("s_waitcnt lgkmcnt(0)" ::: "memory");
#pragma unroll
        for (int k = 0; k < 3; ++k) { const int h = half + 2 * k;
            qr[h * 64 + d] = f2bf((q1[k] * ch - q2[k] * sh) * C2); qr[h * 64 + 32 + d] = f2bf((q2[k] * ch + q1[k] * sh) * C2);
            z[ZDQ + h * 64 + d] = f2bf((e1[k] * ch - e2[k] * sh) * C2); z[ZDQ + h * 64 + 32 + d] = f2bf((e2[k] * ch + e1[k] * sh) * C2); }
#pragma unroll
        for (int k = 0; k < 2; ++k) { LAS u16* q = z + ZKV + (2 + 2 * k) * 128 + half * 64; q[d] = f2bf(s1[k] * ch - s2[k] * sh); q[32 + d] = f2bf(s2[k] * ch + s1[k] * sh); }
        z[ZIQ + hh * 32 + e16] = f2bf(i1 * ci - i2 * si); z[ZIQ + hh * 32 + 16 + e16] = f2bf(i2 * ci + i1 * si);
        if (lane < 16) { z[ZIK + e16] = f2bf(y1 * ci - y2 * si); z[ZIK + 16 + e16] = f2bf(y2 * ci + y1 * si); }
        if (lane < 4) z[ZIW + lane] = f2bf(iwv * 0.5f);
        if (lane < 18) z[ZG + lane] = f2bf(1.f / (1.f + __expf(-gtv)));
        { const float ss = wave_sum(c0 * c0 + c1 * c1); const float r = rsqrtf(ss * (1.f / 128.f) + 1e-6f);
          const float ak = kraw * r, av = vraw * r;
          const float ko = SHFL_XOR(ak, 32); const float kr = half == 0 ? ak * ch - ko * sh : ak * ch + ko * sh;
          z[ZCKV + lane] = f2bf(kr); z[ZCKV + 64 + lane] = f2bf(av); }
        { float xg[4], mu[4], dx[4], var[4];
#pragma unroll
          for (int g = 0; g < 4; ++g) xg[g] = gelu_tanh(sv[g]);
#pragma unroll
          for (int g = 0; g < 4; ++g) mu[g] = wave_sum(xg[g]) * (1.f / 64.f);
#pragma unroll
          for (int g = 0; g < 4; ++g) { dx[g] = xg[g] - mu[g]; var[g] = wave_sum(dx[g] * dx[g]) * (1.f / 64.f); }
#pragma unroll
          for (int g = 0; g < 4; ++g) { z[ZSG + g * 64 + lane] = f2bf(gelu_tanh(su[g])); z[ZSG + 256 + g * 64 + lane] = f2bf(dx[g] * rsqrtf(var[g] + 1e-5f) * sgg[g] + sgb[g]); } }
        asm volatile("s_waitcnt lgkmcnt(0)" ::: "memory");
        { u32x4 w_[6];
#pragma unroll
          for (int i = 0; i < 5; ++i) w_[i] = *(const LAS u32x4*)(z + (lane + 64 * i) * 8);
          w_[5] = *(const LAS u32x4*)(qr + (lane < 48 ? lane : 47) * 8);
          asm volatile("s_waitcnt lgkmcnt(0)" ::: "memory");
#pragma unroll
          for (int i = 0; i < 5; ++i) { if (!DRY && stc[i]) *(u32x4*)(Z + (size_t)row * ZP + (lane + 64 * i) * 8) = w_[i]; else asm volatile("" :: "v"(w_[i])); }
          if (!DRY && lane < 48) *(u32x4*)(QR + (size_t)row * 384 + lane * 8) = w_[5]; else asm volatile("" :: "v"(w_[5])); }
        asm volatile("s_waitcnt lgkmcnt(0)" ::: "memory");
    }
    __syncthreads();
}

__device__ __forceinline__ void phase_compress(const Params& p, int layer, LAS unsigned char* lds) {
    const int tid = tid_fresh(p.wave), lane = tid & 63, wid = tid >> 6, fr = lane & 15, fq = lane >> 4;
    LAS float* part = (LAS float*)lds; LAS float* hid = (LAS float*)(lds + 32768);
    const u16* Z = (const u16*)(p.ws + OFF_RZ);
    for (int task = blockIdx.x; task < 8 * 2 * 2 * 16; task += gridDim.x) {
        const int nt = task & 15, j = (task >> 4) & 1, g = (task >> 5) & 1, b = task >> 6;
        const u16* W1 = (const u16*)(p.ws + OFF_CW1T) + (size_t)(layer * 2 + j) * 64 * 2048;
        const int n = nt * 16 + fr; const bool nvalid = n < 255;
        const u16* arow = Z + ((size_t)b * SEQ + (nvalid ? 16 * n : 0)) * ZP + ZKV + j * 128 + g * 64 + fq * 8;
        f32x4 acc[4];
#pragma unroll
        for (int c = 0; c < 4; ++c) acc[c] = (f32x4){0.f, 0.f, 0.f, 0.f};
        bf16x8 av[8], bv[8][4];
#pragma unroll
        for (int i = 0; i < 8; ++i) { const int st = wid * 8 + i, l = st >> 1, dd = (st & 1) * 32; av[i] = *(const bf16x8*)(arow + (size_t)l * ZP + dd);
#pragma unroll
            for (int c = 0; c < 4; ++c) bv[i][c] = *(const bf16x8*)(W1 + (size_t)(c * 16 + fr) * 2048 + st * 32 + fq * 8); }
#pragma unroll
        for (int i = 0; i < 8; ++i) { bf16x8 a = av[i]; if (!nvalid) a = (bf16x8){0, 0, 0, 0, 0, 0, 0, 0};
#pragma unroll
            for (int c = 0; c < 4; ++c) acc[c] = __builtin_amdgcn_mfma_f32_16x16x32_bf16(a, bv[i][c], acc[c], 0, 0, 0); }
#pragma unroll
        for (int c = 0; c < 4; ++c)
#pragma unroll
            for (int r = 0; r < 4; ++r) part[(wid * 16 + 4 * fq + r) * 64 + c * 16 + fr] = acc[c][r];
        __syncthreads();
        const float* cb = (const float*)(p.ws + OFF_CB1) + (layer * 2 + j) * 64;
#pragma unroll
        for (int k = 0; k < 2; ++k) { const int o = tid + k * NTHR, rw = o >> 6, e = o & 63; float sacc = 0.f;
#pragma unroll
            for (int w = 0; w < 8; ++w) sacc += part[(w * 16 + rw) * 64 + e];
            hid[rw * 65 + e] = gelu_tanh(sacc + cb[e]); }
        __syncthreads();
        { const float* w2 = p.cmp_w2 + (size_t)(layer * 2 + j) * 4096; const int rw = tid >> 5, f0 = 2 * (tid & 31); float o0 = 0.f, o1 = 0.f;
#pragma unroll 16
          for (int e = 0; e < 64; ++e) { const float hv = hid[rw * 65 + e]; const f32x2 w = *(const f32x2*)(w2 + e * 64 + f0); o0 = fmaf(hv, w.x, o0); o1 = fmaf(hv, w.y, o1); }
          const int nn = nt * 16 + rw; if (nn >= 255) { o0 = 0.f; o1 = 0.f; }
          if (j == 0) { u16* kc = (u16*)(p.ws + OFF_KC) + ((size_t)(b * 2 + g) * 256 + nn) * 64 + f0; *(unsigned*)kc = cvt_pk_bf16(o0, o1); }
          else { u16* vc = (u16*)(p.ws + OFF_VCT) + ((size_t)(b * 2 + g) * 64 + f0) * 256 + nn; vc[0] = f2bf(o0); vc[256] = f2bf(o1); } }
        __syncthreads();
    }
    __syncthreads();
}
__device__ __forceinline__ f32x16 mfma32(bf16x8 a, bf16x8 b, f32x16 c) { return __builtin_amdgcn_mfma_f32_32x32x16_bf16(a, b, c, 0, 0, 0); }
__device__ __forceinline__ bf16x8 pack8(const f32x16& p, int s) {
    u32x4 w; w.x = cvt_pk_bf16(p[8 * s + 0], p[8 * s + 1]); w.y = cvt_pk_bf16(p[8 * s + 2], p[8 * s + 3]); w.z = cvt_pk_bf16(p[8 * s + 4], p[8 * s + 5]); w.w = cvt_pk_bf16(p[8 * s + 6], p[8 * s + 7]);
    return __builtin_bit_cast(bf16x8, w); }
__device__ __forceinline__ void stage_o(LAS u16* stg, const f32x16 (&o)[2], float inv, int r32, int hi) {
#pragma unroll
    for (int db = 0; db < 2; ++db)
#pragma unroll
        for (int r = 0; r < 16; ++r) stg[r32 * 72 + db * 32 + crow(r, hi)] = f2bf(o[db][r] * inv);
    asm volatile("s_waitcnt lgkmcnt(0)" ::: "memory");
}

__device__ __forceinline__ void phase_cmpattn(const Params& p, int layer, LAS unsigned char* lds) {
    const int tid = tid_fresh(p.wave), lane = tid & 63, wid = tid >> 6, r32 = lane & 31, hi = lane >> 5;
    LAS u16* Kl = (LAS u16*)lds;
    LAS u16* Vl = (LAS u16*)(lds + 36864);
    LAS u16* stg = (LAS u16*)(lds + 36864 + 33792 + wid * 4608);
    const u16* Z = (const u16*)(p.ws + OFF_RZ); u16* OC = (u16*)(p.ws + OFF_OC);
    for (int c = blockIdx.x; c < 256; c += gridDim.x) { const int bg = c >> 4, b = bg >> 1, g = bg & 1; const int rr_ = p.wave < 4 ? p.wave : 11 - p.wave; const int qt = 16 * rr_ + (c & 15);
        { const u16* Kg = (const u16*)(p.ws + OFF_KC) + (size_t)bg * 256 * 64;
          __syncthreads();
#pragma unroll
          for (int i = 0; i < 4; ++i) { const int cc = tid + i * NTHR; const int rw = cc >> 3, ch = cc & 7; *(LAS u32x4*)(Kl + rw * 72 + ch * 8) = *(const u32x4*)(Kg + rw * 64 + ch * 8); }
          { const u16* Vg = (const u16*)(p.ws + OFF_VCT) + (size_t)bg * 64 * 256;
#pragma unroll
            for (int i = 0; i < 4; ++i) { const int cc = tid + i * NTHR; const int rw = cc >> 5, ch = cc & 31; *(LAS u32x4*)(Vl + rw * 264 + ch * 8) = *(const u32x4*)(Vg + rw * 256 + ch * 8); } }
          __syncthreads(); }
        const int t0 = qt * 32, t = t0 + r32; const size_t row = (size_t)b * SEQ + t;
        const int nmax = (t - 31) >> 4;
        const int kbl = qt >> 4, kfull = (2 * qt - 33) >> 5;
        float imps[32];
#pragma unroll
        for (int i = 0; i < 32; ++i) imps[i] = 0.f;
        for (int r = 0; r < 3; ++r) { const int h = 3 * g + r;
            { LAS bf16x8* qs = (LAS bf16x8*)stg;
#pragma unroll
              for (int d0 = 0; d0 < 4; ++d0) qs[d0 * 64 + lane] = *(const bf16x8*)(Z + row * ZP + ZQ + h * 64 + d0 * 16 + hi * 8); }
            float m = 0.f, l = 0.f, carry = 0.f; bool seen = false; f32x16 o[2]; o[0] = (f32x16){}; o[1] = (f32x16){}; float imp[32];
#pragma unroll
            for (int i = 0; i < 32; ++i) imp[i] = 0.f;
#pragma unroll
            for (int kb = 0; kb < 8; ++kb) { if (kb <= kbl) { f32x16 s = {};
#pragma unroll
                for (int d0 = 0; d0 < 4; ++d0) s = mfma32(*(const LAS bf16x8*)(Kl + (32 * kb + r32) * 72 + d0 * 16 + hi * 8), ((const LAS bf16x8*)stg)[d0 * 64 + lane], s);
                if (kb > kfull) {
#pragma unroll
                    for (int rr = 0; rr < 16; ++rr) { const int n = 32 * kb + crow(rr, hi); s[rr] = (n <= nmax) ? fmaf(s[rr], C2, -m) : -INFINITY; } }
                else {
#pragma unroll
                    for (int rr = 0; rr < 16; ++rr) s[rr] = fmaf(s[rr], C2, -m); }
                float mk = fmaxf(fmaxf(s[0], s[1]), s[2]);
#pragma unroll
                for (int rr = 3; rr < 15; rr += 2) mk = fmaxf(fmaxf(mk, s[rr]), s[rr + 1]);
                mk = fmaxf(mk, s[15]); mk = fmaxf(mk, SHFL_XOR(mk, 32));
                const bool mv = (mk > 8.f) | (!seen & (mk > -INFINITY));
                if (__any(mv)) { const float dl = mv ? mk : 0.f; m += dl; const float f = __builtin_amdgcn_exp2f(-dl); l *= f; carry *= f;
#pragma unroll
                    for (int rr = 0; rr < 16; ++rr) { s[rr] -= dl; o[0][rr] *= f; o[1][rr] *= f; }
#pragma unroll
                    for (int i = 0; i < 32; ++i) imp[i] *= f; }
                seen = seen | (mk > -INFINITY);
#pragma unroll
                for (int rr = 0; rr < 16; ++rr) s[rr] = __builtin_amdgcn_exp2f(s[rr]);
#pragma unroll
                for (int gq = 0; gq < 4; ++gq) { const float sum4 = (s[4 * gq] + s[4 * gq + 1]) + (s[4 * gq + 2] + s[4 * gq + 3]); const float ol = SHFL_XOR(s[4 * gq + 3], 32);
                    const float extra = hi ? ol : carry; carry = ol; l += sum4;
                    imp[4 * kb + gq] += sum4 + extra; }
#pragma unroll
                for (int ks = 0; ks < 2; ++ks) { const bf16x8 pb = pack8(s, ks);
#pragma unroll
                    for (int db = 0; db < 2; ++db) { const LAS u16* vp = Vl + (32 * db + r32) * 264 + 32 * kb + 16 * ks + 4 * hi; const s16x4 lo = *(const LAS s16x4*)vp, hh = *(const LAS s16x4*)(vp + 8);
                        const bf16x8 a = (bf16x8){lo[0], lo[1], lo[2], lo[3], hh[0], hh[1], hh[2], hh[3]};
                        o[db] = mfma32(a, pb, o[db]); } }
                } }
            l += SHFL_XOR(l, 32); const float inv = l > 0.f ? 1.f / l : 0.f;
#pragma unroll
            for (int i = 0; i < 32; ++i) imps[i] = fmaf(imp[i], inv, imps[i]);
            asm volatile("s_nop 15\n\ts_nop 7" : "+v"(o[0]), "+v"(o[1]));
            stage_o(stg, o, inv, r32, hi);
#pragma unroll
            for (int i = 0; i < 4; ++i) { const int rw = i * 8 + (lane >> 3), ch = lane & 7; const u32x4 v = *(const LAS u32x4*)(stg + rw * 72 + ch * 8);
                *(u32x4*)(OC + ((size_t)b * SEQ + t0 + rw) * 384 + h * 64 + ch * 8) = v; }
            asm volatile("s_waitcnt lgkmcnt(0)" ::: "memory");
        }
        { asm volatile("s_waitcnt lgkmcnt(0)" ::: "memory");
          const int cur = t >> 6; float k[32]; LAS float* tr = (LAS float*)stg;
#pragma unroll
          for (int hf = 0; hf < 2; ++hf) {
#pragma unroll
              for (int i = 0; i < 16; ++i) tr[r32 * 33 + 8 * (i >> 2) + 2 * (i & 3) + hi] = imps[16 * hf + i];
              asm volatile("s_waitcnt lgkmcnt(0)" ::: "memory");
#pragma unroll
              for (int i = 0; i < 32; ++i) { const float v = tr[r32 * 33 + i]; if (hf == 0) k[i] = v; else k[i] = hi ? v : k[i]; }
              asm volatile("s_waitcnt lgkmcnt(0)" ::: "memory"); }
#pragma unroll
          for (int i = 0; i < 32; ++i) { const int j = 32 * hi + i; const bool valid = j <= cur; const bool forced = (j == 0) | (j == cur) | (j == cur - 1);
              k[i] = valid ? k[i] + (forced ? 1e4f : 0.f) : -INFINITY; }
          unsigned long long msk = 0ull;
#pragma unroll 1
          for (int rd = 0; rd < 16; ++rd) { float best = k[0]; int bi = 0;
#pragma unroll
              for (int i = 1; i < 32; ++i) { const bool gt = k[i] > best; best = gt ? k[i] : best; bi = gt ? i : bi; }
              const float ob = SHFL_XOR(best, 32); const int obi = SHFL_XOR(bi, 32);
              const float v0 = hi ? ob : best, v1 = hi ? best : ob; const int i0 = hi ? obi : bi, i1 = hi ? bi : obi;
              const bool w0 = v0 >= v1; const float wv = w0 ? v0 : v1; const int wj = w0 ? i0 : 32 + i1;
              if (wv > -INFINITY) msk |= 1ull << wj;
              const bool mine = (w0 ? 0 : 1) == hi;
#pragma unroll
              for (int i = 0; i < 32; ++i) k[i] = (mine && i == bi) ? -INFINITY : k[i]; }
          if (hi == 0) ((unsigned long long*)(p.ws + OFF_BLK))[((size_t)b * SEQ + t) * 2 + g] = msk; }
        asm volatile("s_waitcnt lgkmcnt(0)" ::: "memory");
    }
    __syncthreads();
}
constexpr int AT_K = 0, AT_V = 24576, AT_M = 49152, AT_O = 55296, AT_Q = AT_O + 8 * 4608, AT_BYTES = AT_Q + 8 * 4096;
__device__ __forceinline__ float max3f(float a, float b, float c) { float r; asm("v_max3_f32 %0, %1, %2, %3" : "=v"(r) : "v"(a), "v"(b), "v"(c)); return r; }
__device__ __forceinline__ s16x4 vtr(const LAS unsigned char* q) { return __builtin_bit_cast(s16x4, __builtin_amdgcn_ds_read_tr16_b64_v4i16((LAS s16x4*)q)); }
typedef __bf16 bf16x2_t __attribute__((ext_vector_type(2)));
__device__ __forceinline__ unsigned cvtpk_c(float lo, float hi) { const f32x2 v = {lo, hi}; return __builtin_bit_cast(unsigned, __builtin_convertvector(v, bf16x2_t)); }
__device__ __forceinline__ float xor32_max(float v) { auto rr = __builtin_amdgcn_permlane32_swap(__float_as_uint(v), __float_as_uint(v), false, false); return fmaxf(__uint_as_float(rr[0]), __uint_as_float(rr[1])); }
__device__ __forceinline__ void glds16(const void* gsrc, unsigned lds_dst) { unsigned keep;
    asm volatile("s_mov_b32 %0, m0\n\ts_mov_b32 m0, %2\n\ts_nop 0\n\tglobal_load_lds_dwordx4 %1, off\n\ts_mov_b32 m0, %0" : "=&s"(keep) : "v"(gsrc), "s"(lds_dst) : "memory"); }
__device__ __forceinline__ void glds4(const void* gsrc, unsigned lds_dst) { unsigned keep;
    asm volatile("s_mov_b32 %0, m0\n\ts_mov_b32 m0, %2\n\ts_nop 0\n\tglobal_load_lds_dword %1, off\n\ts_mov_b32 m0, %0" : "=&s"(keep) : "v"(gsrc), "s"(lds_dst) : "memory"); }
struct AttnArgs { const u16* Q; int qp, qc; const u16* K; int kp, kc; const u16* V; int vp, vc; u16* O; int op, oc; };
#define SBAR() __builtin_amdgcn_sched_barrier(0)
template <int MODE> __device__ __forceinline__ void attn_unit(const Params& p, const AttnArgs& A, int b, int h, int g, int qb, LAS unsigned char* lds) {
    const int tid = tid_fresh(p.wave), lane = tid & 63, wid = tid >> 6, r32 = lane & 31, hi = lane >> 5; const int wu = p.wave;
    const int q0 = qb * 256, t = q0 + wid * 32 + r32; const size_t row = (size_t)b * SEQ + t;
    const int H1 = 4 * qb + 3, H0 = (MODE == 3) ? (4 * qb - 8 > 0 ? 4 * qb - 8 : 0) : 0;
    const u16* kg = A.K + ((size_t)b * SEQ + lane) * A.kp + A.kc + wu * 8; const u16* vg = A.V + ((size_t)b * SEQ + 16 * (wu & 3) + (lane >> 2)) * A.vp + A.vc + (wu >> 2) * 32 + (lane & 3) * 8;
    const unsigned* mg = (const unsigned*)(p.ws + OFF_MASKW) + ((size_t)b * SEQ + q0 + wu * 32 + (lane >> 1)) * 128 + (lane & 1);
    const unsigned ldsb = (unsigned)(uintptr_t)lds;
#define AT_CL(x) (((x) <= H1) ? (x) : H1)
#define AT_DMA_K(hh, so) glds16(kg + (size_t)AT_CL(hh) * 64 * A.kp, (unsigned)__builtin_amdgcn_readfirstlane(ldsb + AT_K + (so) + wu * 1024))
#define AT_DMA_V(hh, so) glds16(vg + (size_t)AT_CL(hh) * 64 * A.vp, (unsigned)__builtin_amdgcn_readfirstlane(ldsb + AT_V + (so) + wu * 1024))
#define AT_DMA_M(hh, so) do { if (MODE == 2) glds4(mg + 2 * AT_CL(hh), (unsigned)__builtin_amdgcn_readfirstlane(ldsb + AT_M + ((so) >> 2) + wu * 256)); } while (0)
#define AT_WAIT_BAR(N) asm volatile("s_waitcnt vmcnt(" #N ") lgkmcnt(0)\n\ts_barrier" ::: "memory")
#define AT_WAIT_STEP() do { if (MODE == 2) AT_WAIT_BAR(3); else AT_WAIT_BAR(2); } while (0)
    AT_DMA_K(H0, 0); AT_DMA_V(H0, 0); AT_DMA_K(H0 + 1, 8192); AT_DMA_M(H0, 0); AT_DMA_M(H0 + 1, 8192);
    bf16x8 qr[4];
#pragma unroll
    for (int d0 = 0; d0 < 4; ++d0) qr[d0] = *(const bf16x8*)(A.Q + row * A.qp + A.qc + h * 64 + d0 * 16 + hi * 8);
    LAS u16* Qs = (LAS u16*)(lds + AT_Q) + (wid * 256 + lane) * 8;
    if (MODE == 2) {
#pragma unroll
        for (int d0 = 0; d0 < 4; ++d0) *(LAS bf16x8*)(Qs + d0 * 512) = qr[d0]; }
#define AT_QR(j) ((MODE == 2) ? *(const LAS bf16x8*)(Qs + (j) * 512) : qr[j])
    unsigned long long bmask = 0ull; if (MODE == 1) bmask = ((const unsigned long long*)(p.ws + OFF_BLK))[row * 2 + g];
    AT_DMA_K(H0 + 2, 16384);
    const LAS unsigned char* kp0 = lds + AT_K + hi * 1024 + r32 * 16; const LAS unsigned char* vp0 = lds + AT_V + ((lane >> 4) & 1) * 32 + (lane & 3) * 8 + (4 * hi + ((lane & 15) >> 2)) * 64;
    const LAS unsigned char* mp0 = lds + AT_M + wid * 256 + r32 * 8;
    float m = 0.f, l = 0.f; f32x16 o[2], negm; { float z = 0.f; asm volatile("" : "+v"(z));
#pragma unroll
      for (int r = 0; r < 16; ++r) { o[0][r] = z; o[1][r] = z; negm[r] = z; } }
    asm volatile("" : "+v"(negm));
    f32x16 pA0, pA1, pB0, pB1; bf16x8 kf[8]; bool seen = false; bool resc = false; float fsc = 1.f;
    int sl_prev = 0, sl_cur = 0, sl_next = 8192;
#define AT_ROT() do { sl_prev = sl_cur; sl_cur = sl_next; sl_next = (sl_next == 16384) ? 0 : sl_next + 8192; } while (0)
#define AT_KV(sb_, r_) (64 * tt_ + 32 * (sb_) + 4 * hi + ((r_) & 3) + 8 * ((r_) >> 2))
#define AT_CMASK(C0, C1, tt, DG, LW) do { const int tt_ = (tt); \
        if (DG) { _Pragma("unroll") for (int r = 0; r < 16; ++r) { C0[r] = (AT_KV(0, r) > t) ? -INFINITY : C0[r]; C1[r] = (AT_KV(1, r) > t) ? -INFINITY : C1[r]; } } \
        if (LW) { _Pragma("unroll") for (int r = 0; r < 16; ++r) { C0[r] = (AT_KV(0, r) <= t - 512) ? -INFINITY : C0[r]; C1[r] = (AT_KV(1, r) <= t - 512) ? -INFINITY : C1[r]; } } } while (0)
#define AT_EXM(X, B, WW) do { _Pragma("unroll") for (int j_ = 0; j_ < 4; ++j_) { const float e_ = __builtin_amdgcn_exp2f(X[(B) + j_]); \
            X[(B) + j_] = (MODE == 2) ? __int_as_float(__float_as_int(e_) & __builtin_amdgcn_sbfe((int)(WW), (((B) + j_) & 3) + 8 * (((B) + j_) >> 2) + 4 * hi, 1)) : e_; } } while (0)
    AT_WAIT_BAR(0);
    { const LAS unsigned char* kb_ = kp0;
#pragma unroll
      for (int d0 = 0; d0 < 4; ++d0) { const bf16x8 b0 = *(const LAS bf16x8*)(kb_ + d0 * 2048), b1 = *(const LAS bf16x8*)(kb_ + d0 * 2048 + 512);
          if (d0 == 0) { pA0 = mfma32(b0, qr[0], negm); pA1 = mfma32(b1, qr[0], negm); } else { pA0 = mfma32(b0, qr[d0], pA0); pA1 = mfma32(b1, qr[d0], pA1); } }
      asm volatile("s_nop 15\n\ts_nop 7" : "+v"(pA0), "+v"(pA1));
      AT_CMASK(pA0, pA1, H0, true, (MODE == 3));
      float a = max3f(pA0[0], pA0[1], pA1[0]), bb = max3f(pA0[2], pA0[3], pA1[1]); a = max3f(a, pA1[2], pA1[3]);
#pragma unroll
      for (int r = 4; r < 16; r += 4) { a = max3f(a, pA0[r], pA0[r + 1]); bb = max3f(bb, pA0[r + 2], pA0[r + 3]); a = max3f(a, pA1[r], pA1[r + 1]); bb = max3f(bb, pA1[r + 2], pA1[r + 3]); }
      const float rm = xor32_max(fmaxf(a, bb)); seen = rm > -INFINITY; const float dl = seen ? rm : 0.f; m = dl;
#pragma unroll
      for (int r = 0; r < 16; ++r) { pA0[r] -= dl; pA1[r] -= dl; negm[r] = -m; }
      asm volatile("" : "+v"(negm));
      u32x2 mwv = (u32x2){0u, 0u}; if (MODE == 2) mwv = *(const LAS u32x2*)(mp0);
      AT_EXM(pA0, 0, mwv.x); AT_EXM(pA0, 4, mwv.x); AT_EXM(pA0, 8, mwv.x); AT_EXM(pA0, 12, mwv.x); AT_EXM(pA1, 0, mwv.y); AT_EXM(pA1, 4, mwv.y); AT_EXM(pA1, 8, mwv.y); AT_EXM(pA1, 12, mwv.y); }
    AT_WAIT_BAR(0);
    AT_DMA_K(H0 + 3, 0); AT_DMA_V(H0 + 1, 8192); AT_DMA_M(H0 + 2, 16384);
    AT_ROT();
#pragma unroll
    for (int j = 0; j < 4; ++j) { kf[2 * j] = *(const LAS bf16x8*)(kp0 + sl_cur + j * 2048); kf[2 * j + 1] = *(const LAS bf16x8*)(kp0 + sl_cur + j * 2048 + 512); }
    AT_WAIT_STEP();
    s16x4 vlo[8], vhi[8]; u32x4 pw0, pw1, pw2, pw3;
#define PKW(P, B) (cvtpk_c(P[B], P[(B) + 1]) & km)
#define PAF(k) __builtin_bit_cast(bf16x8, pw##k)
#define VFR(i) (bf16x8){vlo[i][0], vlo[i][1], vlo[i][2], vlo[i][3], vhi[i][0], vhi[i][1], vhi[i][2], vhi[i][3]}
#define PIN(x) asm volatile("" : "+v"(x))
#define GAPA(MF, A0, A1, A2, A3, W0, W1, PW) do { MF; sacc += A0; sacc += A1; sacc += A2; sacc += A3; PIN(sacc); W0; W1; PIN(PW); SBAR(); } while (0)
#define GAPB(MF, X, B, WW) do { MF; AT_EXM(X, B, WW); PIN(X); SBAR(); } while (0)
#define VRD(i) do { vlo[i] = vtr(vp_ + (((i) >> 2) * 4096 + ((i) & 3) * 1024)); vhi[i] = vtr(vp_ + (((i) >> 2) * 4096 + ((i) & 3) * 1024 + 512)); } while (0)
#define KRD(j) do { kf[2 * (j)] = *(const LAS bf16x8*)(kp0 + sl_next + (j) * 2048); kf[2 * (j) + 1] = *(const LAS bf16x8*)(kp0 + sl_next + (j) * 2048 + 512); SBAR(); } while (0)
#define AT_STEP(C0, C1, P0, P1, DG, LW) do { SBAR(); \
    const LAS unsigned char* vp_ = vp0 + sl_prev; \
    const bool sel = (MODE != 1) || (((bmask >> (tq - 1)) & 1ull) != 0ull); const unsigned km = sel ? 0xffffffffu : 0u;     \
    VRD(0); SBAR(); float sacc = (P0[0] + P0[1]); \
    GAPA(C0 = mfma32(kf[0], AT_QR(0), negm), P0[2], P0[3], P0[4], P0[5],     pw0[0] = PKW(P0, 0), pw0[1] = PKW(P0, 2), pw0); \
    VRD(4); SBAR(); GAPA(C1 = mfma32(kf[1], AT_QR(0), negm), P0[6], P0[7], P0[8], P0[9],     pw0[2] = PKW(P0, 4), pw0[3] = PKW(P0, 6), pw0); \
    VRD(1); SBAR(); GAPA(C0 = mfma32(kf[2], AT_QR(1), C0),   P0[10], P0[11], P0[12], P0[13], pw1[0] = PKW(P0, 8), pw1[1] = PKW(P0, 10), pw1); \
    VRD(5); SBAR(); GAPA(C1 = mfma32(kf[3], AT_QR(1), C1),   P0[14], P0[15], P1[0], P1[1],   pw1[2] = PKW(P0, 12), pw1[3] = PKW(P0, 14), pw1); \
    VRD(2); SBAR(); GAPA(C0 = mfma32(kf[4], AT_QR(2), C0),   P1[2], P1[3], P1[4], P1[5],     pw2[0] = PKW(P1, 0), pw2[1] = PKW(P1, 2), pw2); \
    VRD(6); SBAR(); GAPA(C1 = mfma32(kf[5], AT_QR(2), C1),   P1[6], P1[7], P1[8], P1[9],     pw2[2] = PKW(P1, 4), pw2[3] = PKW(P1, 6), pw2); \
    VRD(3); SBAR(); GAPA(C0 = mfma32(kf[6], AT_QR(3), C0),   P1[10], P1[11], P1[12], P1[13], pw3[0] = PKW(P1, 8), pw3[1] = PKW(P1, 10), pw3); \
    VRD(7); SBAR(); GAPA(C1 = mfma32(kf[7], AT_QR(3), C1),   P1[14], P1[15], 0.f, 0.f,       pw3[2] = PKW(P1, 12), pw3[3] = PKW(P1, 14), pw3); \
    l += sel ? sacc : 0.f; \
    AT_DMA_K(tq + 3, sl_cur); AT_DMA_V(tq + 1, sl_next); AT_DMA_M(tq + 2, sl_prev); \
    AT_CMASK(C0, C1, tq, DG, LW); \
    u32x2 mwv = (u32x2){0u, 0u}; if (MODE == 2) mwv = *(const LAS u32x2*)(mp0 + (sl_cur >> 2)); \
    { float a = fmaxf(fmaxf(C0[0], C0[1]), C1[0]), bb = fmaxf(fmaxf(C0[2], C0[3]), C1[1]); a = fmaxf(fmaxf(a, C1[2]), C1[3]); \
      _Pragma("unroll") for (int r = 4; r < 16; r += 4) { a = fmaxf(fmaxf(a, C0[r]), C0[r + 1]); bb = fmaxf(fmaxf(bb, C0[r + 2]), C0[r + 3]); a = fmaxf(fmaxf(a, C1[r]), C1[r + 1]); bb = fmaxf(fmaxf(bb, C1[r + 2]), C1[r + 3]); } \
      const float rm = xor32_max(fmaxf(a, bb)); \
      resc = false; const bool mv = (rm > 8.f) | (!seen & (rm > -INFINITY)); \
      if (__builtin_expect(__any(mv), 0)) { const float dl = mv ? rm : 0.f; m += dl; \
        _Pragma("unroll") for (int r = 0; r < 16; ++r) { C0[r] -= dl; C1[r] -= dl; } \
        _Pragma("unroll") for (int r = 0; r < 16; ++r) negm[r] = -m; asm volatile("" : "+v"(negm)); \
        fsc = __builtin_amdgcn_exp2f(-dl); l *= fsc; resc = true; } \
      seen = seen | (rm > -INFINITY); } \
    SBAR(); \
    GAPB(o[0] = mfma32(VFR(0), PAF(0), o[0]), C0, 0, mwv.x); \
    GAPB(o[1] = mfma32(VFR(4), PAF(0), o[1]), C0, 4, mwv.x); \
    KRD(0); GAPB(o[0] = mfma32(VFR(1), PAF(1), o[0]), C0, 8, mwv.x); \
    KRD(1); GAPB(o[1] = mfma32(VFR(5), PAF(1), o[1]), C0, 12, mwv.x); \
    KRD(2); GAPB(o[0] = mfma32(VFR(2), PAF(2), o[0]), C1, 0, mwv.y); \
    KRD(3); GAPB(o[1] = mfma32(VFR(6), PAF(2), o[1]), C1, 4, mwv.y); \
    GAPB(o[0] = mfma32(VFR(3), PAF(3), o[0]), C1, 8, mwv.y); \
    GAPB(o[1] = mfma32(VFR(7), PAF(3), o[1]), C1, 12, mwv.y); \
    AT_WAIT_STEP(); \
    if (resc) { _Pragma("unroll") for (int r = 0; r < 16; ++r) { o[0][r] *= fsc; o[1][r] *= fsc; } }        \
    AT_ROT(); ++tq; } while (0)
    int tq = H0 + 1;
    { const int npair = (H1 - H0 - 1) >> 1; const int ndiag = npair < 2 ? npair : 2; const int nlow = (MODE == 3 && qb >= 2) ? 2 : 0; const int nplain = npair - ndiag - nlow;
      if (MODE == 3) for (int i = 0; i < nlow; ++i) { AT_STEP(pB0, pB1, pA0, pA1, false, true); AT_STEP(pA0, pA1, pB0, pB1, false, true); }
      for (int i = 0; i < nplain; ++i) { AT_STEP(pB0, pB1, pA0, pA1, false, false); AT_STEP(pA0, pA1, pB0, pB1, false, false); }
      for (int i = 0; i < ndiag; ++i) { AT_STEP(pB0, pB1, pA0, pA1, true, false); AT_STEP(pA0, pA1, pB0, pB1, true, false); } }
    AT_STEP(pB0, pB1, pA0, pA1, true, false);
    { const bool sel = (MODE != 1) || (((bmask >> H1) & 1ull) != 0ull); const unsigned km = sel ? 0xffffffffu : 0u;
      float sacc = pB0[0] + pB0[1];
#pragma unroll
      for (int r = 2; r < 16; ++r) sacc += pB0[r];
#pragma unroll
      for (int r = 0; r < 16; ++r) sacc += pB1[r];
      l += sel ? sacc : 0.f;
      pw0 = (u32x4){PKW(pB0, 0), PKW(pB0, 2), PKW(pB0, 4), PKW(pB0, 6)}; pw1 = (u32x4){PKW(pB0, 8), PKW(pB0, 10), PKW(pB0, 12), PKW(pB0, 14)};
      pw2 = (u32x4){PKW(pB1, 0), PKW(pB1, 2), PKW(pB1, 4), PKW(pB1, 6)}; pw3 = (u32x4){PKW(pB1, 8), PKW(pB1, 10), PKW(pB1, 12), PKW(pB1, 14)};
      const LAS unsigned char* vp_ = vp0 + sl_prev;
#pragma unroll
      for (int i = 0; i < 8; ++i) VRD(i);
      o[0] = mfma32(VFR(0), PAF(0), o[0]); o[1] = mfma32(VFR(4), PAF(0), o[1]); o[0] = mfma32(VFR(1), PAF(1), o[0]); o[1] = mfma32(VFR(5), PAF(1), o[1]);
      o[0] = mfma32(VFR(2), PAF(2), o[0]); o[1] = mfma32(VFR(6), PAF(2), o[1]); o[0] = mfma32(VFR(3), PAF(3), o[0]); o[1] = mfma32(VFR(7), PAF(3), o[1]); }
    l += SHFL_XOR(l, 32);
    asm volatile("s_nop 15\n\ts_nop 7" : "+v"(o[0]), "+v"(o[1]));
#undef AT_STEP
#undef KRD
#undef VRD
#undef GAPB
#undef GAPA
#undef PIN
#undef VFR
#undef PAF
#undef PKW
#undef AT_EXM
#undef AT_CMASK
#undef AT_KV
#undef AT_ROT
#undef AT_WAIT_STEP
#undef AT_WAIT_BAR
#undef AT_DMA_K
#undef AT_DMA_V
#undef AT_DMA_M
#undef AT_CL
#undef AT_QR
    const float inv = l > 0.f ? 1.f / l : 0.f;
    LAS u16* stg = (LAS u16*)(lds + AT_O + wid * 4608);
    stage_o(stg, o, inv, r32, hi);
#pragma unroll
    for (int i = 0; i < 4; ++i) { const int rw = i * 8 + (lane >> 3), ch = lane & 7; u32x4 v = *(const LAS u32x4*)(stg + rw * 72 + ch * 8);
        const size_t orow = (size_t)b * SEQ + q0 + wid * 32 + rw;
        if (MODE == 1) {
            const u16* zg = (const u16*)(p.ws + OFF_RZ) + orow * ZP + ZG + h * 3; const float g0 = bf2f(zg[0]), g1 = bf2f(zg[1]), g2 = bf2f(zg[2]);
            const u32x4 c = *(const u32x4*)((const u16*)(p.ws + OFF_OC) + orow * 384 + h * 64 + ch * 8), w = *(const u32x4*)((const u16*)(p.ws + OFF_OW) + orow * 384 + h * 64 + ch * 8);
            u32x4 r;
#define CMB(F) r.F = cvt_pk_bf16(g0 * bflo(c.F) + g1 * bflo(v.F) + g2 * bflo(w.F), g0 * bfhi(c.F) + g1 * bfhi(v.F) + g2 * bfhi(w.F))
            CMB(x); CMB(y); CMB(z); CMB(w);
#undef CMB
            v = r; }
        *(u32x4*)(A.O + orow * A.op + A.oc + h * 64 + ch * 8) = v; }
    asm volatile("s_waitcnt lgkmcnt(0)" ::: "memory");
    __syncthreads();
}
constexpr int DS_HP = 260;
constexpr int DS_HIST = 0, DS_PREF = 32 * 260 * 4, DS_KREM = DS_PREF + 128, DS_THR = DS_KREM + 128, DS_NTK = DS_THR + 128, DS_PART = DS_NTK + 128, DS_ANY = DS_PART + 128, DS_TCNT = DS_ANY + 128, DS_LCNT = DS_TCNT + 32 * 128 * 4, DS_LU = DS_LCNT + 128, DS_LK = DS_LU + 32 * 64 * 4, DS_MWL = DS_LK + 32 * 64 * 4, DS_ZW = DS_MWL + 32 * 128 * 4, DS_HIST2 = DS_ZW + 32 * 128 * 4, DS_BYTES = DS_HIST2 + 32 * 260 * 4;
__device__ __forceinline__ unsigned ordkey(float f) { const int u = __float_as_int(f); return (unsigned)(u ^ ((u >> 31) | (int)0x80000000)); }
struct IdxQ { bf16x8 bq[4][2]; float w[4]; };
__device__ __forceinline__ void idx_scores(const bf16x8 ka0, const bf16x8 ka1, const IdxQ& Q, unsigned (&u)[16]) {
    float I[16];
#pragma unroll
    for (int r = 0; r < 16; ++r) I[r] = 0.f;
    f32x16 sa = {}, sb = {};
    sa = mfma32(ka0, Q.bq[0][0], sa); sa = mfma32(ka1, Q.bq[0][1], sa);
#pragma unroll
    for (int h = 0; h < 4; ++h) {
        if (h < 3) { sb = (f32x16){}; sb = mfma32(ka0, Q.bq[h + 1][0], sb); sb = mfma32(ka1, Q.bq[h + 1][1], sb); }
        __builtin_amdgcn_sched_barrier(0);
#pragma unroll
        for (int r = 0; r < 16; ++r) I[r] = fmaf(Q.w[h], fmaxf(sa[r], 0.f), I[r]);
#pragma unroll
        for (int r = 0; r < 16; ++r) asm volatile("" : "+v"(I[r]));
        __builtin_amdgcn_sched_barrier(0);
        sa = sb; }
#pragma unroll
    for (int r = 0; r < 16; ++r) u[r] = ordkey(I[r]);
}
__device__ __forceinline__ unsigned lowbits(unsigned w, unsigned k) {
    if (k >= (unsigned)__popc(w)) return w;
    unsigned lo = 0u, hi = 32u;
#pragma unroll
    for (int it = 0; it < 6; ++it) { const unsigned mid = (lo + hi) >> 1; const unsigned msk = mid >= 32u ? 0xffffffffu : ((1u << mid) - 1u); if ((unsigned)__popc(w & msk) >= k) hi = mid; else lo = mid + 1u; }
    return w & (hi >= 32u ? 0xffffffffu : ((1u << hi) - 1u));
}
__device__ __forceinline__ void dsa_select_task(const Params& p, int b, int qt, LAS unsigned char* lds) {
    const int tid = tid_fresh(p.wave), lane = tid & 63, wid = tid >> 6, r32 = lane & 31, hi = lane >> 5;
    LAS unsigned* hist = (LAS unsigned*)(lds + DS_HIST); LAS unsigned* pref = (LAS unsigned*)(lds + DS_PREF); LAS unsigned* krem = (LAS unsigned*)(lds + DS_KREM);
    LAS unsigned* thrv = (LAS unsigned*)(lds + DS_THR); LAS unsigned* ntk = (LAS unsigned*)(lds + DS_NTK); LAS unsigned* part = (LAS unsigned*)(lds + DS_PART); LAS unsigned* anyp = (LAS unsigned*)(lds + DS_ANY);
    LAS unsigned* tcnt = (LAS unsigned*)(lds + DS_TCNT);
    const u16* Z = (const u16*)(p.ws + OFF_RZ);
    const int t0 = qt * 32, t = t0 + r32, ntile = qt + 1; const size_t row = (size_t)b * SEQ + t;
    const u16* kbase = Z + ((size_t)b * SEQ + r32) * ZP + ZIK + hi * 8; bf16x8 na0, na1;
#define DS_KLOAD0() do { const int k0_ = wid < ntile ? wid : 0; const u16* kp_ = kbase + (size_t)k0_ * 32 * ZP; na0 = *(const bf16x8*)kp_; na1 = *(const bf16x8*)(kp_ + 16); } while (0)
    IdxQ Q;
#pragma unroll
    for (int h = 0; h < 4; ++h) { Q.bq[h][0] = *(const bf16x8*)(Z + row * ZP + ZIQ + h * 32 + hi * 8); Q.bq[h][1] = *(const bf16x8*)(Z + row * ZP + ZIQ + h * 32 + 16 + hi * 8); Q.w[h] = bf2f(Z[row * ZP + ZIW + h]); }
    if (tid < 32) { pref[tid] = 0u; krem[tid] = 256u; }
    if (tid == 0) anyp[0] = 0u;
#define DS_DPPADD(v, ctrl) ((v) + (unsigned)__builtin_amdgcn_update_dpp(0, (int)(v), (ctrl), 0xF, 0xF, true))
#define DS_RADIX(PLO, PHI) _Pragma("unroll 1") \
    for (int pass = (PLO); pass < (PHI); ++pass) { const int shift = 24 - 8 * pass; \
        for (int i = tid; i < 32 * DS_HP / 4; i += NTHR) { ((LAS u32x4*)hist)[i] = (u32x4){0u, 0u, 0u, 0u}; ((LAS u32x4*)(hist + (DS_HIST2 - DS_HIST) / 4))[i] = (u32x4){0u, 0u, 0u, 0u}; } \
        __syncthreads(); \
        const unsigned mypref = pref[r32]; \
        DS_KLOAD0(); \
        _Pragma("unroll 1") \
        for (int kt = wid; kt < ntile; kt += 8) { unsigned u[16]; const bf16x8 ka0 = na0, ka1 = na1; { const int kn = (kt + 8 < ntile) ? kt + 8 : kt; const u16* kp = kbase + (size_t)kn * 32 * ZP; na0 = *(const bf16x8*)kp; na1 = *(const bf16x8*)(kp + 16); } idx_scores(ka0, ka1, Q, u); \
            const unsigned px = pass == 0 ? 0u : (mypref << 8); LAS unsigned* hrow = hist + hi * ((DS_HIST2 - DS_HIST) / 4) + r32 * DS_HP; \
            if (kt < qt) { \
        _Pragma("unroll") \
                for (int r = 0; r < 16; ++r) { const unsigned y = (u[r] >> shift) ^ px; if (y < 256u) __hip_atomic_fetch_add(hrow + y, 1u, __ATOMIC_RELAXED, __HIP_MEMORY_SCOPE_WORKGROUP); }        \
            } else { \
        _Pragma("unroll") \
                for (int r = 0; r < 16; ++r) { const bool valid = (32 * kt + crow(r, hi)) <= t; const unsigned y = (u[r] >> shift) ^ px; if (valid && y < 256u) __hip_atomic_fetch_add(hrow + y, 1u, __ATOMIC_RELAXED, __HIP_MEMORY_SCOPE_WORKGROUP); } } } \
        __syncthreads(); \
        {   \
          const int sq = lane >> 4, sj = lane & 15, q = wid * 4 + sq; const unsigned need = krem[q]; \
          const LAS unsigned* hr = hist + q * DS_HP + 4 * sj; const LAS unsigned* hr2 = hr + (DS_HIST2 - DS_HIST) / 4; \
          u32x4 c4[4]; unsigned s4[4], S4[4], T4[4]; \
          _Pragma("unroll") for (int i = 0; i < 4; ++i) { c4[i] = *(const LAS u32x4*)(hr + 64 * i) + *(const LAS u32x4*)(hr2 + 64 * i); s4[i] = (c4[i].x + c4[i].y) + (c4[i].z + c4[i].w); \
              unsigned v = s4[i]; v = DS_DPPADD(v, 0x101); v = DS_DPPADD(v, 0x102); v = DS_DPPADD(v, 0x104); v = DS_DPPADD(v, 0x108); S4[i] = v;        \
              unsigned w = s4[i]; w = DS_DPPADD(w, 0x128); w = DS_DPPADD(w, 0x124); w = DS_DPPADD(w, 0x122); w = DS_DPPADD(w, 0x121); T4[i] = w; }     \
          const unsigned A3 = 0u, A2 = T4[3], A1 = A2 + T4[2], A0 = A1 + T4[1]; \
          const unsigned b3 = A3 + S4[3] - s4[3], b2 = A2 + S4[2] - s4[2], b1 = A1 + S4[1] - s4[1], b0 = A0 + S4[0] - s4[0]; \
          const bool f3 = (b3 < need) && (need <= b3 + s4[3]), f2 = (b2 < need) && (need <= b2 + s4[2]), f1 = (b1 < need) && (need <= b1 + s4[1]), f0 = (b0 < need) && (need <= b0 + s4[0]); \
          const bool found = f3 | f2 | f1 | f0; const int fi = f3 ? 3 : (f2 ? 2 : (f1 ? 1 : 0)); const unsigned sufx = f3 ? b3 : (f2 ? b2 : (f1 ? b1 : b0)); \
          const u32x4 cc = f3 ? c4[3] : (f2 ? c4[2] : (f1 ? c4[1] : c4[0])); \
          const unsigned a3 = sufx, a2 = a3 + cc.w, a1 = a2 + cc.z, a0 = a1 + cc.y; const bool t3 = a3 + cc.w >= need, t2 = a2 + cc.z >= need, t1 = a1 + cc.y >= need; \
          unsigned digit = 64 * fi + 4 * sj + (t3 ? 3 : (t2 ? 2 : (t1 ? 1 : 0))), above = t3 ? a3 : (t2 ? a2 : (t1 ? a1 : a0)), cd = t3 ? cc.w : (t2 ? cc.z : (t1 ? cc.y : cc.x)); \
          const unsigned long long bm = __ballot(found); const unsigned seg = (unsigned)(bm >> (16 * sq)) & 0xffffu; const bool any = seg != 0u; const int src = 16 * sq + (any ? __builtin_ctz(seg) : 0); \
          { const unsigned d_ = SHFL_IDX(digit, src), a_ = SHFL_IDX(above, src), c_ = SHFL_IDX(cd, src); digit = any ? d_ : 0u; above = any ? a_ : 0u; cd = any ? c_ : 0u; } \
          if (sj == 0) { pref[q] = (pass == 0 ? 0u : (pref[q] << 8)) | digit; krem[q] = need - above; if (pass == 3) { const int tq = t0 + q; const bool all = tq < 256; \
                    thrv[q] = all ? 0u : ((pref[q])); ntk[q] = need - above; const unsigned pt = (!all && cd > need - above) ? 1u : 0u; part[q] = pt; if (pt) anyp[0] = 1u; } } \
        } \
        __syncthreads(); \
    }
    DS_RADIX(0, 2);
    LAS unsigned* lcnt = (LAS unsigned*)(lds + DS_LCNT); LAS unsigned* lu = (LAS unsigned*)(lds + DS_LU); LAS unsigned* lk = (LAS unsigned*)(lds + DS_LK); LAS unsigned* mwl = (LAS unsigned*)(lds + DS_MWL); LAS unsigned* zwl = (LAS unsigned*)(lds + DS_ZW);
    if (tid < 32) lcnt[tid] = 0u;
    __syncthreads();
    { const unsigned p16 = pref[r32]; const bool all = t < 256;
      DS_KLOAD0();
#pragma unroll 1
      for (int kt = wid; kt < ntile; kt += 8) { unsigned u[16]; const bf16x8 ka0 = na0, ka1 = na1; { const int kn = (kt + 8 < ntile) ? kt + 8 : kt; const u16* kp = kbase + (size_t)kn * 32 * ZP; na0 = *(const bf16x8*)kp; na1 = *(const bf16x8*)(kp + 16); } idx_scores(ka0, ka1, Q, u);
          unsigned bits = 0u, zb = 0u;
#pragma unroll
          for (int r = 0; r < 16; ++r) { const int ps = crow(r, hi); const bool valid = (kt < qt) || ((32 * kt + ps) <= t); const unsigned y = u[r] >> 16;
              if (valid && (all || y > p16)) bits |= 1u << ps;
              const bool und = valid && !all && y == p16;
              if (und && u[r] == 0x80000000u) zb |= 1u << ps;
              if (und && u[r] != 0x80000000u) { const unsigned ix = __hip_atomic_fetch_add(lcnt + r32, 1u, __ATOMIC_RELAXED, __HIP_MEMORY_SCOPE_WORKGROUP); if (ix < 64u) { lu[r32 * 64 + ix] = u[r]; lk[r32 * 64 + ix] = (unsigned)(32 * kt + ps); } } }
          bits |= SHFL_XOR(bits, 32); zb |= SHFL_XOR(zb, 32);
          if (hi == 0) { mwl[r32 * 128 + kt] = bits; zwl[r32 * 128 + kt] = zb; } } }
    __syncthreads();
    bool ovf = false;
#pragma unroll
    for (int q = 0; q < 32; ++q) ovf = ovf || (lcnt[q] > 64u);
    if (!ovf) {
#pragma unroll 1
        for (int qi = 0; qi < 4; ++qi) { const int q = wid * 4 + qi; const unsigned n = (unsigned)__builtin_amdgcn_readfirstlane((int)lcnt[q]), need = krem[q]; const bool act = (unsigned)lane < n;
            const unsigned mu = act ? lu[q * 64 + lane] : 0u, mk = act ? lk[q * 64 + lane] : 0xffffffffu; unsigned rank = 0u;
            for (unsigned j = 0; j < n; ++j) { const unsigned uj = (unsigned)__builtin_amdgcn_readlane((int)mu, (int)j), kj = (unsigned)__builtin_amdgcn_readlane((int)mk, (int)j); rank += (uj > mu || (uj == mu && kj < mk)) ? 1u : 0u; }
            if (act && rank < need) __hip_atomic_fetch_or(mwl + q * 128 + (mk >> 5), 1u << (mk & 31u), __ATOMIC_RELAXED, __HIP_MEMORY_SCOPE_WORKGROUP);
            const unsigned nz = need > n ? need - n : 0u;
            const int k0 = 2 * lane, k1 = 2 * lane + 1; const unsigned z0 = k0 < ntile ? zwl[q * 128 + k0] : 0u, z1 = k1 < ntile ? zwl[q * 128 + k1] : 0u;
            const unsigned c0 = __popc(z0), c1 = __popc(z1), sm = c0 + c1; unsigned v = sm;
#pragma unroll
            for (int off = 1; off < 64; off <<= 1) { const unsigned tmp = SHFL_UP(v, off); if (lane >= off) v += tmp; }
            const unsigned ex = v - sm;
            { const unsigned take0 = nz > ex ? (nz - ex < c0 ? nz - ex : c0) : 0u, take1 = nz > ex + c0 ? (nz - ex - c0 < c1 ? nz - ex - c0 : c1) : 0u;
              if (take0) mwl[q * 128 + k0] |= lowbits(z0, take0);
              if (take1) mwl[q * 128 + k1] |= lowbits(z1, take1); } }
        __syncthreads();
        unsigned* MWg = (unsigned*)(p.ws + OFF_MASKW) + ((size_t)b * SEQ + t0) * 128;
        for (int i = tid; i < 32 * ntile; i += NTHR) { const int q = i / ntile, kt = i - q * ntile; MWg[(size_t)q * 128 + kt] = mwl[q * 128 + kt]; }
        __syncthreads();
        return;
    }
    __syncthreads();
    DS_RADIX(2, 4);
#undef DS_RADIX
    const unsigned thr = thrv[r32], ntake = ntk[r32], ptl = part[r32]; const bool anyPartial = anyp[0] != 0u;
    if (anyPartial) {
        DS_KLOAD0();
#pragma unroll 1
        for (int kt = wid; kt < ntile; kt += 8) { unsigned u[16]; const bf16x8 ka0 = na0, ka1 = na1; { const int kn = (kt + 8 < ntile) ? kt + 8 : kt; const u16* kp = kbase + (size_t)kn * 32 * ZP; na0 = *(const bf16x8*)kp; na1 = *(const bf16x8*)(kp + 16); } idx_scores(ka0, ka1, Q, u); unsigned tb = 0u;
#pragma unroll
            for (int r = 0; r < 16; ++r) { const bool valid = (32 * kt + crow(r, hi)) <= t; if (valid && u[r] == thr) tb |= 1u << crow(r, hi); }
            tb |= SHFL_XOR(tb, 32); if (hi == 0) tcnt[r32 * 128 + kt] = __popc(tb); }
        __syncthreads();
#pragma unroll 1
        for (int qi = 0; qi < 4; ++qi) { const int q = wid * 4 + qi; const unsigned a0 = (2 * lane < ntile) ? tcnt[q * 128 + 2 * lane] : 0u, a1 = (2 * lane + 1 < ntile) ? tcnt[q * 128 + 2 * lane + 1] : 0u;
            const unsigned s = a0 + a1; unsigned v = s;
#pragma unroll
            for (int off = 1; off < 64; off <<= 1) { const unsigned tmp = SHFL_UP(v, off); if (lane >= off) v += tmp; }
            const unsigned ex = v - s; tcnt[q * 128 + 2 * lane] = ex; tcnt[q * 128 + 2 * lane + 1] = ex + a0; }
        __syncthreads();
    }
    unsigned* MW = (unsigned*)(p.ws + OFF_MASKW);
    DS_KLOAD0();
#pragma unroll 1
    for (int kt = wid; kt < ntile; kt += 8) { unsigned u[16]; const bf16x8 ka0 = na0, ka1 = na1; { const int kn = (kt + 8 < ntile) ? kt + 8 : kt; const u16* kp = kbase + (size_t)kn * 32 * ZP; na0 = *(const bf16x8*)kp; na1 = *(const bf16x8*)(kp + 16); } idx_scores(ka0, ka1, Q, u); unsigned bits = 0u, tb = 0u, base = 0u;
        if (anyPartial) {
#pragma unroll
            for (int r = 0; r < 16; ++r) { const bool valid = (32 * kt + crow(r, hi)) <= t; if (valid && u[r] == thr) tb |= 1u << crow(r, hi); }
            tb |= SHFL_XOR(tb, 32); base = tcnt[r32 * 128 + kt]; }
#pragma unroll
        for (int r = 0; r < 16; ++r) { const int ps = crow(r, hi); const bool valid = (32 * kt + ps) <= t; const bool tie = u[r] == thr;
            const bool tieok = !ptl || ((base + __popc(tb & ((1u << ps) - 1u))) < ntake);
            if (valid && (u[r] > thr || (tie && tieok))) bits |= 1u << ps; }
        bits |= SHFL_XOR(bits, 32);
        if (hi == 0) MW[row * 128 + kt] = bits; }
    __syncthreads();
}
#undef DS_KLOAD0
#ifndef DBG_REP
#define DBG_REP 0
#endif
#define REP(g) for (int rep_ = 0; rep_ < (((DBG_REP >> (g)) & 1) ? 2 : 1); ++rep_)
__device__ __forceinline__ void sgu_task(const Params& p, int layer, int b, int n, int g, LAS unsigned char* lds) {
    const int tid = tid_fresh(p.wave), lane = tid & 63, wid = tid >> 6, fr = lane & 15, fq = lane >> 4;
    LAS u16* vt = (LAS u16*)lds; const u16* Z = (const u16*)(p.ws + OFF_RZ); u16* MC = (u16*)(p.ws + OFF_RH);
    const size_t row0 = (size_t)b * SEQ + 128 * n;
    { const int s = tid >> 2, ch = tid & 3; const u16* src = Z + (row0 + s) * ZP + ZSG + 256 + g * 64 + ch * 16; const u32x4 a = *(const u32x4*)src, c = *(const u32x4*)(src + 8);
      LAS u16* d = vt + (ch * 16) * 136 + s;
      d[0 * 136] = (u16)(a.x & 0xffff); d[1 * 136] = (u16)(a.x >> 16); d[2 * 136] = (u16)(a.y & 0xffff); d[3 * 136] = (u16)(a.y >> 16); d[4 * 136] = (u16)(a.z & 0xffff); d[5 * 136] = (u16)(a.z >> 16); d[6 * 136] = (u16)(a.w & 0xffff); d[7 * 136] = (u16)(a.w >> 16);
      d[8 * 136] = (u16)(c.x & 0xffff); d[9 * 136] = (u16)(c.x >> 16); d[10 * 136] = (u16)(c.y & 0xffff); d[11 * 136] = (u16)(c.y >> 16); d[12 * 136] = (u16)(c.z & 0xffff); d[13 * 136] = (u16)(c.z >> 16); d[14 * 136] = (u16)(c.w & 0xffff); d[15 * 136] = (u16)(c.w >> 16); }
    const u16* W = (const u16*)(p.ws + OFF_SGW) + ((size_t)(layer * 4 + g) * 128 + 16 * wid + fr) * 128 + fq * 8;
    bf16x8 af[4];
#pragma unroll
    for (int ks = 0; ks < 4; ++ks) af[ks] = *(const bf16x8*)(W + ks * 32);
    __syncthreads();
    f32x4 acc[4];
#pragma unroll
    for (int c = 0; c < 4; ++c) acc[c] = (f32x4){0.f, 0.f, 0.f, 0.f};
    const int nks = ((16 * wid + 15) >> 5) + 1;
#pragma unroll
    for (int ks = 0; ks < 4; ++ks) if (ks < nks) { const bf16x8 a = af[ks];
#pragma unroll
        for (int c = 0; c < 4; ++c) { const bf16x8 bb = *(const LAS bf16x8*)(vt + (16 * c + fr) * 136 + 32 * ks + fq * 8); acc[c] = __builtin_amdgcn_mfma_f32_16x16x32_bf16(a, bb, acc[c], 0, 0, 0); } }
#pragma unroll
    for (int r = 0; r < 4; ++r) { const int t = 16 * wid + 4 * fq + r; const float bias = p.sgu_b[(layer * 4 + g) * 128 + t];
#pragma unroll
        for (int c = 0; c < 4; ++c) { const int d = 16 * c + fr; const float u = bf2f(Z[(row0 + t) * ZP + ZSG + g * 64 + d]); MC[(row0 + t) * D + 768 + g * 64 + d] = f2bf(u * (acc[c][r] + bias)); } }
    __syncthreads();
}

constexpr int PH_L0 = 2;
constexpr int PH_PER_L0 = 9;
constexpr int PH_L1 = PH_L0 + PH_PER_L0;
constexpr int PH_END = PH_L1 + 7 + 2 * MOE_NCHUNK + 1;

__device__ __forceinline__ void mixer_phase1(const Params& p, int layer, LAS unsigned char* lds) {
    REP(4) phase_cmpattn(p, layer, lds);
    const u16* Z = (const u16*)(p.ws + OFF_RZ);
    REP(5) { AttnArgs A{(const u16*)(p.ws + OFF_QROT), 384, 0, Z, ZP, ZKV + 4 * 128, Z, ZP, ZKV + 5 * 128, (u16*)(p.ws + OFF_OW), 384, 0};
      for (int u = blockIdx.x; u < 768; u += gridDim.x) { const int qb = u & 15, h = (u >> 4) % 6, b = u / 96; AttnArgs B = A; B.kc += (h / 3) * 64; B.vc += (h / 3) * 64; attn_unit<3>(p, B, b, h, h / 3, qb, lds); } }
    REP(6) for (int pr = blockIdx.x; pr < 512; pr += gridDim.x) { const int b = pr >> 6, s = pr & 63; dsa_select_task(p, b, s, lds); dsa_select_task(p, b, 127 - s, lds); }
    REP(7) for (int u = blockIdx.x; u < 1024; u += gridDim.x) sgu_task(p, layer, u >> 7, (u >> 2) & 31, u & 3, lds);
}
__device__ __forceinline__ void mixer_phase2(const Params& p, int layer, LAS unsigned char* lds) {
    const u16* Z = (const u16*)(p.ws + OFF_RZ); u16* MC = (u16*)(p.ws + OFF_RH);
    for (int pr = blockIdx.x; pr < 768; pr += gridDim.x) {
        const bool dsa = pr >= 384; const int q = dsa ? pr - 384 : pr; const int s = q & 7, h = (q >> 3) % 6, b = q / 48;
        REP(dsa ? 9 : 8) for (int k = 0; k < 2; ++k) { const int qb = k ? 15 - s : s;
            if (!dsa) { AttnArgs A{(const u16*)(p.ws + OFF_QROT), 384, 0, Z, ZP, ZKV + 2 * 128 + (h / 3) * 64, Z, ZP, ZKV + 3 * 128 + (h / 3) * 64, MC, D, 0};
#ifdef DBG_VAR
                { AttnArgs Bd = A; Bd.O = (u16*)(p.ws + WS_END); attn_unit<1, DBG_VAR>(p, Bd, b, h, h / 3, qb, lds); }
#endif
                attn_unit<1>(p, A, b, h, h / 3, qb, lds); }
            else { AttnArgs A{Z, ZP, ZDQ, Z, ZP, ZCKV, Z, ZP, ZCKV + 64, MC, D, 384}; attn_unit<2>(p, A, b, h, 0, qb, lds); } }
    }
}

__device__ __forceinline__ Params fresh_params(const Params& p) { Params q = p; asm volatile("" : "+s"(q.ws)); return q; }
__global__ void __launch_bounds__(NTHR, 2) k_main(Params p_in) {
    Params p = p_in; p.wave = __builtin_amdgcn_readfirstlane((int)(threadIdx.x >> 6));
    extern __shared__ __attribute__((aligned(16))) unsigned char shm[];
    LAS unsigned char* lds = (LAS unsigned char*)shm;
    unsigned* bar = (unsigned*)(p.ws + OFF_BAR);
    LAS u32x4* xbw = (LAS u32x4*)(lds + LDS_BYTES - 16);
    XcdBarrier xb; xb.bar = bar; xb.x = 0; xb.wave = p.wave; xb.st = (volatile LAS unsigned*)xbw;
    if (p.use_bar) { if (tid_fresh(p.wave) == 0) *xbw = (u32x4){0u, 0u, 0u, 0u}; __syncthreads(); xb = xcd_barrier_post(bar, (volatile LAS unsigned*)xbw); xb.wave = p.wave; }
    const int G = gridDim.x, c = blockIdx.x;
#define PHASE(id) if ((id) >= p.phase_lo && (id) < p.phase_hi)
#define SEAM(id) do { if (p.use_bar && (id) >= p.phase_lo && (id) + 1 < p.phase_hi) xcd_barrier(xb); } while (0)
    PHASE(0) { const Params q = fresh_params(p); REP(0) for (int j = c; j < PJ_END; j += G) prologue_job(q, j, lds); }
    SEAM(0);
    PHASE(1) { const Params q = fresh_params(p); REP(1) phase_lnmod0(q); }
    SEAM(1);
    for (int layer = 0; layer < DEPTH; ++layer) {
        const int base = layer == 0 ? PH_L0 : PH_L1;
        PHASE(base + 0) REP(2) { const Params q = fresh_params(p); pg8::SchedDense S; S.init(q.ws + OFF_RH, q.ws + OFF_WIN + (size_t)layer * ZP * D * 2, M, ZP, D, G, c); pg8::EpiBf16 E{(u16*)(q.ws + OFF_RZ), ZP}; pg8::gemm_phase(lds, D, S, E, q.wave); }
        SEAM(base + 0);
#ifndef DBG_NOMIX
        PHASE(base + 1) { const Params q = fresh_params(p); if ((DBG_REP >> 18) & 1) phase_prep<true>(q, layer, lds); phase_prep(q, layer, lds); REP(3) phase_compress(q, layer, lds); }
        SEAM(base + 1);
        PHASE(base + 2) { const Params q = fresh_params(p); mixer_phase1(q, layer, lds); }
        SEAM(base + 2);
        PHASE(base + 3) { const Params q = fresh_params(p); mixer_phase2(q, layer, lds); }
        SEAM(base + 3);
#else
        PHASE(base + 3) { const Params q = fresh_params(p); u32x4* mc = (u32x4*)(q.ws + OFF_RH); for (size_t i = (size_t)c * NTHR + tid_fresh(q.wave); i < (size_t)M * D / 8; i += (size_t)G * NTHR) mc[i] = (u32x4){0u, 0u, 0u, 0u}; }
        SEAM(base + 3);
#endif
        PHASE(base + 4) REP(10) { const Params q = fresh_params(p); pg8::SchedDense S; S.init(q.ws + OFF_RH, q.ws + OFF_WOUT + (size_t)layer * D * D * 2, M, D, D, G, c); pg8::EpiBf16 E{(u16*)(q.ws + OFF_RZ), D}; pg8::gemm_phase(lds, D, S, E, q.wave); }
        SEAM(base + 4);
        PHASE(base + 5) { const Params q = fresh_params(p); REP(layer == 0 ? 17 : 31) phase_ln1(q, layer, lds); }
        SEAM(base + 5);
        if (layer == 0) {
            PHASE(base + 6) REP(11) { const Params q = fresh_params(p);
#if FFN0_FP8 == 2
                pg8::SchedDense S; S.init(q.ws + OFF_RH, q.ws + OFF_WGU, M, 2 * DFF, D / 2, G, c); pg8::EpiSwiglu8 E{(unsigned char*)(q.ws + OFF_RZ), DFF, 0, ASC, 1.f / (WSC_UP * ASC)}; pg8::gemm_phase<pg8::EpiSwiglu8, pg8::SchedDense, true, SCB_UP, SCB_ACT>(lds, D / 2, S, E, q.wave);
#elif FFN0_FP8
                pg8::SchedDense S; S.init(q.ws + OFF_RH, q.ws + OFF_WGU, M, 2 * DFF, D / 2, G, c); pg8::EpiSwiglu E{(u16*)(q.ws + OFF_RZ), DFF, 0, 1.f / (WSC_UP * ASC)}; pg8::gemm_phase<pg8::EpiSwiglu, pg8::SchedDense, true, SCB_UP, SCB_ACT>(lds, D / 2, S, E, q.wave);
#else
                pg8::SchedDense S; S.init(q.ws + OFF_RH, q.ws + OFF_WGU, M, 2 * DFF, D, G, c); pg8::EpiSwiglu E{(u16*)(q.ws + OFF_RZ), DFF, 0}; pg8::gemm_phase(lds, D, S, E, q.wave);
#endif
            }
            SEAM(base + 6);
            PHASE(base + 7) REP(12) { const Params q = fresh_params(p);
#if FFN0_FP8 == 2
                pg8::SchedDense S; S.init(q.ws + OFF_RZ, q.ws + OFF_WDN, M, D, DFF / 2, G, c); pg8::EpiBf16 E{(u16*)(q.ws + OFF_RH), D, 1.f / (WSC_DN * ASC)}; pg8::gemm_phase<pg8::EpiBf16, pg8::SchedDense, true, SCB_DN, SCB_ACT>(lds, DFF / 2, S, E, q.wave);
#else
                pg8::SchedDense S; S.init(q.ws + OFF_RZ, q.ws + OFF_WDN, M, D, DFF, G, c); pg8::EpiBf16 E{(u16*)(q.ws + OFF_RH), D}; pg8::gemm_phase(lds, DFF, S, E, q.wave);
#endif
            }
            SEAM(base + 7);
            PHASE(base + 8) { const Params q = fresh_params(p); phase_ln2(q, layer); }
            SEAM(base + 8);
        } else {
            PHASE(base + 6) { const Params q = fresh_params(p); REP(16) phase_moe_slots(q, layer, lds); REP(13) moe_conv_all(q, lds); }
            SEAM(base + 6);
            PHASE(base + 7) REP(14) { const Params q = fresh_params(p); LAS int* tab = (LAS int*)(lds + LDS_TAB); moe_tables(q, 0, tab); const int T = tab[8]; const int ntl = T - 256;
                if (ntl > 0) { pg8::SchedMoe S{q.ws + OFF_HG8, q.ws + OFF_MW1, (size_t)256 * D, (size_t)2 * EFF * D, 256, ntl, 2 * EFF / 256, G, c, tab + 16};
                    pg8::EpiSwiglu8 E{(unsigned char*)(q.ws + OFF_HT), EFF, 256 * 256, ASC, 1.f / (WSC_UP * ASC)}; pg8::gemm_phase<pg8::EpiSwiglu8, pg8::SchedMoe, true, SCB_UP, SCB_ACT>(lds, D / 2, S, E, q.wave); }
                { pg8::SchedMoe S{q.ws + OFF_HG8, q.ws + OFF_MW1, (size_t)256 * D, (size_t)2 * EFF * D, 0, 128, 2 * EFF / 256, G, c, tab + 16};
                    pg8::EpiSwiglu8 E{(unsigned char*)(q.ws + OFF_RO), EFF, 0, ASC, 1.f / (WSC_UP * ASC)}; pg8::gemm_phase<pg8::EpiSwiglu8, pg8::SchedMoe, true, SCB_UP, SCB_ACT>(lds, D / 2, S, E, q.wave); } }
            SEAM(base + 7);
            PHASE(base + 8) REP(15) { const Params q = fresh_params(p); LAS int* tab = (LAS int*)(lds + LDS_TAB); moe_tables(q, 0, tab);
                pg8::SchedMoe S{q.ws + OFF_RO, q.ws + OFF_MW2, (size_t)256 * EFF, (size_t)D * EFF, 0, 128, D / 256, G, c, tab + 16};
                pg8::EpiBf16 E{(u16*)(q.ws + OFF_RH), D, 1.f / (WSC_DN * ASC)}; pg8::gemm_phase<pg8::EpiBf16, pg8::SchedMoe, true, SCB_DN, SCB_ACT>(lds, EFF / 2, S, E, q.wave); }
            SEAM(base + 8);
            PHASE(base + 9) REP(14) { const Params q = fresh_params(p); LAS int* tab = (LAS int*)(lds + LDS_TAB); moe_tables(q, 0, tab); const int T = tab[8]; const int ntl = T - 256;
                if (ntl > 0) { pg8::SchedMoe S{q.ws + OFF_HT - (size_t)256 * 256 * EFF, q.ws + OFF_MW2, (size_t)256 * EFF, (size_t)D * EFF, 256, ntl, D / 256, G, c, tab + 16};
                    pg8::EpiBf16 E{(u16*)(q.ws + OFF_RH), D, 1.f / (WSC_DN * ASC)}; pg8::gemm_phase<pg8::EpiBf16, pg8::SchedMoe, true, SCB_DN, SCB_ACT>(lds, EFF / 2, S, E, q.wave); }
                { pg8::SchedMoeSkip S{q.ws + OFF_HG8, q.ws + OFF_MW1, (size_t)256 * D, (size_t)2 * EFF * D, 128, 128, 2 * EFF / 256, G, c, tab + 16, ntl > 0 ? 4 * ntl : 0, 3};
                    pg8::EpiSwiglu8 E{(unsigned char*)(q.ws + OFF_RO), EFF, 128 * 256, ASC, 1.f / (WSC_UP * ASC)}; pg8::gemm_phase<pg8::EpiSwiglu8, pg8::SchedMoeSkip, true, SCB_UP, SCB_ACT>(lds, D / 2, S, E, q.wave); } }
            SEAM(base + 9);
            PHASE(base + 10) REP(15) { const Params q = fresh_params(p); LAS int* tab = (LAS int*)(lds + LDS_TAB); moe_tables(q, 0, tab);
                pg8::SchedMoe S{q.ws + OFF_RO - (size_t)128 * 256 * EFF, q.ws + OFF_MW2, (size_t)256 * EFF, (size_t)D * EFF, 128, 128, D / 256, G, c, tab + 16};
                pg8::EpiBf16 E{(u16*)(q.ws + OFF_RH), D, 1.f / (WSC_DN * ASC)}; pg8::gemm_phase<pg8::EpiBf16, pg8::SchedMoe, true, SCB_DN, SCB_ACT>(lds, EFF / 2, S, E, q.wave); }
            SEAM(base + 10);
            PHASE(base + 7 + 2 * MOE_NCHUNK) { const Params q = fresh_params(p); phase_ln2(q, layer); }
        }
    }
#undef PHASE
#undef SEAM
}

#include <cstdio>
#include <cstring>
#ifndef MK_LAUNCHES
#define MK_LAUNCHES 1
#endif
extern "C" void kernel_launch(void* const* d_in, const int* in_sizes, int n_in, void* d_out, int out_size, void* d_ws, size_t ws_size, hipStream_t stream) {
    static int grid = 0;
    if (grid == 0) {
        if (n_in != 29 || ws_size < WS_END) { fprintf(stderr, "kernel_launch: n_in %d ws %zu (need %zu)\n", n_in, ws_size, (size_t)WS_END); grid = -1; return; }
        int dev = 0, cus = 0, per_cu = 0;
        if (hipGetDevice(&dev) != hipSuccess || hipDeviceGetAttribute(&cus, hipDeviceAttributeMultiprocessorCount, dev) != hipSuccess) { grid = -1; return; }
        if (hipFuncSetAttribute((const void*)k_main, hipFuncAttributeMaxDynamicSharedMemorySize, LDS_BYTES) != hipSuccess) { fprintf(stderr, "kernel_launch: hipFuncSetAttribute failed\n"); grid = -1; return; }
        if (hipOccupancyMaxActiveBlocksPerMultiprocessor(&per_cu, (const void*)k_main, NTHR, LDS_BYTES) != hipSuccess || per_cu < 1) { fprintf(stderr, "kernel_launch: occupancy query says %d\n", per_cu); }
        grid = cus;
    }
    if (grid < 0) return;
    hipMemsetAsync((char*)d_ws + OFF_BAR, 0, 65536, stream);
    Params p; memset(&p, 0, sizeof(p));
    p.x = (const float*)d_in[0]; p.c = (const float*)d_in[1]; p.pos = (const int*)d_in[2]; p.w_ada = (const float*)d_in[3]; p.b_ada = (const float*)d_in[4]; p.w_in = (const float*)d_in[5];
    p.cmp_pos = (const float*)d_in[6]; p.cmp_w1 = (const float*)d_in[7]; p.cmp_w2 = (const float*)d_in[8]; p.kvn = (const float*)d_in[9]; p.w_uk = (const float*)d_in[10]; p.w_uv = (const float*)d_in[11];
    p.sgu_g = (const float*)d_in[12]; p.sgu_bn = (const float*)d_in[13]; p.sgu_w = (const float*)d_in[14]; p.sgu_b = (const float*)d_in[15]; p.w_out = (const float*)d_in[16];
    p.ln1g = (const float*)d_in[17]; p.ln1b = (const float*)d_in[18]; p.ln2g = (const float*)d_in[19]; p.ln2b = (const float*)d_in[20];
    p.fg = (const float*)d_in[21]; p.fu = (const float*)d_in[22]; p.fd = (const float*)d_in[23]; p.mr = (const float*)d_in[24]; p.mbr = (const float*)d_in[25]; p.mg = (const float*)d_in[26]; p.mu = (const float*)d_in[27]; p.md = (const float*)d_in[28];
    p.out = (float*)d_out; p.ws = (char*)d_ws;
#if MK_LAUNCHES == 1
    p.phase_lo = 0; p.phase_hi = PH_END; p.use_bar = 1;
    hipLaunchKernelGGL(k_main, dim3(grid), dim3(NTHR), LDS_BYTES, stream, p);
#else
    for (int ph = 0; ph < PH_END; ++ph) { p.phase_lo = ph; p.phase_hi = ph + 1; p.use_bar = 0; hipLaunchKernelGGL(k_main, dim3(grid), dim3(NTHR), LDS_BYTES, stream, p); }
#endif
}
```

```cpp
#include <hip/hip_runtime.h>
#include <stdint.h>
#include <math.h>

#define LAS __attribute__((address_space(3)))
typedef unsigned short u16;
typedef short bf16x8 __attribute__((ext_vector_type(8)));
typedef short s16x4 __attribute__((ext_vector_type(4)));
typedef float f32x4 __attribute__((ext_vector_type(4)));
typedef float f32x2 __attribute__((ext_vector_type(2)));
typedef float f32x16 __attribute__((ext_vector_type(16)));
typedef unsigned u32x4 __attribute__((ext_vector_type(4)));
typedef unsigned u32x2 __attribute__((ext_vector_type(2)));

constexpr int D = 1024, NB = 8, SEQ = 4096, M = NB * SEQ, DEPTH = 2;
constexpr int ZP = 2560;
constexpr int ZQ = 0, ZKV = 384, ZDQ = 1152, ZCKV = 1536, ZIQ = 1664, ZIK = 1792, ZSG = 1824, ZG = 2336, ZIW = 2360;
constexpr int INW = 2358;
constexpr int DFF = 2816, EFF = 3584, NEXP = 8;
constexpr float ALPHA = 1.41421356237309515f;
constexpr float C2 = 0.125f * 1.4426950408889634f;
constexpr int NTHR = 512;
constexpr int LDS_BYTES = 147456;
constexpr int LDS_TAB = 131072;
constexpr int MOE_ROWS = 65536 + 8 * 256;
constexpr int MOE_TILES = MOE_ROWS / 256;
constexpr int MOE_CHUNK = 128;
constexpr int MOE_NCHUNK = 2;

constexpr size_t al256(size_t x) { return (x + 255) & ~(size_t)255; }
constexpr size_t OFF_BAR = 0;
constexpr size_t OFF_MOD = 65536;
constexpr size_t OFF_COSH = OFF_MOD + (size_t)2 * 8 * 6144 * 4;
constexpr size_t OFF_SINH = OFF_COSH + (size_t)M * 32 * 4;
constexpr size_t OFF_COSI = OFF_SINH + (size_t)M * 32 * 4;
constexpr size_t OFF_SINI = OFF_COSI + (size_t)M * 16 * 4;
constexpr size_t OFF_WIN = OFF_SINI + (size_t)M * 16 * 4;
constexpr size_t OFF_WOUT = OFF_WIN + (size_t)2 * ZP * D * 2;
constexpr size_t OFF_WGU = OFF_WOUT + (size_t)2 * D * D * 2;
constexpr size_t OFF_WDN = OFF_WGU + (size_t)2 * DFF * D * 2;
constexpr size_t OFF_CW1T = OFF_WDN + (size_t)D * DFF * 2;
constexpr size_t OFF_CB1 = OFF_CW1T + (size_t)4 * 64 * 2048 * 2;
constexpr size_t OFF_SGW = OFF_CB1 + 1024;
constexpr size_t OFF_KC = OFF_SGW + (size_t)2 * 4 * 128 * 128 * 2;
constexpr size_t OFF_VCT = OFF_KC + (size_t)8 * 2 * 256 * 64 * 2;
constexpr size_t OFF_BLK = OFF_VCT + (size_t)8 * 2 * 256 * 64 * 2;
constexpr size_t OFF_TOK = OFF_BLK + (size_t)M * 2 * 8;
constexpr size_t OFF_SLOT = OFF_TOK + (size_t)M * 16;
constexpr size_t OFF_HIST = OFF_SLOT + (size_t)M * 8;
constexpr size_t OFF_RZ = al256(OFF_HIST + 256 * 8 * 4);
constexpr size_t SZ_RZ = (size_t)M * DFF * 2;
constexpr size_t OFF_RH = OFF_RZ + SZ_RZ;
constexpr size_t SZ_RH = (size_t)MOE_ROWS * D * 2;
constexpr size_t OFF_RO = OFF_RH + SZ_RH;
constexpr size_t SZ_RO = (size_t)MOE_CHUNK * 256 * EFF;
constexpr size_t OFF_OC = OFF_RO, OFF_OW = OFF_OC + (size_t)M * 384 * 2, OFF_QROT = OFF_OW + (size_t)M * 384 * 2;
constexpr size_t OFF_MASKW = OFF_QROT + (size_t)M * 384 * 2;
static_assert(OFF_MASKW + (size_t)M * 128 * 4 <= OFF_RO + SZ_RO, "R_O map");
constexpr size_t OFF_XR = OFF_RO + SZ_RO;
constexpr size_t OFF_HT = OFF_XR + (size_t)M * D * 2;
constexpr size_t WS_END = OFF_HT + (size_t)8 * 256 * EFF;
constexpr size_t OFF_MW1 = OFF_RZ;
constexpr size_t OFF_MW2 = OFF_RZ + (size_t)NEXP * 2 * EFF * D;
constexpr size_t OFF_HG8 = OFF_RZ + ((size_t)96 << 20);
static_assert(OFF_MW2 + (size_t)NEXP * D * EFF <= OFF_HG8 && OFF_HG8 + (size_t)MOE_ROWS * D <= OFF_RZ + SZ_RZ, "R_Z map");
#ifndef FFN0_FP8
#define FFN0_FP8 1
#endif
constexpr float WSC_UP = 64.f, WSC_DN = 128.f, ASC = 8.f;
constexpr int SCB_UP = 0x79797979, SCB_DN = 0x78787878, SCB_ACT = 0x7C7C7C7C;
constexpr int CTL_Q = 4096;

__device__ __forceinline__ unsigned cvt_pk_bf16(float lo, float hi) { unsigned r; asm volatile("v_cvt_pk_bf16_f32 %0, %1, %2" : "=v"(r) : "v"(lo), "v"(hi)); return r; }
__device__ __forceinline__ u16 f2bf(float f) { return (u16)(cvt_pk_bf16(f, 0.f) & 0xffffu); }
__device__ __forceinline__ float bf2f(u16 b) { return __uint_as_float(((unsigned)b) << 16); }
__device__ __forceinline__ float bflo(unsigned w) { return __uint_as_float(w << 16); }
__device__ __forceinline__ float bfhi(unsigned w) { return __uint_as_float(w & 0xffff0000u); }
__device__ __forceinline__ int lane_fresh() { unsigned z = 0u; asm volatile("" : "+v"(z)); return (int)__builtin_amdgcn_mbcnt_hi(~0u, __builtin_amdgcn_mbcnt_lo(~0u, z)); }
template <class T> __device__ __forceinline__ T bperm(T v, int src) { return __builtin_bit_cast(T, __builtin_amdgcn_ds_bpermute(src << 2, __builtin_bit_cast(int, v))); }
#define SHFL_XOR(v, m) bperm((v), lane_fresh() ^ (m))
#define SHFL_DOWN(v, o) bperm((v), lane_fresh() + (o))
#define SHFL_UP(v, o) bperm((v), lane_fresh() - (o))
#define SHFL_IDX(v, s) bperm((v), (s))
__device__ __forceinline__ u32x2 halves32(unsigned v) { auto rr = __builtin_amdgcn_permlane32_swap(v, v, false, false); return (u32x2){rr[0], rr[1]}; }
#define DPP_ADD(v, ctrl, row_mask) ((v) + __int_as_float(__builtin_amdgcn_update_dpp(0, __float_as_int(v), (ctrl), (row_mask), 0xF, false)))
__device__ __forceinline__ float wave_sum(float v) {
    v = DPP_ADD(v, 0xB1, 0xF);
    v = DPP_ADD(v, 0x4E, 0xF);
    v = DPP_ADD(v, 0x141, 0xF);
    v = DPP_ADD(v, 0x140, 0xF);
    v = DPP_ADD(v, 0x142, 0xA);
    v = DPP_ADD(v, 0x143, 0xC);
    return __int_as_float(__builtin_amdgcn_readlane(__float_as_int(v), 63)); }
__device__ __forceinline__ float gelu_tanh(float x) { const float y = 0.7978845608028654f * (x + 0.044715f * x * x * x); const float e = __expf(2.f * y); const float t = 1.f - 2.f / (e + 1.f); return 0.5f * x * (1.f + t); }
__device__ __forceinline__ int crow(int r, int hi) { return (r & 3) + 8 * (r >> 2) + 4 * hi; }

struct Params {
    const float *x, *c; const int* pos;
    const float *w_ada, *b_ada, *w_in, *cmp_pos, *cmp_w1, *cmp_w2, *kvn, *w_uk, *w_uv, *sgu_g, *sgu_bn, *sgu_w, *sgu_b, *w_out, *ln1g, *ln1b, *ln2g, *ln2b;
    const float *fg, *fu, *fd, *mr, *mbr, *mg, *mu, *md;
    float* out; char* ws;
    int phase_lo, phase_hi, use_bar, wave;
};
__device__ __forceinline__ int tid_fresh(int wave) { unsigned z = 0u; asm volatile("" : "+v"(z)); const int l = (int)__builtin_amdgcn_mbcnt_hi(~0u, __builtin_amdgcn_mbcnt_lo(~0u, z)); return (wave << 6) | l; }
#define XB_TMO      128
#define XB_XCNT(j)  (256  + 64 * (j))
#define XB_XSUB(j)  (1280 + 64 * (j))
#define XB_XGEN(j)  (2304 + 64 * (j))
#define XB_TOP      3328
#define XB_TOPGEN   3392
#define XCD_BAR_WORDS 3456
#define XB_SPIN_CAP (1u << 18)

__device__ __forceinline__ unsigned xb_ld(unsigned* p)              { return __hip_atomic_load(p, __ATOMIC_RELAXED, __HIP_MEMORY_SCOPE_AGENT); }
__device__ __forceinline__ unsigned xb_add(unsigned* p, unsigned v) { return __hip_atomic_fetch_add(p, v, __ATOMIC_RELAXED, __HIP_MEMORY_SCOPE_AGENT); }
__device__ __forceinline__ unsigned xb_xcc_id() { return (unsigned)__builtin_amdgcn_s_getreg((3 << 11) | 20) & 0xFu; }
#define XB_SPIN(cond, bar) do { unsigned _sp = 0; while (cond) { __builtin_amdgcn_s_sleep(1); \
    if ((++_sp & 255u) == 0u) { if (xb_ld(&(bar)[XB_TMO])) break; if (_sp > XB_SPIN_CAP) { atomicAdd(&(bar)[XB_TMO], 1u); break; } } } } while (0)

struct XcdBarrier {
    unsigned* bar; unsigned x; int wave;
    volatile LAS unsigned* st;
};

__device__ __forceinline__ XcdBarrier xcd_barrier_post(unsigned* bar, volatile LAS unsigned* st) {
    XcdBarrier b; b.bar = bar; b.x = xb_xcc_id(); b.st = st;
    if (threadIdx.x == 0) (void)xb_add(&bar[XB_XCNT(b.x)], 1u);
    return b;
}
__device__ __forceinline__ void xcd_barrier_complete(unsigned* bar, unsigned x, unsigned& nloc, unsigned& nx) {
    const unsigned G = gridDim.x * gridDim.y * gridDim.z;
    unsigned sum, cnt, mine, sp = 0u;
    for (;;) {
        sum = 0u; cnt = 0u; mine = 0u;
#pragma unroll
        for (unsigned j = 0; j < 16; ++j) { const unsigned c = xb_ld(&bar[XB_XCNT(j)]); sum += c; cnt += (c > 0u) ? 1u : 0u; mine = (j == x) ? c : mine; }
        if (sum == G) break;
        __builtin_amdgcn_s_sleep(1);
        if ((++sp & 255u) == 0u) { if (xb_ld(&bar[XB_TMO])) break; if (sp > XB_SPIN_CAP) { atomicAdd(&bar[XB_TMO], 1u); break; } }
    }
    nloc = mine > 0u ? mine : 1u; nx = cnt > 0u ? cnt : 1u;
}

__device__ __forceinline__ void xcd_barrier(const XcdBarrier& b) {
    asm volatile("s_waitcnt vmcnt(0)" ::: "memory");
    __syncthreads();
    if (tid_fresh(b.wave) == 0) {
        unsigned* bar = b.bar;
        __builtin_amdgcn_s_waitcnt(0);
        unsigned nloc = b.st[0], nx = b.st[1];
        if (nloc == 0u) { xcd_barrier_complete(bar, b.x, nloc, nx); b.st[0] = nloc; b.st[1] = nx; }
        const unsigned old = xb_add(&bar[XB_XSUB(b.x)], 1u);
        const unsigned gen = old / nloc;
        if (old + 1u == (gen + 1u) * nloc) {
            __builtin_amdgcn_fence(__ATOMIC_RELEASE, "agent");
            asm volatile("s_waitcnt vmcnt(0)" ::: "memory");
            const unsigned og = xb_add(&bar[XB_TOP], 1u);
            const unsigned tg = og / nx;
            if (og + 1u == (tg + 1u) * nx) xb_add(&bar[XB_TOPGEN], 1u);
            else XB_SPIN(xb_ld(&bar[XB_TOPGEN]) == tg, bar);
            __builtin_amdgcn_fence(__ATOMIC_ACQUIRE, "agent");
            xb_add(&bar[XB_XGEN(b.x)], 1u);
            asm volatile("s_waitcnt vmcnt(0)" ::: "memory");
        } else {
            XB_SPIN(xb_ld(&bar[XB_XGEN(b.x)]) == gen, bar);
            __builtin_amdgcn_fence(__ATOMIC_ACQUIRE, "agent");
            asm volatile("s_waitcnt vmcnt(0)" ::: "memory");
        }
    }
    __syncthreads();
}
namespace pg8 {
constexpr int BM = 256, BK = 64, HALF = 128, HTB = HALF * BK * 2, STAGE_BYTES = 8 * HTB, NXCD = 8, WGM = 8;
__host__ __device__ __forceinline__ int lds_byte(int r, int c) { const int st = (r >> 4) * 2 + (c >> 5), rr = r & 15, cc = c & 31, ob = rr * 64 + cc * 2; return st * 1024 + (ob ^ (((ob >> 9) & 1) << 5)); }
__host__ __device__ __forceinline__ void stage_rc(int b, int& R, int& C) { const int st = b / 1024, sb = b % 1024, swz = sb ^ (((sb >> 9) & 1) << 5); R = (st >> 1) * 16 + swz / 64; C = (st & 1) * 32 + (swz % 64) / 2; }
__host__ __device__ __forceinline__ int perm32(int rho) { const int n = rho >> 4, i = rho & 15; return 8 * (i >> 2) + 4 * n + (i & 3); }

struct Unit { int pm, pn; };

struct SchedDense {
    const char* A; const char* B; size_t tstep;
    int nM, nN, nwg, G, c;
    __device__ void init(const void* A_, const void* B_, int Mr, int N, int K, int G_, int c_) { A = (const char*)A_; B = (const char*)B_; tstep = (size_t)256 * K * 2; nM = Mr / BM; nN = N / BM; nwg = nM * nN; G = G_; c = c_; }
    __device__ bool next(int i, Unit& u) const {
        const long L = (long)i * G + c; if (L >= nwg) return false;
        int wgid = (int)L; { const int q = nwg / NXCD, r = nwg % NXCD, xcd = wgid % NXCD, off = wgid / NXCD; wgid = (xcd < r ? xcd * (q + 1) : r * (q + 1) + (xcd - r) * q) + off; }
        const int nig = WGM * nN, gid = wgid / nig, fm = gid * WGM, gsz = (nM - fm) < WGM ? (nM - fm) : WGM;
        u.pm = fm + ((wgid % nig) % gsz); u.pn = (wgid % nig) / gsz; return true;
    }
    __device__ __forceinline__ const char* a_ptr(const Unit& u) const { return A + (size_t)u.pm * tstep; }
    __device__ __forceinline__ const char* b_ptr(const Unit& u) const { return B + (size_t)u.pn * tstep; }
};
struct SchedMoe {
    const char* A; const char* B; size_t tstep, estride; int tile0, ntile, nN, G, c; const LAS int* texp;
    __device__ bool next(int i, Unit& u) const { const long L = (long)i * G + c; if (L >= (long)ntile * nN) return false; u.pm = tile0 + (int)(L % ntile); u.pn = (int)(L / ntile); return true; }
    __device__ __forceinline__ const char* a_ptr(const Unit& u) const { return A + (size_t)u.pm * tstep; }
    __device__ __forceinline__ const char* b_ptr(const Unit& u) const { return B + (size_t)texp[u.pm] * estride + (size_t)u.pn * tstep; }
};

struct SchedMoeSkip {
    const char* A; const char* B; size_t tstep, estride; int tile0, ntile, nN, G, c; const LAS int* texp; int nlong, skip;
    __device__ bool next(int i, Unit& u) const { const long tot = (long)ntile * nN; long L;
        if (c < nlong) L = (long)(i + skip) * G + c;
        else { const long nreg = (tot - c + G - 1) / G; if (i < nreg) L = (long)i * G + c; else { const int a = c - nlong; if (i > nreg || a >= nlong * skip) return false; L = (long)(a / nlong) * G + (a % nlong); } }
        if (L >= tot) return false; u.pm = tile0 + (int)(L % ntile); u.pn = (int)(L / ntile); return true; }
    __device__ __forceinline__ const char* a_ptr(const Unit& u) const { return A + (size_t)u.pm * tstep; }
    __device__ __forceinline__ const char* b_ptr(const Unit& u) const { return B + (size_t)texp[u.pm] * estride + (size_t)u.pn * tstep; }
};

struct EpiBf16 {
    u16* O; int ldc; float sc = 1.f;
    __device__ __forceinline__ void operator()(const f32x4 (&acc)[2][2][4][2], const Unit& u, int wr, int wc, int fr, int fq) const {
        const int row0 = u.pm * BM + wr * 64 + fr; const int col0 = u.pn * BM + wc * 32 + 8 * fq;
#pragma unroll
        for (int ai = 0; ai < 2; ++ai)
#pragma unroll
            for (int m = 0; m < 4; ++m) { u16* rowp = O + (size_t)(row0 + ai * HALF + m * 16) * ldc + col0;
#pragma unroll
                for (int bj = 0; bj < 2; ++bj) { const f32x4 v0 = acc[ai][bj][m][0] * sc, v1 = acc[ai][bj][m][1] * sc;
                    u32x4 w; w.x = cvt_pk_bf16(v0[0], v0[1]); w.y = cvt_pk_bf16(v0[2], v0[3]); w.z = cvt_pk_bf16(v1[0], v1[1]); w.w = cvt_pk_bf16(v1[2], v1[3]);
                    *(u32x4*)(rowp + bj * HALF) = w; } }
    }
};
struct EpiSwiglu {
    u16* H; int ldc; int row_off; float isc = 1.f;
    __device__ __forceinline__ void operator()(const f32x4 (&acc)[2][2][4][2], const Unit& u, int wr, int wc, int fr, int fq) const {
        const int row0 = u.pm * BM - row_off + wr * 64 + fr; const int col0 = u.pn * HALF + wc * 32 + 8 * fq;
#pragma unroll
        for (int ai = 0; ai < 2; ++ai)
#pragma unroll
            for (int m = 0; m < 4; ++m) { u16* rowp = H + (size_t)(row0 + ai * HALF + m * 16) * ldc + col0;
                float o[8];
#pragma unroll
                for (int n = 0; n < 2; ++n)
#pragma unroll
                    for (int j = 0; j < 4; ++j) { const float ag = acc[ai][0][m][n][j], au = acc[ai][1][m][n][j]; o[n * 4 + j] = (ag * au) * ((isc * isc) * __builtin_amdgcn_rcpf(1.f + __builtin_amdgcn_exp2f(ag * (-1.4426950408889634f * isc)))); }
                u32x4 w; w.x = cvt_pk_bf16(o[0], o[1]); w.y = cvt_pk_bf16(o[2], o[3]); w.z = cvt_pk_bf16(o[4], o[5]); w.w = cvt_pk_bf16(o[6], o[7]);
                *(u32x4*)rowp = w; }
    }
};

typedef int i32x8 __attribute__((ext_vector_type(8)));
typedef int i32x4 __attribute__((ext_vector_type(4)));
__device__ __forceinline__ i32x8 cat8(bf16x8 a, bf16x8 b) { const i32x4 x = __builtin_bit_cast(i32x4, a), y = __builtin_bit_cast(i32x4, b); return __builtin_shufflevector(x, y, 0, 1, 2, 3, 4, 5, 6, 7); }
__device__ __forceinline__ float clamp448(float x) { return __builtin_amdgcn_fmed3f(x, -448.f, 448.f); }
__device__ __forceinline__ unsigned pk4_fp8(float a, float b, float c, float d) { int w = 0; w = __builtin_amdgcn_cvt_pk_fp8_f32(clamp448(a), clamp448(b), w, false); w = __builtin_amdgcn_cvt_pk_fp8_f32(clamp448(c), clamp448(d), w, true); return (unsigned)w; }
struct EpiSwiglu8 {
    unsigned char* H; int ldc; int row_off; float hsc; float isc;
    __device__ __forceinline__ void operator()(const f32x4 (&acc)[2][2][4][2], const Unit& u, int wr, int wc, int fr, int fq) const {
        const int row0 = u.pm * BM - row_off + wr * 64 + fr; const int col0 = u.pn * HALF + wc * 32 + 8 * fq; const float ce = -1.4426950408889634f * isc, cs = isc * isc * hsc;
#pragma unroll
        for (int ai = 0; ai < 2; ++ai)
#pragma unroll
            for (int m = 0; m < 4; ++m) { unsigned char* rowp = H + (size_t)(row0 + ai * HALF + m * 16) * ldc + col0;
                float o[8];
#pragma unroll
                for (int n = 0; n < 2; ++n)
#pragma unroll
                    for (int j = 0; j < 4; ++j) { const float ag = acc[ai][0][m][n][j], au = acc[ai][1][m][n][j];
                        o[n * 4 + j] = (ag * au) * (cs * __builtin_amdgcn_rcpf(1.f + __builtin_amdgcn_exp2f(ag * ce))); }
                u32x2 w; w.x = pk4_fp8(o[0], o[1], o[2], o[3]); w.y = pk4_fp8(o[4], o[5], o[6], o[7]);
                *(u32x2*)rowp = w; }
    }
};

template <class Epi, class Sched, bool FP8 = false, int SCW = 0x7F7F7F7F, int SCA = 0x7F7F7F7F>
__device__ __forceinline__ void gemm_phase(LAS unsigned char* lds, const int K, const Sched& S, const Epi& E, const int wave) {
    const int tid = tid_fresh(wave), wid = __builtin_amdgcn_readfirstlane(tid >> 6), lane = tid & 63, wr = wid >> 2, wc = wid & 3, fr = lane & 15, fq = lane >> 4;
    const int nt = K / BK;
    unsigned voffA[2], voffB[2];
#pragma unroll
    for (int i = 0; i < 2; ++i) { int R, C; stage_rc(tid * 16 + i * 8192, R, C); const int Rb = (R & ~31) + perm32(R & 31);
        voffA[i] = (unsigned)(R * K + C) * 2u; voffB[i] = (unsigned)(Rb * K + C) * 2u; }
    const size_t kstep = (size_t)(BK * 2);
    const size_t hstep = (size_t)HALF * K * 2;
    const unsigned ldsw = (unsigned)wid * 1024u;
    const int aoff = lds_byte(wr * 64 + fr, fq * 8), boff = lds_byte(wc * 32 + fr, fq * 8);
#define PG8_SA(b, h) (((b) * 2 + (h)) * HTB)
#define PG8_SB(b, h) ((4 + (b) * 2 + (h)) * HTB)
#define PG8_STAGE(bufoff, gbase, voff) do { _Pragma("unroll") for (int _i = 0; _i < 2; ++_i) \
        __builtin_amdgcn_global_load_lds((const unsigned*)((const char*)(gbase) + (voff)[_i]), (LAS unsigned*)(lds + (bufoff) + ldsw + _i * 8192), 16, 0, 0); } while (0)
#define PG8_LDA(dst, b, h) do { if (FP8) { _Pragma("unroll") for (int m = 0; m < 4; ++m) dst##8[m] = cat8(*(const LAS bf16x8*)(lds + PG8_SA(b, h) + aoff + m * 2048), *(const LAS bf16x8*)(lds + PG8_SA(b, h) + aoff + m * 2048 + 1024)); } \
        else { _Pragma("unroll") for (int m = 0; m < 4; ++m) _Pragma("unroll") for (int k = 0; k < 2; ++k) dst[m][k] = *(const LAS bf16x8*)(lds + PG8_SA(b, h) + aoff + m * 2048 + k * 1024); } } while (0)
#define PG8_LDB(dst, b, h) do { if (FP8) { _Pragma("unroll") for (int n = 0; n < 2; ++n) dst##8[n] = cat8(*(const LAS bf16x8*)(lds + PG8_SB(b, h) + boff + n * 2048), *(const LAS bf16x8*)(lds + PG8_SB(b, h) + boff + n * 2048 + 1024)); } \
        else { _Pragma("unroll") for (int n = 0; n < 2; ++n) _Pragma("unroll") for (int k = 0; k < 2; ++k) dst[n][k] = *(const LAS bf16x8*)(lds + PG8_SB(b, h) + boff + n * 2048 + k * 1024); } } while (0)
#define PG8_MMA(ai, bj, At, Bt) do { __builtin_amdgcn_s_setprio(1); \
        if (FP8) { _Pragma("unroll") for (int m = 0; m < 4; ++m) _Pragma("unroll") for (int n = 0; n < 2; ++n) \
            asm volatile("v_mfma_f32_16x16x128_f8f6f4 %0, %1, %2, %0" : "+v"(acc[ai][bj][m][n]) : "v"(Bt##8[n]), "v"(At##8[m])); } \
        else { _Pragma("unroll") for (int m = 0; m < 4; ++m) _Pragma("unroll") for (int n = 0; n < 2; ++n) _Pragma("unroll") for (int k = 0; k < 2; ++k) \
            acc[ai][bj][m][n] = __builtin_amdgcn_mfma_f32_16x16x32_bf16(Bt[n][k], At[m][k], acc[ai][bj][m][n], 0, 0, 0); } \
        __builtin_amdgcn_s_setprio(0); } while (0)
#define PG8_WAIT_V(n) asm volatile("s_waitcnt vmcnt(" #n ")" ::: "memory")
#define PG8_WAIT_L(n) asm volatile("s_waitcnt lgkmcnt(" #n ")" ::: "memory")
#define PG8_BAR __builtin_amdgcn_s_barrier()
#define PG8_SCHED __builtin_amdgcn_sched_barrier(0)
    Unit cur, nxt; int ui = 0;
    if (!S.next(0, cur)) return;
    f32x4 acc[2][2][4][2];
#pragma unroll
    for (int a = 0; a < 2; ++a)
#pragma unroll
        for (int b = 0; b < 2; ++b)
#pragma unroll
            for (int m = 0; m < 4; ++m)
#pragma unroll
                for (int n = 0; n < 2; ++n) acc[a][b][m][n] = (f32x4){0.f, 0.f, 0.f, 0.f};
    bf16x8 At[4][2], B0[2][2], B1[2][2]; i32x8 At8[4], B08[2], B18[2];
    const char* cA = S.a_ptr(cur); const char* cB = S.b_ptr(cur);
    PG8_STAGE(PG8_SB(0, 0), cB, voffB); PG8_STAGE(PG8_SA(0, 0), cA, voffA); PG8_STAGE(PG8_SB(0, 1), cB + hstep, voffB); PG8_STAGE(PG8_SA(0, 1), cA + hstep, voffA);
    if (wr == 1) PG8_BAR;
    PG8_WAIT_V(4); PG8_BAR;
    PG8_STAGE(PG8_SB(1, 0), cB + kstep, voffB); PG8_STAGE(PG8_SA(1, 0), cA + kstep, voffA); PG8_STAGE(PG8_SB(1, 1), cB + hstep + kstep, voffB);
    PG8_WAIT_V(6); PG8_BAR;
    for (;;) {
        const bool has_next = S.next(ui + 1, nxt);
        const char* nA = has_next ? S.a_ptr(nxt) : cA; const char* nB = has_next ? S.b_ptr(nxt) : cB;
        for (int t = 0; t < nt; t += 2) {
            const bool last = (t == nt - 2);
            const char* a1 = cA + (size_t)(t + 1) * kstep;
            const char* a2 = last ? nA : cA + (size_t)(t + 2) * kstep; const char* b2 = last ? nB : cB + (size_t)(t + 2) * kstep;
            const char* a3 = a2 + kstep; const char* b3 = b2 + kstep;
            PG8_LDB(B0, 0, 0); PG8_SCHED; PG8_LDA(At, 0, 0); PG8_STAGE(PG8_SA(1, 1), a1 + hstep, voffA);
            PG8_WAIT_L(8); PG8_BAR; PG8_WAIT_L(0); PG8_MMA(0, 0, At, B0); PG8_BAR; PG8_SCHED;
            PG8_LDB(B1, 0, 1); PG8_STAGE(PG8_SB(0, 0), b2, voffB);
            PG8_BAR; PG8_WAIT_L(0); PG8_MMA(0, 1, At, B1); PG8_BAR;
            PG8_LDA(At, 0, 1); PG8_STAGE(PG8_SA(0, 0), a2, voffA);
            PG8_BAR; PG8_WAIT_L(0); PG8_MMA(1, 0, At, B0); PG8_BAR; PG8_SCHED;
            PG8_STAGE(PG8_SB(0, 1), b2 + hstep, voffB);
            PG8_WAIT_V(6); PG8_BAR; PG8_MMA(1, 1, At, B1); PG8_BAR;
            PG8_LDB(B0, 1, 0); PG8_SCHED; PG8_LDA(At, 1, 0); PG8_STAGE(PG8_SA(0, 1), a2 + hstep, voffA);
            PG8_WAIT_L(8); PG8_BAR; PG8_WAIT_L(0); PG8_MMA(0, 0, At, B0); PG8_BAR; PG8_SCHED;
            PG8_LDB(B1, 1, 1); PG8_STAGE(PG8_SB(1, 0), b3, voffB);
            PG8_BAR; PG8_WAIT_L(0); PG8_MMA(0, 1, At, B1); PG8_BAR;
            PG8_LDA(At, 1, 1); PG8_STAGE(PG8_SA(1, 0), a3, voffA);
            PG8_BAR; PG8_WAIT_L(0); PG8_MMA(1, 0, At, B0); PG8_BAR; PG8_SCHED;
            PG8_STAGE(PG8_SB(1, 1), b3 + hstep, voffB);
            PG8_WAIT_V(6); PG8_BAR; PG8_MMA(1, 1, At, B1); PG8_BAR;
        }
        if (FP8) asm volatile("s_nop 15\n\ts_nop 7" ::: "memory");
        E(acc, cur, wr, wc, fr, fq);
        if (!has_next) break;
#pragma unroll
        for (int a = 0; a < 2; ++a)
#pragma unroll
            for (int b = 0; b < 2; ++b)
#pragma unroll
                for (int m = 0; m < 4; ++m)
#pragma unroll
                    for (int n = 0; n < 2; ++n) acc[a][b][m][n] = (f32x4){0.f, 0.f, 0.f, 0.f};
        cur = nxt; cA = nA; cB = nB; ++ui;
    }
    PG8_WAIT_V(0);
    if (wr == 0) PG8_BAR;
    PG8_BAR;
#undef PG8_SA
#undef PG8_SB
#undef PG8_STAGE
#undef PG8_LDA
#undef PG8_LDB
#undef PG8_MMA
#undef PG8_WAIT_V
#undef PG8_WAIT_L
#undef PG8_BAR
#undef PG8_SCHED
}
}
__device__ __forceinline__ int zcol_to_orig(int n) {
    if (n < 1152) return n;
    if (n < 1536) return 1170 + (n - 1152);
    if (n < 1664) return 1554 + (n - 1536);
    if (n < 1792) return 1682 + (n - 1664);
    if (n < 1824) return 1810 + (n - 1792);
    if (n < 2336) return 1846 + (n - 1824);
    if (n < 2354) return 1152 + (n - 2336);
    if (n < 2360) return -1;
    if (n < 2364) return 1842 + (n - 2360);
    return -1;
}
__constant__ float ROPE_INV[32] = {1.f, 0.749894261f, 0.562341332f, 0.421696514f, 0.316227764f, 0.237137377f, 0.177827939f, 0.133352131f, 0.100000001f, 0.0749894157f, 0.0562341325f, 0.0421696529f, 0.0316227749f, 0.0237137377f, 0.0177827943f, 0.0133352149f,
    0.00999999978f, 0.00749894185f, 0.00562341325f, 0.00421696482f, 0.00316227763f, 0.00237137359f, 0.00177827943f, 0.00133352145f, 0.00100000005f, 0.000749894243f, 0.000562341302f, 0.000421696517f, 0.000316227757f, 0.00023713737f, 0.00017782794f, 0.00013335215f};
template <class F, bool OUT8 = false> __device__ __forceinline__ void conv_tile(LAS float* tile, const F srcp, int ld, int n0, int k0, void* dstv, int K, int wave, float sc = 1.f) {
    const int tid = tid_fresh(wave);
    { const int nn = tid & 63, kk = tid >> 6; const float* p = srcp(n0 + nn); float v[16];
#pragma unroll
      for (int ps = 0; ps < 16; ++ps) v[ps] = p ? p[(size_t)(k0 + ps * 8 + kk) * ld] : 0.f;
#pragma unroll
      for (int ps = 0; ps < 16; ++ps) tile[(ps * 8 + kk) * 65 + nn] = v[ps]; }
    __syncthreads();
    if (OUT8) { const int nn = tid >> 3, kc = tid & 7; float v[16];
#pragma unroll
      for (int i = 0; i < 16; ++i) v[i] = tile[(kc * 16 + i) * 65 + nn] * sc;
      u32x4 w; w.x = pg8::pk4_fp8(v[0], v[1], v[2], v[3]); w.y = pg8::pk4_fp8(v[4], v[5], v[6], v[7]); w.z = pg8::pk4_fp8(v[8], v[9], v[10], v[11]); w.w = pg8::pk4_fp8(v[12], v[13], v[14], v[15]);
      *(u32x4*)((unsigned char*)dstv + (size_t)(n0 + nn) * K + k0 + kc * 16) = w;
    } else { u16* dst = (u16*)dstv;
#pragma unroll
    for (int hf = 0; hf < 2; ++hf) { const int nn = tid >> 3, kc = (tid & 7) + 8 * hf; float v[8];
#pragma unroll
      for (int i = 0; i < 8; ++i) v[i] = tile[(kc * 8 + i) * 65 + nn];
      u32x4 w; w.x = cvt_pk_bf16(v[0], v[1]); w.y = cvt_pk_bf16(v[2], v[3]); w.z = cvt_pk_bf16(v[4], v[5]); w.w = cvt_pk_bf16(v[6], v[7]);
      *(u32x4*)(dst + (size_t)(n0 + nn) * K + k0 + kc * 8) = w; } }
    __syncthreads();
}
struct SrcPlain { const float* base; __device__ __forceinline__ const float* operator()(int n) const { return base + n; } };
struct SrcWin { const float* base; __device__ __forceinline__ const float* operator()(int n) const { const int o = zcol_to_orig(n); return o < 0 ? nullptr : base + o; } };
struct SrcGU { const float* g; const float* u; __device__ __forceinline__ const float* operator()(int n) const { const int pn = n >> 8, bj = (n >> 7) & 1, j = n & 127; const uintptr_t a = (uintptr_t)g, d = (uintptr_t)u - (uintptr_t)g; return (const float*)(a + (uintptr_t)bj * d) + pn * 128 + j; } };

constexpr int PJ_WIN = 0, PJ_WOUT = PJ_WIN + 2 * 40 * 8, PJ_WGU = PJ_WOUT + 2 * 16 * 8, PJ_WDN = PJ_WGU + 88 * 8, PJ_CW1 = PJ_WDN + 16 * 22, PJ_MOD = PJ_CW1 + 4 * 16,
              PJ_ROPE = PJ_MOD + 192, PJ_CB1 = PJ_ROPE + 256, PJ_SGW = PJ_CB1 + 4, PJ_WKV = PJ_SGW + 64, PJ_END = PJ_WKV + 2 * 16;

struct ConvJob { const float* src; int ld, k0, n0, K, out8, skip; void* dst; float sc; };
__device__ __forceinline__ ConvJob conv_decode(const Params& p, int job, int nn) {
    ConvJob J; J.out8 = 0; J.skip = 0; J.sc = 1.f; char* ws = p.ws;
    if (job < PJ_WOUT) { const int j = job - PJ_WIN, layer = j / 320, r = j % 320, nt = r / 8, kt = r % 8;
        J.skip = (nt == 37 || nt == 38);
        SrcWin s{p.w_in + (size_t)layer * D * INW}; J.n0 = nt * 64; J.src = s(J.n0 + nn); J.ld = INW; J.k0 = kt * 128; J.dst = (u16*)(ws + OFF_WIN) + (size_t)layer * ZP * D; J.K = D;
    } else if (job < PJ_WGU) { const int j = job - PJ_WOUT, layer = j / 128, r = j % 128, nt = r / 8, kt = r % 8;
        SrcPlain s{p.w_out + (size_t)layer * D * D}; J.n0 = nt * 64; J.src = s(J.n0 + nn); J.ld = D; J.k0 = kt * 128; J.dst = (u16*)(ws + OFF_WOUT) + (size_t)layer * D * D; J.K = D;
    } else if (job < PJ_WDN) { const int j = job - PJ_WGU, nt = j / 8, kt = j % 8;
        SrcGU s{p.fg, p.fu}; J.n0 = nt * 64; J.src = s(J.n0 + nn); J.ld = DFF; J.k0 = kt * 128; J.dst = ws + OFF_WGU; J.K = D; if (FFN0_FP8) { J.out8 = 1; J.sc = WSC_UP; }
    } else if (job < PJ_CW1) { const int j = job - PJ_WDN, nt = j / 22, kt = j % 22;
        SrcPlain s{p.fd}; J.n0 = nt * 64; J.src = s(J.n0 + nn); J.ld = D; J.k0 = kt * 128; J.dst = ws + OFF_WDN; J.K = DFF; if (FFN0_FP8 == 2) { J.out8 = 1; J.sc = WSC_DN; }
    } else { const int j = job - PJ_CW1, mat = j / 16, kt = j % 16;
        SrcPlain s{p.cmp_w1 + (size_t)mat * 2048 * 64}; J.n0 = 0; J.src = s(nn); J.ld = 64; J.k0 = kt * 128; J.dst = (u16*)(ws + OFF_CW1T) + (size_t)mat * 64 * 2048; J.K = 2048; }
    return J; }
__device__ __forceinline__ void conv_load(const ConvJob& J, int kk, float (&v)[16]) {
#pragma unroll
    for (int ps = 0; ps < 16; ++ps) v[ps] = J.src ? J.src[(size_t)(J.k0 + ps * 8 + kk) * J.ld] : 0.f; }
__device__ __forceinline__ void conv_finish(LAS float* tile, const ConvJob& J, const float (&v)[16], int tid) {
    { const int nn = tid & 63, kk = tid >> 6;
#pragma unroll
      for (int ps = 0; ps < 16; ++ps) tile[(ps * 8 + kk) * 65 + nn] = v[ps]; }
    __syncthreads();
    if (J.out8) { const int nn = tid >> 3, kc = tid & 7; float x[16];
#pragma unroll
      for (int i = 0; i < 16; ++i) x[i] = tile[(kc * 16 + i) * 65 + nn] * J.sc;
      u32x4 w; w.x = pg8::pk4_fp8(x[0], x[1], x[2], x[3]); w.y = pg8::pk4_fp8(x[4], x[5], x[6], x[7]); w.z = pg8::pk4_fp8(x[8], x[9], x[10], x[11]); w.w = pg8::pk4_fp8(x[12], x[13], x[14], x[15]);
      *(u32x4*)((unsigned char*)J.dst + (size_t)(J.n0 + nn) * J.K + J.k0 + kc * 16) = w;
    } else { u16* dst = (u16*)J.dst;
#pragma unroll
      for (int hf = 0; hf < 2; ++hf) { const int nn = tid >> 3, kc = (tid & 7) + 8 * hf; float x[8];
#pragma unroll
        for (int i = 0; i < 8; ++i) x[i] = tile[(kc * 8 + i) * 65 + nn];
        u32x4 w; w.x = cvt_pk_bf16(x[0], x[1]); w.y = cvt_pk_bf16(x[2], x[3]); w.z = cvt_pk_bf16(x[4], x[5]); w.w = cvt_pk_bf16(x[6], x[7]);
        *(u32x4*)(dst + (size_t)(J.n0 + nn) * J.K + J.k0 + kc * 8) = w; } }
    __syncthreads();
}
__device__ __forceinline__ void prologue_job(const Params& p, int job, LAS unsigned char* lds);
__device__ __forceinline__ void prologue_all(const Params& p, int c, int G, LAS unsigned char* lds) {
    const int tid = tid_fresh(p.wave), nn = tid & 63, kk = tid >> 6; LAS float* tile = (LAS float*)lds;
    float v[16]; int jp = -1;
    for (int j = c; j < PJ_END; j += G) {
        if (j >= PJ_MOD) { prologue_job(p, j, lds); continue; }
        const ConvJob J = conv_decode(p, j, nn); if (J.skip) continue;
        if (jp != j) conv_load(J, kk, v);
        float w[16]; int jn = -1; { const int jx = j + G; if (jx < PJ_MOD) { const ConvJob N = conv_decode(p, jx, nn); if (!N.skip) { conv_load(N, kk, w); jn = jx; } } }
        conv_finish(tile, J, v, tid);
        if (jn >= 0) {
#pragma unroll
            for (int i = 0; i < 16; ++i) v[i] = w[i];
            jp = jn; }
    }
}
__device__ __forceinline__ void prologue_job(const Params& p, int job, LAS unsigned char* lds) {
    char* ws = p.ws; const int tid = tid_fresh(p.wave);
    LAS float* tile = (LAS float*)lds;
    if (job < PJ_WOUT) { const int j = job - PJ_WIN, layer = j / 320, r = j % 320, nt = r / 8, kt = r % 8;
        if (nt == 37 || nt == 38) return;
        SrcWin s{p.w_in + (size_t)layer * D * INW}; conv_tile(tile, s, INW, nt * 64, kt * 128, (u16*)(ws + OFF_WIN) + (size_t)layer * ZP * D, D, p.wave);
    } else if (job < PJ_WGU) { const int j = job - PJ_WOUT, layer = j / 128, r = j % 128, nt = r / 8, kt = r % 8;
        SrcPlain s{p.w_out + (size_t)layer * D * D}; conv_tile(tile, s, D, nt * 64, kt * 128, (u16*)(ws + OFF_WOUT) + (size_t)layer * D * D, D, p.wave);
    } else if (job < PJ_WDN) { const int j = job - PJ_WGU, nt = j / 8, kt = j % 8;
        SrcGU s{p.fg, p.fu};
        if (FFN0_FP8) conv_tile<SrcGU, true>(tile, s, DFF, nt * 64, kt * 128, ws + OFF_WGU, D, p.wave, WSC_UP); else conv_tile(tile, s, DFF, nt * 64, kt * 128, (u16*)(ws + OFF_WGU), D, p.wave);
    } else if (job < PJ_CW1) { const int j = job - PJ_WDN, nt = j / 22, kt = j % 22;
        SrcPlain s{p.fd};
        if (FFN0_FP8 == 2) conv_tile<SrcPlain, true>(tile, s, D, nt * 64, kt * 128, ws + OFF_WDN, DFF, p.wave, WSC_DN); else conv_tile(tile, s, D, nt * 64, kt * 128, (u16*)(ws + OFF_WDN), DFF, p.wave);
    } else if (job < PJ_MOD) { const int j = job - PJ_CW1, mat = j / 16, kt = j % 16;
        SrcPlain s{p.cmp_w1 + (size_t)mat * 2048 * 64}; conv_tile(tile, s, 64, 0, kt * 128, (u16*)(ws + OFF_CW1T) + (size_t)mat * 64 * 2048, 2048, p.wave);
    } else if (job < PJ_ROPE) {
        const int j = job - PJ_MOD, layer = j / 96, cg = j % 96;
        LAS float* cact = (LAS float*)lds;
        LAS float* red = cact + 8 * 1024;
        for (int i = tid; i < 8 * 1024; i += NTHR) { const float v = p.c[i]; cact[i] = v / (1.f + __expf(-v)); }
        __syncthreads();
        const int col = tid & 63, kg = tid >> 6; float acc[8];
#pragma unroll
        for (int b = 0; b < 8; ++b) acc[b] = 0.f;
        const float* w = p.w_ada + (size_t)layer * D * 6144 + cg * 64 + col;
#pragma unroll 16
        for (int k = kg; k < 1024; k += 8) { const float wv = w[(size_t)k * 6144];
#pragma unroll
            for (int b = 0; b < 8; ++b) acc[b] = fmaf(cact[b * 1024 + k], wv, acc[b]); }
#pragma unroll
        for (int b = 0; b < 8; ++b) red[(kg * 8 + b) * 64 + col] = acc[b];
        __syncthreads();
        { const int b = tid >> 6; float s = 0.f;
#pragma unroll
          for (int g = 0; g < 8; ++g) s += red[(g * 8 + b) * 64 + col];
          ((float*)(ws + OFF_MOD))[((size_t)layer * 8 + b) * 6144 + cg * 64 + col] = s + p.b_ada[layer * 6144 + cg * 64 + col]; }
        __syncthreads();
    } else if (job < PJ_CB1) {
        const int j = job - PJ_ROPE;
        float* ch = (float*)(ws + OFF_COSH); float* sh = (float*)(ws + OFF_SINH); float* ci = (float*)(ws + OFF_COSI); float* si = (float*)(ws + OFF_SINI);
        for (int e = tid; e < 128 * 32; e += NTHR) { const int row = j * 128 + (e >> 5), i = e & 31; const float ang = (float)p.pos[row] * ROPE_INV[i];
            const double rev = (double)ang * 0.15915494309189535; const float fr = (float)(rev - floor(rev));
            ch[(size_t)row * 32 + i] = __builtin_amdgcn_cosf(fr); sh[(size_t)row * 32 + i] = __builtin_amdgcn_sinf(fr); }
        for (int e = tid; e < 128 * 16; e += NTHR) { const int row = j * 128 + (e >> 4), i = e & 15; const float ang = (float)p.pos[row] * ROPE_INV[2 * i];
            const double rev = (double)ang * 0.15915494309189535; const float fr = (float)(rev - floor(rev));
            ci[(size_t)row * 16 + i] = __builtin_amdgcn_cosf(fr); si[(size_t)row * 16 + i] = __builtin_amdgcn_sinf(fr); }
    } else if (job < PJ_SGW) {
        const int mat = job - PJ_CB1; LAS float* red = (LAS float*)lds;
        const int e = tid & 63, kg = tid >> 6; float s = 0.f;
        const float* w = p.cmp_w1 + (size_t)mat * 2048 * 64; const float* ps = p.cmp_pos + (size_t)mat * 2048;
#pragma unroll 16
        for (int k = kg * 256; k < kg * 256 + 256; ++k) s = fmaf(ps[k], w[(size_t)k * 64 + e], s);
        red[kg * 64 + e] = s; __syncthreads();
        if (tid < 64) { float t = 0.f;
#pragma unroll
            for (int g = 0; g < 8; ++g) t += red[g * 64 + tid];
            ((float*)(ws + OFF_CB1))[mat * 64 + tid] = t; }
        __syncthreads();
    } else if (job >= PJ_WKV) {
        const int j = job - PJ_WKV, layer = j / 16, kb = j % 16;
        LAS float* Aw = (LAS float*)lds; LAS float* Wg = Aw + 64 * 128;
        for (int i = tid; i < 64 * 128; i += NTHR) Aw[i] = p.w_in[((size_t)layer * D + kb * 64 + (i >> 7)) * INW + 1554 + (i & 127)];
        for (int i = tid; i < 128 * 128; i += NTHR) { const int c = i >> 7, n = i & 127; Wg[i] = p.kvn[layer * 128 + c] * (n < 64 ? p.w_uk[((size_t)layer * 128 + c) * 64 + n] : p.w_uv[((size_t)layer * 128 + c) * 64 + n - 64]); }
        __syncthreads();
        { const int n = tid & 127, kq = tid >> 7; float acc[16];
#pragma unroll
          for (int i = 0; i < 16; ++i) acc[i] = 0.f;
          for (int c = 0; c < 128; ++c) { const float w = Wg[c * 128 + n];
#pragma unroll
              for (int i = 0; i < 16; ++i) acc[i] = fmaf(Aw[(kq * 16 + i) * 128 + c], w, acc[i]); }
          u16* dst = (u16*)(ws + OFF_WIN) + (size_t)layer * ZP * D + (size_t)(2368 + n) * D + kb * 64 + kq * 16;
          u32x4 w0, w1; w0.x = cvt_pk_bf16(acc[0], acc[1]); w0.y = cvt_pk_bf16(acc[2], acc[3]); w0.z = cvt_pk_bf16(acc[4], acc[5]); w0.w = cvt_pk_bf16(acc[6], acc[7]);
          w1.x = cvt_pk_bf16(acc[8], acc[9]); w1.y = cvt_pk_bf16(acc[10], acc[11]); w1.z = cvt_pk_bf16(acc[12], acc[13]); w1.w = cvt_pk_bf16(acc[14], acc[15]);
          *(u32x4*)dst = w0; *(u32x4*)(dst + 8) = w1; }
        __syncthreads();
    } else {
        const int j = job - PJ_SGW; u16* dst = (u16*)(ws + OFF_SGW);
        for (int e = j * 2048 + tid; e < j * 2048 + 2048; e += NTHR) { const int t = (e >> 7) & 127, s = e & 127; dst[e] = f2bf(s <= t ? p.sgu_w[e] : 0.f); }
    }
}
constexpr int MJ_W1 = 0, MJ_W2 = NEXP * 112 * 4, MJ_END = MJ_W2 + NEXP * 16 * 14;
struct MoeConvJob { const float* src; unsigned char* dst; int ld, K; float sc; };
__device__ __forceinline__ MoeConvJob moe_conv_decode(const Params& p, int job, int tid) {
    MoeConvJob J; const int nn = tid & 63;
    if (job < MJ_W2) { const int e = job / 448, r = job % 448, nt = r / 4, kt = r % 4; const int n = nt * 64 + nn; const int pn = n >> 8, bj = (n >> 7) & 1, j = n & 127;
        const uintptr_t a = (uintptr_t)(p.mg + (size_t)e * D * EFF), dlt = (uintptr_t)(p.mu + (size_t)e * D * EFF) - a;
        J.src = (const float*)(a + (uintptr_t)bj * dlt) + pn * 128 + j + (size_t)(kt * 256) * EFF; J.ld = EFF; J.K = D; J.sc = WSC_UP; J.dst = (unsigned char*)(p.ws + OFF_MW1) + (size_t)e * 2 * EFF * D + (size_t)(nt * 64) * D + kt * 256;
    } else { const int jj = job - MJ_W2, e = jj / 224, r = jj % 224, nt = r / 14, kt = r % 14;
        J.src = p.md + (size_t)e * EFF * D + nt * 64 + nn + (size_t)(kt * 256) * D; J.ld = D; J.K = EFF; J.sc = WSC_DN; J.dst = (unsigned char*)(p.ws + OFF_MW2) + (size_t)e * D * EFF + (size_t)(nt * 64) * EFF + kt * 256; }
    return J;
}
__device__ __forceinline__ void moe_conv_all(const Params& p, LAS unsigned char* lds) {
    const int tid = tid_fresh(p.wave), kk = tid >> 6, nn = tid & 63, G = gridDim.x; LAS float* tile = (LAS float*)lds;
    int job = blockIdx.x; if (job >= MJ_END) return;
    MoeConvJob J = moe_conv_decode(p, job, tid); float v[32];
#pragma unroll
    for (int ps = 0; ps < 32; ++ps) v[ps] = J.src[(size_t)(ps * 8 + kk) * J.ld];
    for (;;) { const int nj = job + G; const bool more = nj < MJ_END; MoeConvJob N = J; float w[32];
        if (more) { N = moe_conv_decode(p, nj, tid);
#pragma unroll
            for (int ps = 0; ps < 32; ++ps) w[ps] = N.src[(size_t)(ps * 8 + kk) * N.ld]; }
#pragma unroll
        for (int ps = 0; ps < 32; ++ps) tile[(ps * 8 + kk) * 65 + nn] = v[ps];
        __syncthreads();
        { const int n2 = tid >> 3, kc = tid & 7;
#pragma unroll
          for (int hf = 0; hf < 2; ++hf) { float x[16];
#pragma unroll
              for (int i = 0; i < 16; ++i) x[i] = tile[(kc * 32 + hf * 16 + i) * 65 + n2] * J.sc;
              u32x4 o; o.x = pg8::pk4_fp8(x[0], x[1], x[2], x[3]); o.y = pg8::pk4_fp8(x[4], x[5], x[6], x[7]); o.z = pg8::pk4_fp8(x[8], x[9], x[10], x[11]); o.w = pg8::pk4_fp8(x[12], x[13], x[14], x[15]);
              *(u32x4*)(J.dst + (size_t)n2 * J.K + kc * 32 + hf * 16) = o; } }
        __syncthreads();
        if (!more) break;
        job = nj; J = N;
#pragma unroll
        for (int ps = 0; ps < 32; ++ps) v[ps] = w[ps];
    }
}
__device__ __forceinline__ void row_stats(const f32x4 (&v)[4], float& mu, float& rstd) {
    float s = 0.f;
#pragma unroll
    for (int i = 0; i < 4; ++i) s += (v[i][0] + v[i][1]) + (v[i][2] + v[i][3]);
    s = wave_sum(s); mu = s * (1.f / 1024.f); float q = 0.f;
#pragma unroll
    for (int i = 0; i < 4; ++i) { const f32x4 d = v[i] - mu; q += (d[0] * d[0] + d[1] * d[1]) + (d[2] * d[2] + d[3] * d[3]); }
    q = wave_sum(q); rstd = rsqrtf(q * (1.f / 1024.f) + 1e-5f);
}
__device__ __forceinline__ void ld_row_f32(const float* p, int lane, f32x4 (&v)[4]) {
#pragma unroll
    for (int i = 0; i < 4; ++i) v[i] = *(const f32x4*)(p + i * 256 + lane * 4); }
__device__ __forceinline__ void ld_row_bf16(const u16* p, int lane, f32x4 (&v)[4]) {
#pragma unroll
    for (int i = 0; i < 4; ++i) { const u32x2 w = *(const u32x2*)(p + i * 256 + lane * 4); v[i] = (f32x4){bflo(w.x), bfhi(w.x), bflo(w.y), bfhi(w.y)}; } }
__device__ __forceinline__ void st_row_bf16(u16* p, int lane, const f32x4 (&v)[4]) {
#pragma unroll
    for (int i = 0; i < 4; ++i) { u32x2 w; w.x = cvt_pk_bf16(v[i][0], v[i][1]); w.y = cvt_pk_bf16(v[i][2], v[i][3]); *(u32x2*)(p + i * 256 + lane * 4) = w; } }
__device__ __forceinline__ void st_row_fp8(unsigned char* p, int lane, const f32x4 (&v)[4]) {
#pragma unroll
    for (int i = 0; i < 4; ++i) *(unsigned*)(p + i * 256 + lane * 4) = pg8::pk4_fp8(v[i][0] * ASC, v[i][1] * ASC, v[i][2] * ASC, v[i][3] * ASC); }
template <bool BF> struct XRaw { typedef f32x4 T; };
template <> struct XRaw<true> { typedef u32x2 T; };
template <bool BF> __device__ __forceinline__ void ldx(const void* base, size_t row, int lane, typename XRaw<BF>::T (&r)[4]) {
#pragma unroll
    for (int i = 0; i < 4; ++i) { if constexpr (BF) r[i] = *(const u32x2*)((const u16*)base + row * D + i * 256 + lane * 4); else r[i] = *(const f32x4*)((const float*)base + row * D + i * 256 + lane * 4); } }
__device__ __forceinline__ f32x4 cvx(const f32x4 r) { return r; }
__device__ __forceinline__ f32x4 cvx(const u32x2 r) { return (f32x4){bflo(r.x), bfhi(r.x), bflo(r.y), bfhi(r.y)}; }
__device__ __forceinline__ void st_row_f32(float* p, int lane, const f32x4 (&v)[4]) {
#pragma unroll
    for (int i = 0; i < 4; ++i) *(f32x4*)(p + i * 256 + lane * 4) = v[i]; }
__device__ __forceinline__ void modulate_row(const f32x4 (&v)[4], const float* shift, const float* scale, int lane, f32x4 (&h)[4]) {
    float mu, rstd; row_stats(v, mu, rstd);
#pragma unroll
    for (int i = 0; i < 4; ++i) { const f32x4 sc = *(const f32x4*)(scale + i * 256 + lane * 4), sh = *(const f32x4*)(shift + i * 256 + lane * 4); h[i] = (v[i] - mu) * rstd * (sc + 1.f) + sh; } }
__device__ __forceinline__ void layernorm_row(f32x4 (&v)[4], const float* g, const float* b, int lane) {
    float mu, rstd; row_stats(v, mu, rstd);
#pragma unroll
    for (int i = 0; i < 4; ++i) { const f32x4 gg = *(const f32x4*)(g + i * 256 + lane * 4), bb = *(const f32x4*)(b + i * 256 + lane * 4); v[i] = (v[i] - mu) * rstd * gg + bb; } }

__device__ __forceinline__ void modulate_regs(const f32x4 (&v)[4], const f32x4 (&sh)[4], const f32x4 (&sc)[4], f32x4 (&h)[4]) {
    float mu, rstd; row_stats(v, mu, rstd);
#pragma unroll
    for (int i = 0; i < 4; ++i) h[i] = (v[i] - mu) * rstd * (sc[i] + 1.f) + sh[i]; }
__device__ __forceinline__ void layernorm_regs(f32x4 (&v)[4], const f32x4 (&g)[4], const f32x4 (&b)[4]) {
    float mu, rstd; row_stats(v, mu, rstd);
#pragma unroll
    for (int i = 0; i < 4; ++i) v[i] = (v[i] - mu) * rstd * g[i] + b[i]; }

__device__ __forceinline__ void phase_lnmod0(const Params& p) {
    const int tid = tid_fresh(p.wave); const int lane = tid & 63, wid = tid >> 6; u16* H = (u16*)(p.ws + OFF_RH); const float* mod = (const float*)(p.ws + OFF_MOD);
    for (int vb = blockIdx.x; vb < 256; vb += gridDim.x) { const int b = (vb * 128) / SEQ; const float* mb = mod + (size_t)b * 6144;
        f32x4 sh[4], sc[4], na[4], nb[4]; ld_row_f32(mb + 0 * 1024, lane, sh); ld_row_f32(mb + 1 * 1024, lane, sc);
        const int r0 = vb * 128 + wid; ld_row_f32(p.x + (size_t)r0 * D, lane, na); ld_row_f32(p.x + (size_t)(r0 + 8) * D, lane, nb);
        for (int i = 0; i < 16; ++i) { const int row = r0 + i * 8; f32x4 v[4], h[4];
#pragma unroll
            for (int k = 0; k < 4; ++k) { v[k] = na[k]; na[k] = nb[k]; }
            if (i + 2 < 16) ld_row_f32(p.x + (size_t)(row + 16) * D, lane, nb);
            modulate_regs(v, sh, sc, h);
            st_row_bf16(H + (size_t)row * D, lane, h); } }
}
template <bool XBF> __device__ __forceinline__ void phase_ln1_t(const Params& p, int layer, LAS unsigned char* lds) {
    const int tid = tid_fresh(p.wave); const int lane = tid & 63, wid = tid >> 6; const bool moe = (layer & 1) != 0;
    const void* xin = XBF ? (const void*)(p.ws + OFF_XR) : (const void*)p.x; u16* XR = (u16*)(p.ws + OFF_XR); const u16* mix = (const u16*)(p.ws + OFF_RZ); u16* H = (u16*)(p.ws + OFF_RH);
    const float* mod = (const float*)(p.ws + OFF_MOD) + (size_t)layer * 8 * 6144;
    LAS int* hist = (LAS int*)lds; LAS float* wrt = (LAS float*)(lds + 64);
    if (moe) { for (int i = tid; i < 8192; i += NTHR) wrt[(i & 7) * 1024 + (i >> 3)] = p.mr[i]; __syncthreads(); }
    f32x4 lg1[4], lb1[4]; ld_row_f32(p.ln1g + layer * D, lane, lg1); ld_row_f32(p.ln1b + layer * D, lane, lb1);
    for (int vb = blockIdx.x; vb < 256; vb += gridDim.x) { const int b = (vb * 128) / SEQ; const float* mb = mod + (size_t)b * 6144;
        if (moe) { if (tid < 8) hist[tid] = 0; __syncthreads(); }
        f32x4 g1[4], sh[4], sc[4]; ld_row_f32(mb + 2 * 1024, lane, g1); ld_row_f32(mb + 3 * 1024, lane, sh); ld_row_f32(mb + 4 * 1024, lane, sc);
        typename XRaw<XBF>::T nv[4], nv2[4]; u32x2 nm[4], nm2[4];
        { const int r0 = vb * 128 + wid; ldx<XBF>(xin, (size_t)r0, lane, nv); ldx<XBF>(xin, (size_t)(r0 + 8), lane, nv2);
#pragma unroll
            for (int k = 0; k < 4; ++k) { nm[k] = *(const u32x2*)(mix + (size_t)r0 * D + k * 256 + lane * 4); nm2[k] = *(const u32x2*)(mix + (size_t)(r0 + 8) * D + k * 256 + lane * 4); } }
        for (int i = 0; i < 16; ++i) { const int row = vb * 128 + i * 8 + wid;
            f32x4 v[4], h[4];
#pragma unroll
            for (int k = 0; k < 4; ++k) { const f32x4 mx = (f32x4){bflo(nm[k].x), bfhi(nm[k].x), bflo(nm[k].y), bfhi(nm[k].y)}; v[k] = cvx(nv[k]) * ALPHA + g1[k] * mx; nv[k] = nv2[k]; nm[k] = nm2[k]; }
            if (i + 2 < 16) { const int rn = row + 16; ldx<XBF>(xin, (size_t)rn, lane, nv2);
#pragma unroll
                for (int k = 0; k < 4; ++k) nm2[k] = *(const u32x2*)(mix + (size_t)rn * D + k * 256 + lane * 4); }
            layernorm_regs(v, lg1, lb1);
            st_row_bf16(XR + (size_t)row * D, lane, v);
            modulate_regs(v, sh, sc, h);
            if (!moe) { if (FFN0_FP8) st_row_fp8((unsigned char*)H + (size_t)row * D, lane, h); else st_row_bf16(H + (size_t)row * D, lane, h); }
            else {
                float lg[8];
#pragma unroll
                for (int e = 0; e < 8; ++e) { float a = 0.f;
#pragma unroll
                    for (int k = 0; k < 4; ++k) { const f32x4 w = *(const LAS f32x4*)(wrt + e * 1024 + k * 256 + lane * 4); a = fmaf(h[k][0], w[0], a); a = fmaf(h[k][1], w[1], a); a = fmaf(h[k][2], w[2], a); a = fmaf(h[k][3], w[3], a); }
                    lg[e] = wave_sum(a) + p.mbr[e]; }
                int e0 = 0; float v0 = lg[0];
#pragma unroll
                for (int e = 1; e < 8; ++e) if (lg[e] > v0) { v0 = lg[e]; e0 = e; }
                int e1 = -1; float v1 = -INFINITY;
#pragma unroll
                for (int e = 0; e < 8; ++e) if (e != e0 && (e1 < 0 || lg[e] > v1)) { v1 = lg[e]; e1 = e; }
                const float ex = __expf(v1 - v0), w0 = 1.f / (1.f + ex), w1 = ex / (1.f + ex);
                if (lane == 0) { int4 ti; ti.x = e0 | (e1 << 8); ti.y = __float_as_int(w0); ti.z = __float_as_int(w1); ti.w = 0; ((int4*)(p.ws + OFF_TOK))[row] = ti;
                    __hip_atomic_fetch_add(hist + e0, 1, __ATOMIC_RELAXED, __HIP_MEMORY_SCOPE_WORKGROUP); __hip_atomic_fetch_add(hist + e1, 1, __ATOMIC_RELAXED, __HIP_MEMORY_SCOPE_WORKGROUP); }
            }
        }
        if (moe) { __syncthreads(); if (tid < 8) ((int*)(p.ws + OFF_HIST))[vb * 8 + tid] = hist[tid]; __syncthreads(); }
    }
}
__device__ __forceinline__ void phase_ln1(const Params& p, int layer, LAS unsigned char* lds) { if (layer == 0) phase_ln1_t<false>(p, layer, lds); else phase_ln1_t<true>(p, layer, lds); }
__device__ __forceinline__ void moe_tables(const Params& p, int vb, LAS int* tab) {
    const int tid = tid_fresh(p.wave);
    const int* hist = (const int*)(p.ws + OFF_HIST);
    LAS int* cnt = tab + 300; LAS int* part = tab + 320;
    { const int e = tid & 7, j = tid >> 3; int tot = 0, pre = 0;
#pragma unroll
      for (int k = 0; k < 4; ++k) { const int b = 4 * j + k; const int h = hist[b * 8 + e]; tot += h; pre += (b < vb) ? h : 0; }
      part[j * 16 + e] = tot; part[j * 16 + 8 + e] = pre; }
    __syncthreads();
    if (tid < 16) { int s = 0;
        for (int j = 0; j < 64; ++j) s += part[j * 16 + tid];
        cnt[tid] = s; }
    __syncthreads();
    if (tid == 0) { int start = 0, t = 0;
        for (int e = 0; e < 8; ++e) { const int nt = (cnt[e] + 255) >> 8; tab[e] = start + cnt[8 + e]; int ev = e; asm volatile("" : "+v"(ev)); for (int k = 0; k < nt; ++k) tab[16 + t + k] = ev; t += nt;        start += nt * 256; }
        tab[8] = t; }
    __syncthreads();
}
__device__ __forceinline__ void phase_moe_slots(const Params& p, int layer, LAS unsigned char* lds) {
    const int tid = tid_fresh(p.wave); const int lane = tid & 63, wid = tid >> 6; LAS int* tab = (LAS int*)lds; LAS int* te = tab + 1408; LAS int* tp = tab + 1600;
    unsigned char* HG = (unsigned char*)(p.ws + OFF_HG8); const float* mod = (const float*)(p.ws + OFF_MOD) + (size_t)layer * 8 * 6144;
    for (int vb = blockIdx.x; vb < 256; vb += gridDim.x) {
        moe_tables(p, vb, tab);
        if (tid < 128) te[tid] = ((const int4*)(p.ws + OFF_TOK))[vb * 128 + tid].x;
        __syncthreads();
        if (tid < 128) { const int t = tid, e0 = te[t] & 255, e1 = te[t] >> 8; int c0 = 0, c1 = 0;
            for (int k = 0; k < t; ++k) { const int a = te[k] & 255, b = te[k] >> 8; c0 += (a == e0) + (b == e0); c1 += (a == e1) + (b == e1); }
            const int p0 = tab[e0] + c0, p1 = tab[e1] + c1; tp[2 * t] = p0; tp[2 * t + 1] = p1; ((int2*)(p.ws + OFF_SLOT))[vb * 128 + t] = make_int2(p0, p1); }
        __syncthreads();
        u32x2 nv[4], nv2[4]; f32x4 sh[4], sc[4]; { const float* mb = mod + (size_t)((vb * 128) / SEQ) * 6144; ld_row_f32(mb + 3 * 1024, lane, sh); ld_row_f32(mb + 4 * 1024, lane, sc); }
        const void* XR = (const void*)(p.ws + OFF_XR);
        ldx<true>(XR, (size_t)(vb * 128 + wid), lane, nv); ldx<true>(XR, (size_t)(vb * 128 + wid + 8), lane, nv2);
        for (int i = 0; i < 16; ++i) { const int tl = i * 8 + wid, row = vb * 128 + tl;
            f32x4 v[4], h[4];
#pragma unroll
            for (int k = 0; k < 4; ++k) { v[k] = cvx(nv[k]); nv[k] = nv2[k]; }
            if (i + 2 < 16) ldx<true>(XR, (size_t)(row + 16), lane, nv2);
            modulate_regs(v, sh, sc, h);
            st_row_fp8(HG + (size_t)tp[2 * tl] * D, lane, h); st_row_fp8(HG + (size_t)tp[2 * tl + 1] * D, lane, h); }
        __syncthreads();
    }
}
__device__ __forceinline__ void phase_ln2(const Params& p, int layer) {
    const int tid = tid_fresh(p.wave); const int lane = tid & 63, wid = tid >> 6; const bool moe = (layer & 1) != 0;
    u16* H = (u16*)(p.ws + OFF_RH); const float* mod = (const float*)(p.ws + OFF_MOD) + (size_t)layer * 8 * 6144;
    f32x4 lg2[4], lb2[4]; ld_row_f32(p.ln2g + layer * D, lane, lg2); ld_row_f32(p.ln2b + layer * D, lane, lb2);
    for (int vb = blockIdx.x; vb < 256; vb += gridDim.x) { const int b = (vb * 128) / SEQ; const float* mb = mod + (size_t)b * 6144;
        f32x4 g2[4], nsh[4], nsc[4]; ld_row_f32(mb + 5 * 1024, lane, g2);
        if (layer + 1 < DEPTH) { const float* mn = mb + (size_t)8 * 6144; ld_row_f32(mn + 0 * 1024, lane, nsh); ld_row_f32(mn + 1 * 1024, lane, nsc); }
        const int r0 = vb * 128 + wid;
        u32x2 nv[4], nv2[4]; u32x2 na[4], nb[4]; int4 ti = make_int4(0, 0, 0, 0), ti2 = ti; int2 sl = make_int2(0, 0), sl2 = sl; u16* XR = (u16*)(p.ws + OFF_XR);
#pragma unroll
        for (int k = 0; k < 4; ++k) { na[k] = (u32x2){0u, 0u}; nb[k] = (u32x2){0u, 0u}; }
        ldx<true>(XR, (size_t)r0, lane, nv); ldx<true>(XR, (size_t)(r0 + 8), lane, nv2);
        if (moe) { ti = ((const int4*)(p.ws + OFF_TOK))[r0]; sl = ((const int2*)(p.ws + OFF_SLOT))[r0];
#pragma unroll
            for (int k = 0; k < 4; ++k) { na[k] = *(const u32x2*)(H + (size_t)sl.x * D + k * 256 + lane * 4); nb[k] = *(const u32x2*)(H + (size_t)sl.y * D + k * 256 + lane * 4); }
            ti2 = ((const int4*)(p.ws + OFF_TOK))[r0 + 8]; sl2 = ((const int2*)(p.ws + OFF_SLOT))[r0 + 8]; }
        else {
#pragma unroll
            for (int k = 0; k < 4; ++k) na[k] = *(const u32x2*)(H + (size_t)r0 * D + k * 256 + lane * 4); }
        for (int i = 0; i < 16; ++i) { const int row = r0 + i * 8;
            f32x4 v[4], f[4]; const float w0 = __int_as_float(ti.y), w1 = __int_as_float(ti.z);
#pragma unroll
            for (int k = 0; k < 4; ++k) { v[k] = cvx(nv[k]); nv[k] = nv2[k]; const f32x4 a = (f32x4){bflo(na[k].x), bfhi(na[k].x), bflo(na[k].y), bfhi(na[k].y)};
                if (moe) { const f32x4 c = (f32x4){bflo(nb[k].x), bfhi(nb[k].x), bflo(nb[k].y), bfhi(nb[k].y)}; f[k] = a * w0 + c * w1; } else f[k] = a; }
            if (i + 2 < 16) ldx<true>(XR, (size_t)(row + 16), lane, nv2);
            if (i + 1 < 16) { const int nx = row + 8;
                if (moe) { ti = ti2; sl = sl2;
#pragma unroll
                    for (int k = 0; k < 4; ++k) { na[k] = *(const u32x2*)(H + (size_t)sl.x * D + k * 256 + lane * 4); nb[k] = *(const u32x2*)(H + (size_t)sl.y * D + k * 256 + lane * 4); }
                    if (i + 2 < 16) { ti2 = ((const int4*)(p.ws + OFF_TOK))[nx + 8]; sl2 = ((const int2*)(p.ws + OFF_SLOT))[nx + 8]; } }
                else {
#pragma unroll
                    for (int k = 0; k < 4; ++k) na[k] = *(const u32x2*)(H + (size_t)nx * D + k * 256 + lane * 4); } }
#pragma unroll
            for (int k = 0; k < 4; ++k) v[k] = v[k] * ALPHA + g2[k] * f[k];
            layernorm_regs(v, lg2, lb2);
            if (layer + 1 < DEPTH) st_row_bf16(XR + (size_t)row * D, lane, v); else st_row_f32(p.out + (size_t)row * D, lane, v);
            if (layer + 1 < DEPTH) { f32x4 h[4]; modulate_regs(v, nsh, nsc, h); st_row_bf16(H + (size_t)row * D, lane, h); }
        }
    }
}
template <bool DRY = false> __device__ __forceinline__ void phase_prep(const Params& p, int layer, LAS unsigned char* lds) {
    const int tid = tid_fresh(p.wave), lane = tid & 63, wid = tid >> 6;
    LAS u16* z = (LAS u16*)(lds + 65536 + wid * 6400); LAS u16* qr = z + 2560;
    u16* Z = (u16*)(p.ws + OFF_RZ); u16* QR = (u16*)(p.ws + OFF_QROT);
    const float* CH = (const float*)(p.ws + OFF_COSH); const float* SH = (const float*)(p.ws + OFF_SINH); const float* CI = (const float*)(p.ws + OFF_COSI); const float* SI = (const float*)(p.ws + OFF_SINI);
    const int d = lane & 31, half = lane >> 5, e16 = lane & 15, hh = lane >> 4;
    const int stride = gridDim.x * 8; int row = blockIdx.x * 8 + wid;
    bool ldc[5], stc[5];
#pragma unroll
    for (int i = 0; i < 5; ++i) { const int ci = lane + 64 * i; ldc[i] = !((ci >= 48 && ci < 80) || (ci >= 96 && ci < 112) || (ci >= 128 && ci < 144) || ci >= 312); stc[i] = ldc[i] && ci >= 48 && ci < 296; }
    u32x4 pf[5]; float nch = 0.f, nsh = 0.f, nci = 0.f, nsi = 0.f;
    if (row < M) {
#pragma unroll
        for (int i = 0; i < 5; ++i) if (ldc[i]) pf[i] = *(const u32x4*)(Z + (size_t)row * ZP + (lane + 64 * i) * 8);
        nch = CH[(size_t)row * 32 + d]; nsh = SH[(size_t)row * 32 + d]; nci = CI[(size_t)row * 16 + e16]; nsi = SI[(size_t)row * 16 + e16]; }
    float sgg[4], sgb[4];
#pragma unroll
    for (int g = 0; g < 4; ++g) { sgg[g] = p.sgu_g[layer * 256 + g * 64 + lane]; sgb[g] = p.sgu_bn[layer * 256 + g * 64 + lane]; }
    for (; row < M; row += stride) {
#pragma unroll
        for (int i = 0; i < 5; ++i) *(LAS u32x4*)(z + (lane + 64 * i) * 8) = pf[i];
        const float ch = nch, sh = nsh, ci = nci, si = nsi;
        { const int nx = row + stride; if (nx < M) {
#pragma unroll
            for (int i = 0; i < 5; ++i) if (ldc[i]) pf[i] = *(const u32x4*)(Z + (size_t)nx * ZP + (lane + 64 * i) * 8);
            nch = CH[(size_t)nx * 32 + d]; nsh = SH[(size_t)nx * 32 + d]; nci = CI[(size_t)nx * 16 + e16]; nsi = SI[(size_t)nx * 16 + e16]; } }
        asm volatile("s_waitcnt lgkmcnt(0)" ::: "memory");
        float q1[3], q2[3], s1[2], s2[2], e1[3], e2[3], su[4], sv[4];
#pragma unroll
        for (int k = 0; k < 3; ++k) { const int h = half + 2 * k; q1[k] = bf2f(z[ZQ + h * 64 + d]); q2[k] = bf2f(z[ZQ + h * 64 + 32 + d]); e1[k] = bf2f(z[ZDQ + h * 64 + d]); e2[k] = bf2f(z[ZDQ + h * 64 + 32 + d]); }
#pragma unroll
        for (int k = 0; k < 2; ++k) { const LAS u16* q = z + ZKV + (2 + 2 * k) * 128 + half * 64; s1[k] = bf2f(q[d]); s2[k] = bf2f(q[32 + d]); }
        const float i1 = bf2f(z[ZIQ + hh * 32 + e16]), i2 = bf2f(z[ZIQ + hh * 32 + 16 + e16]), y1 = bf2f(z[ZIK + e16]), y2 = bf2f(z[ZIK + 16 + e16]);
        const float iwv = bf2f(z[ZIW + (lane & 3)]), gtv = bf2f(z[ZG + (lane < 18 ? lane : 17)]);
        const float c0 = bf2f(z[ZCKV + lane]), c1 = bf2f(z[ZCKV + 64 + lane]), kraw = bf2f(z[2368 + lane]), vraw = bf2f(z[2432 + lane]);
#pragma unroll
        for (int g = 0; g < 4; ++g) { su[g] = bf2f(z[ZSG + g * 64 + lane]); sv[g] = bf2f(z[ZSG + 256 + g * 64 + lane]); }
        asm volatile("s_waitcnt lgkmcnt(0)" ::: "memory");
#pragma unroll
        for (int k = 0; k < 3; ++k) { const int h = half + 2 * k;
            qr[h * 64 + d] = f2bf((q1[k] * ch - q2[k] * sh) * C2); qr[h * 64 + 32 + d] = f2bf((q2[k] * ch + q1[k] * sh) * C2);
            z[ZDQ + h * 64 + d] = f2bf((e1[k] * ch - e2[k] * sh) * C2); z[ZDQ + h * 64 + 32 + d] = f2bf((e2[k] * ch + e1[k] * sh) * C2); }
#pragma unroll
        for (int k = 0; k < 2; ++k) { LAS u16* q = z + ZKV + (2 + 2 * k) * 128 + half * 64; q[d] = f2bf(s1[k] * ch - s2[k] * sh); q[32 + d] = f2bf(s2[k] * ch + s1[k] * sh); }
        z[ZIQ + hh * 32 + e16] = f2bf(i1 * ci - i2 * si); z[ZIQ + hh * 32 + 16 + e16] = f2bf(i2 * ci + i1 * si);
        if (lane < 16) { z[ZIK + e16] = f2bf(y1 * ci - y2 * si); z[ZIK + 16 + e16] = f2bf(y2 * ci + y1 * si); }
        if (lane < 4) z[ZIW + lane] = f2bf(iwv * 0.5f);
        if (lane < 18) z[ZG + lane] = f2bf(1.f / (1.f + __expf(-gtv)));
        { const float ss = wave_sum(c0 * c0 + c1 * c1); const float r = rsqrtf(ss * (1.f / 128.f) + 1e-6f);
          const float ak = kraw * r, av = vraw * r;
          const u32x2 hk_ = halves32(__float_as_uint(ak)); const float ko = __uint_as_float(half ? hk_.x : hk_.y); const float kr = half == 0 ? ak * ch - ko * sh : ak * ch + ko * sh;
          z[ZCKV + lane] = f2bf(kr); z[ZCKV + 64 + lane] = f2bf(av); }
        { float xg[4], mu[4], dx[4], var[4];
#pragma unroll
          for (int g = 0; g < 4; ++g) xg[g] = gelu_tanh(sv[g]);
#pragma unroll
          for (int g = 0; g < 4; ++g) mu[g] = wave_sum(xg[g]) * (1.f / 64.f);
#pragma unroll
          for (int g = 0; g < 4; ++g) { dx[g] = xg[g] - mu[g]; var[g] = wave_sum(dx[g] * dx[g]) * (1.f / 64.f); }
#pragma unroll
          for (int g = 0; g < 4; ++g) { z[ZSG + g * 64 + lane] = f2bf(gelu_tanh(su[g])); z[ZSG + 256 + g * 64 + lane] = f2bf(dx[g] * rsqrtf(var[g] + 1e-5f) * sgg[g] + sgb[g]); } }
        asm volatile("s_waitcnt lgkmcnt(0)" ::: "memory");
        { u32x4 w_[6];
#pragma unroll
          for (int i = 0; i < 5; ++i) w_[i] = *(const LAS u32x4*)(z + (lane + 64 * i) * 8);
          w_[5] = *(const LAS u32x4*)(qr + (lane < 48 ? lane : 47) * 8);
          asm volatile("s_waitcnt lgkmcnt(0)" ::: "memory");
#pragma unroll
          for (int i = 0; i < 5; ++i) { if (!DRY && stc[i]) *(u32x4*)(Z + (size_t)row * ZP + (lane + 64 * i) * 8) = w_[i]; else asm volatile("" :: "v"(w_[i])); }
          if (!DRY && lane < 48) *(u32x4*)(QR + (size_t)row * 384 + lane * 8) = w_[5]; else asm volatile("" :: "v"(w_[5])); }
        asm volatile("s_waitcnt lgkmcnt(0)" ::: "memory");
    }
    __syncthreads();
}

__device__ __forceinline__ void phase_compress(const Params& p, int layer, LAS unsigned char* lds) {
    const int tid = tid_fresh(p.wave), lane = tid & 63, wid = tid >> 6, fr = lane & 15, fq = lane >> 4;
    LAS float* part = (LAS float*)lds; LAS float* hid = (LAS float*)(lds + 32768);
    const u16* Z = (const u16*)(p.ws + OFF_RZ);
    bf16x8 av[8], bv[8][4]; int jcur = -1;
#define CMP_ALOAD(dst, task_) do { const int nt_ = (task_) & 15, j_ = ((task_) >> 4) & 1, g_ = ((task_) >> 5) & 1, b_ = (task_) >> 6; const int n_ = nt_ * 16 + fr; \
        const u16* arow_ = Z + ((size_t)b_ * SEQ + (n_ < 255 ? 16 * n_ : 0)) * ZP + ZKV + j_ * 128 + g_ * 64 + fq * 8; \
        _Pragma("unroll") for (int i = 0; i < 8; ++i) { const int st = wid * 8 + i, l = st >> 1, dd = (st & 1) * 32; dst[i] = *(const bf16x8*)(arow_ + (size_t)l * ZP + dd); } } while (0)
    for (int task = blockIdx.x; task < 8 * 2 * 2 * 16; task += gridDim.x) {
        const int nt = task & 15, j = (task >> 4) & 1, g = (task >> 5) & 1, b = task >> 6;
        const int n = nt * 16 + fr; const bool nvalid = n < 255;
        f32x4 acc[4];
#pragma unroll
        for (int c = 0; c < 4; ++c) acc[c] = (f32x4){0.f, 0.f, 0.f, 0.f};
        if (j != jcur) { jcur = j; const u16* W1 = (const u16*)(p.ws + OFF_CW1T) + (size_t)(layer * 2 + j) * 64 * 2048;
#pragma unroll
            for (int i = 0; i < 8; ++i) { const int st = wid * 8 + i;
#pragma unroll
                for (int c = 0; c < 4; ++c) bv[i][c] = *(const bf16x8*)(W1 + (size_t)(c * 16 + fr) * 2048 + st * 32 + fq * 8); } }
        CMP_ALOAD(av, task);
#pragma unroll
        for (int i = 0; i < 8; ++i) { bf16x8 a = av[i]; if (!nvalid) a = (bf16x8){0, 0, 0, 0, 0, 0, 0, 0};
#pragma unroll
            for (int c = 0; c < 4; ++c) acc[c] = __builtin_amdgcn_mfma_f32_16x16x32_bf16(a, bv[i][c], acc[c], 0, 0, 0); }
#pragma unroll
        for (int c = 0; c < 4; ++c)
#pragma unroll
            for (int r = 0; r < 4; ++r) part[(wid * 16 + 4 * fq + r) * 64 + c * 16 + fr] = acc[c][r];
        __syncthreads();
        const float* cb = (const float*)(p.ws + OFF_CB1) + (layer * 2 + j) * 64;
#pragma unroll
        for (int k = 0; k < 2; ++k) { const int o = tid + k * NTHR, rw = o >> 6, e = o & 63; float sacc = 0.f;
#pragma unroll
            for (int w = 0; w < 8; ++w) sacc += part[(w * 16 + rw) * 64 + e];
            hid[rw * 65 + e] = gelu_tanh(sacc + cb[e]); }
        __syncthreads();
        { const float* w2 = p.cmp_w2 + (size_t)(layer * 2 + j) * 4096; const int rw = tid >> 5, f0 = 2 * (tid & 31); float o0 = 0.f, o1 = 0.f;
#pragma unroll 16
          for (int e = 0; e < 64; ++e) { const float hv = hid[rw * 65 + e]; const f32x2 w = *(const f32x2*)(w2 + e * 64 + f0); o0 = fmaf(hv, w.x, o0); o1 = fmaf(hv, w.y, o1); }
          const int nn = nt * 16 + rw; if (nn >= 255) { o0 = 0.f; o1 = 0.f; }
          if (j == 0) { u16* kc = (u16*)(p.ws + OFF_KC) + ((size_t)(b * 2 + g) * 256 + nn) * 64 + f0; *(unsigned*)kc = cvt_pk_bf16(o0, o1); }
          else { u16* vc = (u16*)(p.ws + OFF_VCT) + ((size_t)(b * 2 + g) * 64 + f0) * 256 + nn; vc[0] = f2bf(o0); vc[256] = f2bf(o1); } }
        __syncthreads();
    }
    __syncthreads();
#undef CMP_ALOAD
}
__device__ __forceinline__ f32x16 mfma32(bf16x8 a, bf16x8 b, f32x16 c) { return __builtin_amdgcn_mfma_f32_32x32x16_bf16(a, b, c, 0, 0, 0); }
__device__ __forceinline__ bf16x8 pack8(const f32x16& p, int s) {
    u32x4 w; w.x = cvt_pk_bf16(p[8 * s + 0], p[8 * s + 1]); w.y = cvt_pk_bf16(p[8 * s + 2], p[8 * s + 3]); w.z = cvt_pk_bf16(p[8 * s + 4], p[8 * s + 5]); w.w = cvt_pk_bf16(p[8 * s + 6], p[8 * s + 7]);
    return __builtin_bit_cast(bf16x8, w); }
__device__ __forceinline__ void stage_o(LAS u16* stg, const f32x16 (&o)[2], float inv, int r32, int hi) {
#pragma unroll
    for (int db = 0; db < 2; ++db)
#pragma unroll
        for (int r = 0; r < 16; ++r) stg[r32 * 72 + db * 32 + crow(r, hi)] = f2bf(o[db][r] * inv);
    asm volatile("s_waitcnt lgkmcnt(0)" ::: "memory");
}

__device__ __forceinline__ float xor32f(float v, int hi) { auto rr = __builtin_amdgcn_permlane32_swap(__float_as_uint(v), __float_as_uint(v), false, false); return __uint_as_float(hi ? rr[0] : rr[1]); }
__device__ __forceinline__ int xor32i(int v, int hi) { auto rr = __builtin_amdgcn_permlane32_swap((unsigned)v, (unsigned)v, false, false); return (int)(hi ? rr[0] : rr[1]); }
__device__ __forceinline__ void phase_cmpattn(const Params& p, int layer, LAS unsigned char* lds) {
    const int tid = tid_fresh(p.wave), lane = tid & 63, wid = tid >> 6, r32 = lane & 31, hi = lane >> 5;
    LAS u16* Kl = (LAS u16*)lds;
    LAS u16* Vl = (LAS u16*)(lds + 36864);
    LAS u16* stg = (LAS u16*)(lds + 36864 + 33792 + wid * 4608);
    const u16* Z = (const u16*)(p.ws + OFF_RZ); u16* OC = (u16*)(p.ws + OFF_OC);
    for (int c = blockIdx.x; c < 256; c += gridDim.x) { const int bg = c >> 4, b = bg >> 1, g = bg & 1; const int rr_ = p.wave < 4 ? p.wave : 11 - p.wave; const int qt = 16 * rr_ + (c & 15);
        { const u16* Kg = (const u16*)(p.ws + OFF_KC) + (size_t)bg * 256 * 64;
          __syncthreads();
#pragma unroll
          for (int i = 0; i < 4; ++i) { const int cc = tid + i * NTHR; const int rw = cc >> 3, ch = cc & 7; *(LAS u32x4*)(Kl + rw * 72 + ch * 8) = *(const u32x4*)(Kg + rw * 64 + ch * 8); }
          { const u16* Vg = (const u16*)(p.ws + OFF_VCT) + (size_t)bg * 64 * 256;
#pragma unroll
            for (int i = 0; i < 4; ++i) { const int cc = tid + i * NTHR; const int rw = cc >> 5, ch = cc & 31; *(LAS u32x4*)(Vl + rw * 264 + ch * 8) = *(const u32x4*)(Vg + rw * 256 + ch * 8); } }
          __syncthreads(); }
        const int t0 = qt * 32, t = t0 + r32; const size_t row = (size_t)b * SEQ + t;
        const int nmax = (t - 31) >> 4;
        const int kbl = qt >> 4, kfull = (2 * qt - 33) >> 5;
        float imps[32];
#pragma unroll
        for (int i = 0; i < 32; ++i) imps[i] = 0.f;
        for (int r = 0; r < 3; ++r) { const int h = 3 * g + r;
            { LAS bf16x8* qs = (LAS bf16x8*)stg;
#pragma unroll
              for (int d0 = 0; d0 < 4; ++d0) qs[d0 * 64 + lane] = *(const bf16x8*)(Z + row * ZP + ZQ + h * 64 + d0 * 16 + hi * 8); }
            float m = 0.f, l = 0.f, carry = 0.f; bool seen = false; f32x16 o[2]; o[0] = (f32x16){}; o[1] = (f32x16){}; float imp[32];
#pragma unroll
            for (int i = 0; i < 32; ++i) imp[i] = 0.f;
#pragma unroll
            for (int kb = 0; kb < 8; ++kb) { if (kb <= kbl) { f32x16 s = {};
#pragma unroll
                for (int d0 = 0; d0 < 4; ++d0) s = mfma32(*(const LAS bf16x8*)(Kl + (32 * kb + r32) * 72 + d0 * 16 + hi * 8), ((const LAS bf16x8*)stg)[d0 * 64 + lane], s);
                if (kb > kfull) {
#pragma unroll
                    for (int rr = 0; rr < 16; ++rr) { const int n = 32 * kb + crow(rr, hi); s[rr] = (n <= nmax) ? fmaf(s[rr], C2, -m) : -INFINITY; } }
                else {
#pragma unroll
                    for (int rr = 0; rr < 16; ++rr) s[rr] = fmaf(s[rr], C2, -m); }
                float mk = fmaxf(fmaxf(s[0], s[1]), s[2]);
#pragma unroll
                for (int rr = 3; rr < 15; rr += 2) mk = fmaxf(fmaxf(mk, s[rr]), s[rr + 1]);
                mk = fmaxf(mk, s[15]); mk = fmaxf(mk, xor32f(mk, hi));
                const bool mv = (mk > 8.f) | (!seen & (mk > -INFINITY));
                if (__any(mv)) { const float dl = mv ? mk : 0.f; m += dl; const float f = __builtin_amdgcn_exp2f(-dl); l *= f; carry *= f;
#pragma unroll
                    for (int rr = 0; rr < 16; ++rr) { s[rr] -= dl; o[0][rr] *= f; o[1][rr] *= f; }
#pragma unroll
                    for (int i = 0; i < 32; ++i) imp[i] *= f; }
                seen = seen | (mk > -INFINITY);
#pragma unroll
                for (int rr = 0; rr < 16; ++rr) s[rr] = __builtin_amdgcn_exp2f(s[rr]);
#pragma unroll
                for (int gq = 0; gq < 4; ++gq) { const float sum4 = (s[4 * gq] + s[4 * gq + 1]) + (s[4 * gq + 2] + s[4 * gq + 3]); const float ol = xor32f(s[4 * gq + 3], hi);
                    const float extra = hi ? ol : carry; carry = ol; l += sum4;
                    imp[4 * kb + gq] += sum4 + extra; }
#pragma unroll
                for (int ks = 0; ks < 2; ++ks) { const bf16x8 pb = pack8(s, ks);
#pragma unroll
                    for (int db = 0; db < 2; ++db) { const LAS u16* vp = Vl + (32 * db + r32) * 264 + 32 * kb + 16 * ks + 4 * hi; const s16x4 lo = *(const LAS s16x4*)vp, hh = *(const LAS s16x4*)(vp + 8);
                        const bf16x8 a = (bf16x8){lo[0], lo[1], lo[2], lo[3], hh[0], hh[1], hh[2], hh[3]};
                        o[db] = mfma32(a, pb, o[db]); } }
                } }
            l += xor32f(l, hi); const float inv = l > 0.f ? 1.f / l : 0.f;
#pragma unroll
            for (int i = 0; i < 32; ++i) imps[i] = fmaf(imp[i], inv, imps[i]);
            asm volatile("s_nop 15\n\ts_nop 7" : "+v"(o[0]), "+v"(o[1]));
            stage_o(stg, o, inv, r32, hi);
#pragma unroll
            for (int i = 0; i < 4; ++i) { const int rw = i * 8 + (lane >> 3), ch = lane & 7; const u32x4 v = *(const LAS u32x4*)(stg + rw * 72 + ch * 8);
                *(u32x4*)(OC + ((size_t)b * SEQ + t0 + rw) * 384 + h * 64 + ch * 8) = v; }
            asm volatile("s_waitcnt lgkmcnt(0)" ::: "memory");
        }
        { asm volatile("s_waitcnt lgkmcnt(0)" ::: "memory");
          const int cur = t >> 6; float k[32]; LAS float* tr = (LAS float*)stg;
#pragma unroll
          for (int hf = 0; hf < 2; ++hf) {
#pragma unroll
              for (int i = 0; i < 16; ++i) tr[r32 * 33 + 8 * (i >> 2) + 2 * (i & 3) + hi] = imps[16 * hf + i];
              asm volatile("s_waitcnt lgkmcnt(0)" ::: "memory");
#pragma unroll
              for (int i = 0; i < 32; ++i) { const float v = tr[r32 * 33 + i]; if (hf == 0) k[i] = v; else k[i] = hi ? v : k[i]; }
              asm volatile("s_waitcnt lgkmcnt(0)" ::: "memory"); }
#pragma unroll
          for (int i = 0; i < 32; ++i) { const int j = 32 * hi + i; const bool valid = j <= cur; const bool forced = (j == 0) | (j == cur) | (j == cur - 1);
              k[i] = valid ? k[i] + (forced ? 1e4f : 0.f) : -INFINITY; }
          unsigned long long msk = 0ull;
#pragma unroll 1
          for (int rd = 0; rd < 16; ++rd) { float best = k[0]; int bi = 0;
#pragma unroll
              for (int i = 1; i < 32; ++i) { const bool gt = k[i] > best; best = gt ? k[i] : best; bi = gt ? i : bi; }
              const float ob = xor32f(best, hi); const int obi = xor32i(bi, hi);
              const float v0 = hi ? ob : best, v1 = hi ? best : ob; const int i0 = hi ? obi : bi, i1 = hi ? bi : obi;
              const bool w0 = v0 >= v1; const float wv = w0 ? v0 : v1; const int wj = w0 ? i0 : 32 + i1;
              if (wv > -INFINITY) msk |= 1ull << wj;
              const bool mine = (w0 ? 0 : 1) == hi;
#pragma unroll
              for (int i = 0; i < 32; ++i) k[i] = (mine && i == bi) ? -INFINITY : k[i]; }
          if (hi == 0) ((unsigned long long*)(p.ws + OFF_BLK))[((size_t)b * SEQ + t) * 2 + g] = msk; }
        asm volatile("s_waitcnt lgkmcnt(0)" ::: "memory");
    }
    __syncthreads();
}
constexpr int AT_K = 0, AT_V = 24576, AT_M = 49152, AT_O = 55296, AT_Q = AT_O + 8 * 4608, AT_BYTES = AT_Q + 8 * 4096;
__device__ __forceinline__ float max3f(float a, float b, float c) { float r; asm("v_max3_f32 %0, %1, %2, %3" : "=v"(r) : "v"(a), "v"(b), "v"(c)); return r; }
__device__ __forceinline__ s16x4 vtr(const LAS unsigned char* q) { return __builtin_bit_cast(s16x4, __builtin_amdgcn_ds_read_tr16_b64_v4i16((LAS s16x4*)q)); }
typedef __bf16 bf16x2_t __attribute__((ext_vector_type(2)));
__device__ __forceinline__ unsigned cvtpk_c(float lo, float hi) { const f32x2 v = {lo, hi}; return __builtin_bit_cast(unsigned, __builtin_convertvector(v, bf16x2_t)); }
__device__ __forceinline__ float xor32_max(float v) { auto rr = __builtin_amdgcn_permlane32_swap(__float_as_uint(v), __float_as_uint(v), false, false); return fmaxf(__uint_as_float(rr[0]), __uint_as_float(rr[1])); }
__device__ __forceinline__ void glds16(const void* gsrc, unsigned lds_dst) { unsigned keep;
    asm volatile("s_mov_b32 %0, m0\n\ts_mov_b32 m0, %2\n\ts_nop 0\n\tglobal_load_lds_dwordx4 %1, off\n\ts_mov_b32 m0, %0" : "=&s"(keep) : "v"(gsrc), "s"(lds_dst) : "memory"); }
__device__ __forceinline__ void glds4(const void* gsrc, unsigned lds_dst) { unsigned keep;
    asm volatile("s_mov_b32 %0, m0\n\ts_mov_b32 m0, %2\n\ts_nop 0\n\tglobal_load_lds_dword %1, off\n\ts_mov_b32 m0, %0" : "=&s"(keep) : "v"(gsrc), "s"(lds_dst) : "memory"); }
struct AttnArgs { const u16* Q; int qp, qc; const u16* K; int kp, kc; const u16* V; int vp, vc; u16* O; int op, oc; };
#define SBAR() __builtin_amdgcn_sched_barrier(0)
template <int MODE> __device__ __forceinline__ void attn_unit(const Params& p, const AttnArgs& A, int b, int h, int g, int qb, LAS unsigned char* lds) {
    const int tid = tid_fresh(p.wave), lane = tid & 63, wid = tid >> 6, r32 = lane & 31, hi = lane >> 5; const int wu = p.wave;
    const int q0 = qb * 256, t = q0 + wid * 32 + r32; const size_t row = (size_t)b * SEQ + t;
    const int H1 = 4 * qb + 3, H0 = (MODE == 3) ? (4 * qb - 8 > 0 ? 4 * qb - 8 : 0) : 0;
    const u16* kg = A.K + ((size_t)b * SEQ + lane) * A.kp + A.kc + wu * 8; const u16* vg = A.V + ((size_t)b * SEQ + 16 * (wu & 3) + (lane >> 2)) * A.vp + A.vc + (wu >> 2) * 32 + (lane & 3) * 8;
    const unsigned* mg = (const unsigned*)(p.ws + OFF_MASKW) + ((size_t)b * SEQ + q0 + wu * 32 + (lane >> 1)) * 128 + (lane & 1);
    const unsigned ldsb = (unsigned)(uintptr_t)lds;
#define AT_CL(x) (((x) <= H1) ? (x) : H1)
#define AT_DMA_K(hh, so) glds16(kg + (size_t)AT_CL(hh) * 64 * A.kp, (unsigned)__builtin_amdgcn_readfirstlane(ldsb + AT_K + (so) + wu * 1024))
#define AT_DMA_V(hh, so) glds16(vg + (size_t)AT_CL(hh) * 64 * A.vp, (unsigned)__builtin_amdgcn_readfirstlane(ldsb + AT_V + (so) + wu * 1024))
#define AT_DMA_M(hh, so) do { if (MODE == 2) glds4(mg + 2 * AT_CL(hh), (unsigned)__builtin_amdgcn_readfirstlane(ldsb + AT_M + ((so) >> 2) + wu * 256)); } while (0)
#define AT_WAIT_BAR(N) asm volatile("s_waitcnt vmcnt(" #N ") lgkmcnt(0)\n\ts_barrier" ::: "memory")
#define AT_WAIT_STEP() do { if (MODE == 2) AT_WAIT_BAR(3); else AT_WAIT_BAR(2); } while (0)
    AT_DMA_K(H0, 0); AT_DMA_V(H0, 0); AT_DMA_K(H0 + 1, 8192); AT_DMA_M(H0, 0); AT_DMA_M(H0 + 1, 8192);
    bf16x8 qr[4];
#pragma unroll
    for (int d0 = 0; d0 < 4; ++d0) qr[d0] = *(const bf16x8*)(A.Q + row * A.qp + A.qc + h * 64 + d0 * 16 + hi * 8);
    LAS u16* Qs = (LAS u16*)(lds + AT_Q) + (wid * 256 + lane) * 8;
    if (MODE == 2) {
#pragma unroll
        for (int d0 = 0; d0 < 4; ++d0) *(LAS bf16x8*)(Qs + d0 * 512) = qr[d0]; }
#define AT_QR(j) ((MODE == 2) ? *(const LAS bf16x8*)(Qs + (j) * 512) : qr[j])
    unsigned long long bmask = 0ull; if (MODE == 1) bmask = ((const unsigned long long*)(p.ws + OFF_BLK))[row * 2 + g];
    AT_DMA_K(H0 + 2, 16384);
    const LAS unsigned char* kp0 = lds + AT_K + hi * 1024 + r32 * 16; const LAS unsigned char* vp0 = lds + AT_V + ((lane >> 4) & 1) * 32 + (lane & 3) * 8 + (4 * hi + ((lane & 15) >> 2)) * 64;
    const LAS unsigned char* mp0 = lds + AT_M + wid * 256 + r32 * 8;
    float m = 0.f, l = 0.f; f32x16 o[2], negm; { float z = 0.f; asm volatile("" : "+v"(z));
#pragma unroll
      for (int r = 0; r < 16; ++r) { o[0][r] = z; o[1][r] = z; negm[r] = z; } }
    asm volatile("" : "+v"(negm));
    f32x16 pA0, pA1, pB0, pB1; bf16x8 kf[8]; bool seen = false; bool resc = false; float fsc = 1.f;
    int sl_prev = 0, sl_cur = 0, sl_next = 8192;
#define AT_ROT() do { sl_prev = sl_cur; sl_cur = sl_next; sl_next = (sl_next == 16384) ? 0 : sl_next + 8192; } while (0)
#define AT_KC(sb_, r_) (32 * (sb_) + ((r_) & 3) + 8 * ((r_) >> 2))
#define AT_CMASK(C0, C1, tt, DG, LW) do { const int tb_ = t - 64 * (tt) - 4 * hi; asm volatile("" :: "v"(tb_));        \
        if (DG) { _Pragma("unroll") for (int r = 0; r < 16; ++r) { C0[r] = (AT_KC(0, r) > tb_) ? -INFINITY : C0[r]; C1[r] = (AT_KC(1, r) > tb_) ? -INFINITY : C1[r]; } } \
        if (LW) { const int tl_ = tb_ - 512; _Pragma("unroll") for (int r = 0; r < 16; ++r) { C0[r] = (AT_KC(0, r) <= tl_) ? -INFINITY : C0[r]; C1[r] = (AT_KC(1, r) <= tl_) ? -INFINITY : C1[r]; } } } while (0)
#define AT_EXM(X, B, WW) do { _Pragma("unroll") for (int j_ = 0; j_ < 4; ++j_) { const float e_ = __builtin_amdgcn_exp2f(X[(B) + j_]); \
            X[(B) + j_] = (MODE == 2) ? __int_as_float(__float_as_int(e_) & __builtin_amdgcn_sbfe((int)(WW), (((B) + j_) & 3) + 8 * (((B) + j_) >> 2) + 4 * hi, 1)) : e_; } } while (0)
    AT_WAIT_BAR(0);
    { const LAS unsigned char* kb_ = kp0;
#pragma unroll
      for (int d0 = 0; d0 < 4; ++d0) { const bf16x8 b0 = *(const LAS bf16x8*)(kb_ + d0 * 2048), b1 = *(const LAS bf16x8*)(kb_ + d0 * 2048 + 512);
          if (d0 == 0) { pA0 = mfma32(b0, qr[0], negm); pA1 = mfma32(b1, qr[0], negm); } else { pA0 = mfma32(b0, qr[d0], pA0); pA1 = mfma32(b1, qr[d0], pA1); } }
      asm volatile("s_nop 15\n\ts_nop 7" : "+v"(pA0), "+v"(pA1));
      AT_CMASK(pA0, pA1, H0, true, (MODE == 3));
      float a = max3f(pA0[0], pA0[1], pA1[0]), bb = max3f(pA0[2], pA0[3], pA1[1]); a = max3f(a, pA1[2], pA1[3]);
#pragma unroll
      for (int r = 4; r < 16; r += 4) { a = max3f(a, pA0[r], pA0[r + 1]); bb = max3f(bb, pA0[r + 2], pA0[r + 3]); a = max3f(a, pA1[r], pA1[r + 1]); bb = max3f(bb, pA1[r + 2], pA1[r + 3]); }
      const float rm = xor32_max(fmaxf(a, bb)); seen = rm > -INFINITY; const float dl = seen ? rm : 0.f; m = dl;
#pragma unroll
      for (int r = 0; r < 16; ++r) { pA0[r] -= dl; pA1[r] -= dl; negm[r] = -m; }
      asm volatile("" : "+v"(negm));
      u32x2 mwv = (u32x2){0u, 0u}; if (MODE == 2) mwv = *(const LAS u32x2*)(mp0);
      AT_EXM(pA0, 0, mwv.x); AT_EXM(pA0, 4, mwv.x); AT_EXM(pA0, 8, mwv.x); AT_EXM(pA0, 12, mwv.x); AT_EXM(pA1, 0, mwv.y); AT_EXM(pA1, 4, mwv.y); AT_EXM(pA1, 8, mwv.y); AT_EXM(pA1, 12, mwv.y); }
    AT_WAIT_BAR(0);
    AT_DMA_K(H0 + 3, 0); AT_DMA_V(H0 + 1, 8192); AT_DMA_M(H0 + 2, 16384);
    AT_ROT();
#pragma unroll
    for (int j = 0; j < 4; ++j) { kf[2 * j] = *(const LAS bf16x8*)(kp0 + sl_cur + j * 2048); kf[2 * j + 1] = *(const LAS bf16x8*)(kp0 + sl_cur + j * 2048 + 512); }
    AT_WAIT_STEP();
    s16x4 vlo[8], vhi[8]; u32x4 pw0, pw1, pw2, pw3;
#define PKW(P, B) (cvtpk_c(P[B], P[(B) + 1]) & km)
#define PAF(k) __builtin_bit_cast(bf16x8, pw##k)
#define VFR(i) (bf16x8){vlo[i][0], vlo[i][1], vlo[i][2], vlo[i][3], vhi[i][0], vhi[i][1], vhi[i][2], vhi[i][3]}
#define PIN(x) asm volatile("" : "+v"(x))
#define GAPA(MF, A0, A1, A2, A3, W0, W1, PW) do { MF; sacc += A0; sacc += A1; sacc += A2; sacc += A3; PIN(sacc); W0; W1; PIN(PW); SBAR(); } while (0)
#define GAPB(MF, X, B, WW) do { MF; AT_EXM(X, B, WW); PIN(X); SBAR(); } while (0)
#define VRD(i) do { vlo[i] = vtr(vp_ + (((i) >> 2) * 4096 + ((i) & 3) * 1024)); vhi[i] = vtr(vp_ + (((i) >> 2) * 4096 + ((i) & 3) * 1024 + 512)); } while (0)
#define KRD(j) do { kf[2 * (j)] = *(const LAS bf16x8*)(kp0 + sl_next + (j) * 2048); kf[2 * (j) + 1] = *(const LAS bf16x8*)(kp0 + sl_next + (j) * 2048 + 512); SBAR(); } while (0)
#define AT_STEP(C0, C1, P0, P1, DG, LW) do { SBAR(); \
    const LAS unsigned char* vp_ = vp0 + sl_prev; \
    const bool sel = (MODE != 1) || (((bmask >> (tq - 1)) & 1ull) != 0ull); const unsigned km = sel ? 0xffffffffu : 0u;     \
    VRD(0); SBAR(); float sacc = (P0[0] + P0[1]); \
    GAPA(C0 = mfma32(kf[0], AT_QR(0), negm), P0[2], P0[3], P0[4], P0[5],     pw0[0] = PKW(P0, 0), pw0[1] = PKW(P0, 2), pw0); \
    VRD(4); SBAR(); GAPA(C1 = mfma32(kf[1], AT_QR(0), negm), P0[6], P0[7], P0[8], P0[9],     pw0[2] = PKW(P0, 4), pw0[3] = PKW(P0, 6), pw0); \
    VRD(1); SBAR(); GAPA(C0 = mfma32(kf[2], AT_QR(1), C0),   P0[10], P0[11], P0[12], P0[13], pw1[0] = PKW(P0, 8), pw1[1] = PKW(P0, 10), pw1); \
    VRD(5); SBAR(); GAPA(C1 = mfma32(kf[3], AT_QR(1), C1),   P0[14], P0[15], P1[0], P1[1],   pw1[2] = PKW(P0, 12), pw1[3] = PKW(P0, 14), pw1); \
    VRD(2); SBAR(); GAPA(C0 = mfma32(kf[4], AT_QR(2), C0),   P1[2], P1[3], P1[4], P1[5],     pw2[0] = PKW(P1, 0), pw2[1] = PKW(P1, 2), pw2); \
    VRD(6); SBAR(); GAPA(C1 = mfma32(kf[5], AT_QR(2), C1),   P1[6], P1[7], P1[8], P1[9],     pw2[2] = PKW(P1, 4), pw2[3] = PKW(P1, 6), pw2); \
    VRD(3); SBAR(); GAPA(C0 = mfma32(kf[6], AT_QR(3), C0),   P1[10], P1[11], P1[12], P1[13], pw3[0] = PKW(P1, 8), pw3[1] = PKW(P1, 10), pw3); \
    VRD(7); SBAR(); GAPA(C1 = mfma32(kf[7], AT_QR(3), C1),   P1[14], P1[15], 0.f, 0.f,       pw3[2] = PKW(P1, 12), pw3[3] = PKW(P1, 14), pw3); \
    l += sel ? sacc : 0.f; \
    AT_DMA_K(tq + 3, sl_cur); AT_DMA_V(tq + 1, sl_next); AT_DMA_M(tq + 2, sl_prev); \
    AT_CMASK(C0, C1, tq, DG, LW); \
    u32x2 mwv = (u32x2){0u, 0u}; if (MODE == 2) mwv = *(const LAS u32x2*)(mp0 + (sl_cur >> 2)); \
    { float a = fmaxf(fmaxf(C0[0], C0[1]), C1[0]), bb = fmaxf(fmaxf(C0[2], C0[3]), C1[1]); a = fmaxf(fmaxf(a, C1[2]), C1[3]); \
      _Pragma("unroll") for (int r = 4; r < 16; r += 4) { a = fmaxf(fmaxf(a, C0[r]), C0[r + 1]); bb = fmaxf(fmaxf(bb, C0[r + 2]), C0[r + 3]); a = fmaxf(fmaxf(a, C1[r]), C1[r + 1]); bb = fmaxf(fmaxf(bb, C1[r + 2]), C1[r + 3]); } \
      const float rm = xor32_max(fmaxf(a, bb)); \
      resc = false; const bool mv = (rm > 8.f) | (!seen & (rm > -INFINITY)); \
      if (__builtin_expect(__any(mv), 0)) { const float dl = mv ? rm : 0.f; m += dl; \
        _Pragma("unroll") for (int r = 0; r < 16; ++r) { C0[r] -= dl; C1[r] -= dl; } \
        _Pragma("unroll") for (int r = 0; r < 16; ++r) negm[r] = -m; asm volatile("" : "+v"(negm)); \
        fsc = __builtin_amdgcn_exp2f(-dl); l *= fsc; resc = true; } \
      seen = seen | (rm > -INFINITY); } \
    SBAR(); \
    GAPB(o[0] = mfma32(VFR(0), PAF(0), o[0]), C0, 0, mwv.x); \
    GAPB(o[1] = mfma32(VFR(4), PAF(0), o[1]), C0, 4, mwv.x); \
    KRD(0); GAPB(o[0] = mfma32(VFR(1), PAF(1), o[0]), C0, 8, mwv.x); \
    KRD(1); GAPB(o[1] = mfma32(VFR(5), PAF(1), o[1]), C0, 12, mwv.x); \
    KRD(2); GAPB(o[0] = mfma32(VFR(2), PAF(2), o[0]), C1, 0, mwv.y); \
    KRD(3); GAPB(o[1] = mfma32(VFR(6), PAF(2), o[1]), C1, 4, mwv.y); \
    GAPB(o[0] = mfma32(VFR(3), PAF(3), o[0]), C1, 8, mwv.y); \
    GAPB(o[1] = mfma32(VFR(7), PAF(3), o[1]), C1, 12, mwv.y); \
    AT_WAIT_STEP(); \
    if (resc) { _Pragma("unroll") for (int r = 0; r < 16; ++r) { o[0][r] *= fsc; o[1][r] *= fsc; } }        \
    AT_ROT(); ++tq; } while (0)
    int tq = H0 + 1;
    { const int npair = (H1 - H0 - 1) >> 1; const int ndiag = npair < 2 ? npair : 2; const int nlow = (MODE == 3 && qb >= 2) ? 2 : 0; const int nplain = npair - ndiag - nlow;
      if (MODE == 3) for (int i = 0; i < nlow; ++i) { AT_STEP(pB0, pB1, pA0, pA1, false, true); AT_STEP(pA0, pA1, pB0, pB1, false, true); }
      for (int i = 0; i < nplain; ++i) { AT_STEP(pB0, pB1, pA0, pA1, false, false); AT_STEP(pA0, pA1, pB0, pB1, false, false); }
      for (int i = 0; i < ndiag; ++i) { AT_STEP(pB0, pB1, pA0, pA1, true, false); AT_STEP(pA0, pA1, pB0, pB1, true, false); } }
    AT_STEP(pB0, pB1, pA0, pA1, true, false);
    { const bool sel = (MODE != 1) || (((bmask >> H1) & 1ull) != 0ull); const unsigned km = sel ? 0xffffffffu : 0u;
      float sacc = pB0[0] + pB0[1];
#pragma unroll
      for (int r = 2; r < 16; ++r) sacc += pB0[r];
#pragma unroll
      for (int r = 0; r < 16; ++r) sacc += pB1[r];
      l += sel ? sacc : 0.f;
      pw0 = (u32x4){PKW(pB0, 0), PKW(pB0, 2), PKW(pB0, 4), PKW(pB0, 6)}; pw1 = (u32x4){PKW(pB0, 8), PKW(pB0, 10), PKW(pB0, 12), PKW(pB0, 14)};
      pw2 = (u32x4){PKW(pB1, 0), PKW(pB1, 2), PKW(pB1, 4), PKW(pB1, 6)}; pw3 = (u32x4){PKW(pB1, 8), PKW(pB1, 10), PKW(pB1, 12), PKW(pB1, 14)};
      const LAS unsigned char* vp_ = vp0 + sl_prev;
#pragma unroll
      for (int i = 0; i < 8; ++i) VRD(i);
      o[0] = mfma32(VFR(0), PAF(0), o[0]); o[1] = mfma32(VFR(4), PAF(0), o[1]); o[0] = mfma32(VFR(1), PAF(1), o[0]); o[1] = mfma32(VFR(5), PAF(1), o[1]);
      o[0] = mfma32(VFR(2), PAF(2), o[0]); o[1] = mfma32(VFR(6), PAF(2), o[1]); o[0] = mfma32(VFR(3), PAF(3), o[0]); o[1] = mfma32(VFR(7), PAF(3), o[1]); }
    { const u32x2 hl_ = halves32(__float_as_uint(l)); l = __uint_as_float(hl_.x) + __uint_as_float(hl_.y); }
    asm volatile("s_nop 15\n\ts_nop 7" : "+v"(o[0]), "+v"(o[1]));
#undef AT_STEP
#undef KRD
#undef VRD
#undef GAPB
#undef GAPA
#undef PIN
#undef VFR
#undef PAF
#undef PKW
#undef AT_EXM
#undef AT_CMASK
#undef AT_KC
#undef AT_ROT
#undef AT_WAIT_STEP
#undef AT_WAIT_BAR
#undef AT_DMA_K
#undef AT_DMA_V
#undef AT_DMA_M
#undef AT_CL
#undef AT_QR
    const float inv = l > 0.f ? 1.f / l : 0.f;
    LAS u16* stg = (LAS u16*)(lds + AT_O + wid * 4608);
    stage_o(stg, o, inv, r32, hi);
#pragma unroll
    for (int i = 0; i < 4; ++i) { const int rw = i * 8 + (lane >> 3), ch = lane & 7; u32x4 v = *(const LAS u32x4*)(stg + rw * 72 + ch * 8);
        const size_t orow = (size_t)b * SEQ + q0 + wid * 32 + rw;
        if (MODE == 1) {
            const u16* zg = (const u16*)(p.ws + OFF_RZ) + orow * ZP + ZG + h * 3; const float g0 = bf2f(zg[0]), g1 = bf2f(zg[1]), g2 = bf2f(zg[2]);
            const u32x4 c = *(const u32x4*)((const u16*)(p.ws + OFF_OC) + orow * 384 + h * 64 + ch * 8), w = *(const u32x4*)((const u16*)(p.ws + OFF_OW) + orow * 384 + h * 64 + ch * 8);
            u32x4 r;
#define CMB(F) r.F = cvt_pk_bf16(g0 * bflo(c.F) + g1 * bflo(v.F) + g2 * bflo(w.F), g0 * bfhi(c.F) + g1 * bfhi(v.F) + g2 * bfhi(w.F))
            CMB(x); CMB(y); CMB(z); CMB(w);
#undef CMB
            v = r; }
        *(u32x4*)(A.O + orow * A.op + A.oc + h * 64 + ch * 8) = v; }
    asm volatile("s_waitcnt lgkmcnt(0)" ::: "memory");
    __syncthreads();
}
constexpr int DS_HP = 260;
constexpr int DS_HIST = 0, DS_PREF = 32 * 260 * 4, DS_KREM = DS_PREF + 128, DS_THR = DS_KREM + 128, DS_NTK = DS_THR + 128, DS_PART = DS_NTK + 128, DS_ANY = DS_PART + 128, DS_TCNT = DS_ANY + 128, DS_LCNT = DS_TCNT + 32 * 128 * 4, DS_LU = DS_LCNT + 128, DS_LK = DS_LU + 32 * 64 * 4, DS_MWL = DS_LK + 32 * 64 * 4, DS_ZW = DS_MWL + 32 * 128 * 4, DS_HIST2 = DS_ZW + 32 * 128 * 4, DS_BYTES = DS_HIST2 + 32 * 260 * 4;
__device__ __forceinline__ unsigned ordkey(float f) { const int u = __float_as_int(f); return (unsigned)(u ^ ((u >> 31) | (int)0x80000000)); }
struct IdxQ { bf16x8 bq[4][2]; float w[4]; };
__device__ __forceinline__ void idx_scores(const bf16x8 ka0, const bf16x8 ka1, const IdxQ& Q, unsigned (&u)[16]) {
    float I[16];
#pragma unroll
    for (int r = 0; r < 16; ++r) I[r] = 0.f;
    f32x16 sa = {}, sb = {};
    sa = mfma32(ka0, Q.bq[0][0], sa); sa = mfma32(ka1, Q.bq[0][1], sa);
#pragma unroll
    for (int h = 0; h < 4; ++h) {
        if (h < 3) { sb = (f32x16){}; sb = mfma32(ka0, Q.bq[h + 1][0], sb); sb = mfma32(ka1, Q.bq[h + 1][1], sb); }
        __builtin_amdgcn_sched_barrier(0);
#pragma unroll
        for (int r = 0; r < 16; ++r) I[r] = fmaf(Q.w[h], fmaxf(sa[r], 0.f), I[r]);
#pragma unroll
        for (int r = 0; r < 16; ++r) asm volatile("" : "+v"(I[r]));
        __builtin_amdgcn_sched_barrier(0);
        sa = sb; }
#pragma unroll
    for (int r = 0; r < 16; ++r) u[r] = ordkey(I[r]);
}
__device__ __forceinline__ unsigned lowbits(unsigned w, unsigned k) {
    if (k >= (unsigned)__popc(w)) return w;
    unsigned lo = 0u, hi = 32u;
#pragma unroll
    for (int it = 0; it < 6; ++it) { const unsigned mid = (lo + hi) >> 1; const unsigned msk = mid >= 32u ? 0xffffffffu : ((1u << mid) - 1u); if ((unsigned)__popc(w & msk) >= k) hi = mid; else lo = mid + 1u; }
    return w & (hi >= 32u ? 0xffffffffu : ((1u << hi) - 1u));
}
__device__ __forceinline__ void dsa_select_task(const Params& p, int b, int qt, LAS unsigned char* lds) {
    const int tid = tid_fresh(p.wave), lane = tid & 63, wid = tid >> 6, r32 = lane & 31, hi = lane >> 5;
    LAS unsigned* hist = (LAS unsigned*)(lds + DS_HIST); LAS unsigned* pref = (LAS unsigned*)(lds + DS_PREF); LAS unsigned* krem = (LAS unsigned*)(lds + DS_KREM);
    LAS unsigned* thrv = (LAS unsigned*)(lds + DS_THR); LAS unsigned* ntk = (LAS unsigned*)(lds + DS_NTK); LAS unsigned* part = (LAS unsigned*)(lds + DS_PART); LAS unsigned* anyp = (LAS unsigned*)(lds + DS_ANY);
    LAS unsigned* tcnt = (LAS unsigned*)(lds + DS_TCNT);
    const u16* Z = (const u16*)(p.ws + OFF_RZ);
    const int t0 = qt * 32, t = t0 + r32, ntile = qt + 1; const size_t row = (size_t)b * SEQ + t;
    const u16* kbase = Z + ((size_t)b * SEQ + r32) * ZP + ZIK + hi * 8; bf16x8 na0, na1;
#define DS_KLOAD0() do { const int k0_ = wid < ntile ? wid : 0; const u16* kp_ = kbase + (size_t)k0_ * 32 * ZP; na0 = *(const bf16x8*)kp_; na1 = *(const bf16x8*)(kp_ + 16); } while (0)
    IdxQ Q;
#pragma unroll
    for (int h = 0; h < 4; ++h) { Q.bq[h][0] = *(const bf16x8*)(Z + row * ZP + ZIQ + h * 32 + hi * 8); Q.bq[h][1] = *(const bf16x8*)(Z + row * ZP + ZIQ + h * 32 + 16 + hi * 8); Q.w[h] = bf2f(Z[row * ZP + ZIW + h]); }
    if (tid < 32) { pref[tid] = 0u; krem[tid] = 256u; }
    if (tid == 0) anyp[0] = 0u;
#define DS_KTOUCH() do { const int k0_ = wid < ntile ? wid : 0; const unsigned tv_ = *(const volatile unsigned*)(kbase + (size_t)k0_ * 32 * ZP); asm volatile("" :: "v"(tv_)); } while (0)
#define DS_DPPADD(v, ctrl) ((v) + (unsigned)__builtin_amdgcn_update_dpp(0, (int)(v), (ctrl), 0xF, 0xF, true))
#define DS_RADIX(PLO, PHI) _Pragma("unroll 1") \
    for (int pass = (PLO); pass < (PHI); ++pass) { const int shift = 24 - 8 * pass; \
        for (int i = tid; i < 32 * DS_HP / 4; i += NTHR) { ((LAS u32x4*)hist)[i] = (u32x4){0u, 0u, 0u, 0u}; ((LAS u32x4*)(hist + (DS_HIST2 - DS_HIST) / 4))[i] = (u32x4){0u, 0u, 0u, 0u}; } \
        __syncthreads(); \
        const unsigned mypref = pref[r32]; \
        DS_KLOAD0(); \
        _Pragma("unroll 1") \
        for (int kt = wid; kt < ntile; kt += 8) { unsigned u[16]; const bf16x8 ka0 = na0, ka1 = na1; { const int kn = (kt + 8 < ntile) ? kt + 8 : kt; const u16* kp = kbase + (size_t)kn * 32 * ZP; na0 = *(const bf16x8*)kp; na1 = *(const bf16x8*)(kp + 16); } idx_scores(ka0, ka1, Q, u); \
            const unsigned px = pass == 0 ? 0u : (mypref << 8); LAS unsigned* hrow = hist + hi * ((DS_HIST2 - DS_HIST) / 4) + r32 * DS_HP; \
            if (kt < qt) { \
        _Pragma("unroll") \
                for (int r = 0; r < 16; ++r) { const unsigned y = (u[r] >> shift) ^ px; if (y < 256u) __hip_atomic_fetch_add(hrow + y, 1u, __ATOMIC_RELAXED, __HIP_MEMORY_SCOPE_WORKGROUP); }        \
            } else { \
        _Pragma("unroll") \
                for (int r = 0; r < 16; ++r) { const bool valid = (32 * kt + crow(r, hi)) <= t; const unsigned y = (u[r] >> shift) ^ px; if (valid && y < 256u) __hip_atomic_fetch_add(hrow + y, 1u, __ATOMIC_RELAXED, __HIP_MEMORY_SCOPE_WORKGROUP); } } } \
        DS_KTOUCH(); \
        __syncthreads(); \
        {   \
          const int sq = lane >> 4, sj = lane & 15, q = wid * 4 + sq; const unsigned need = krem[q]; \
          const LAS unsigned* hr = hist + q * DS_HP + 4 * sj; const LAS unsigned* hr2 = hr + (DS_HIST2 - DS_HIST) / 4; \
          u32x4 c4[4]; unsigned s4[4], S4[4], T4[4]; \
          _Pragma("unroll") for (int i = 0; i < 4; ++i) { c4[i] = *(const LAS u32x4*)(hr + 64 * i) + *(const LAS u32x4*)(hr2 + 64 * i); s4[i] = (c4[i].x + c4[i].y) + (c4[i].z + c4[i].w); \
              unsigned v = s4[i]; v = DS_DPPADD(v, 0x101); v = DS_DPPADD(v, 0x102); v = DS_DPPADD(v, 0x104); v = DS_DPPADD(v, 0x108); S4[i] = v;        \
              unsigned w = s4[i]; w = DS_DPPADD(w, 0x128); w = DS_DPPADD(w, 0x124); w = DS_DPPADD(w, 0x122); w = DS_DPPADD(w, 0x121); T4[i] = w; }     \
          const unsigned A3 = 0u, A2 = T4[3], A1 = A2 + T4[2], A0 = A1 + T4[1]; \
          const unsigned b3 = A3 + S4[3] - s4[3], b2 = A2 + S4[2] - s4[2], b1 = A1 + S4[1] - s4[1], b0 = A0 + S4[0] - s4[0]; \
          const bool f3 = (b3 < need) && (need <= b3 + s4[3]), f2 = (b2 < need) && (need <= b2 + s4[2]), f1 = (b1 < need) && (need <= b1 + s4[1]), f0 = (b0 < need) && (need <= b0 + s4[0]); \
          const bool found = f3 | f2 | f1 | f0; const int fi = f3 ? 3 : (f2 ? 2 : (f1 ? 1 : 0)); const unsigned sufx = f3 ? b3 : (f2 ? b2 : (f1 ? b1 : b0)); \
          const u32x4 cc = f3 ? c4[3] : (f2 ? c4[2] : (f1 ? c4[1] : c4[0])); \
          const unsigned a3 = sufx, a2 = a3 + cc.w, a1 = a2 + cc.z, a0 = a1 + cc.y; const bool t3 = a3 + cc.w >= need, t2 = a2 + cc.z >= need, t1 = a1 + cc.y >= need; \
          unsigned digit = 64 * fi + 4 * sj + (t3 ? 3 : (t2 ? 2 : (t1 ? 1 : 0))), above = t3 ? a3 : (t2 ? a2 : (t1 ? a1 : a0)), cd = t3 ? cc.w : (t2 ? cc.z : (t1 ? cc.y : cc.x)); \
          const unsigned long long bm = __ballot(found); const unsigned seg = (unsigned)(bm >> (16 * sq)) & 0xffffu; const bool any = seg != 0u; const int src = 16 * sq + (any ? __builtin_ctz(seg) : 0); \
          { const unsigned d_ = SHFL_IDX(digit, src), a_ = SHFL_IDX(above, src), c_ = SHFL_IDX(cd, src); digit = any ? d_ : 0u; above = any ? a_ : 0u; cd = any ? c_ : 0u; } \
          if (sj == 0) { pref[q] = (pass == 0 ? 0u : (pref[q] << 8)) | digit; krem[q] = need - above; if (pass == 3) { const int tq = t0 + q; const bool all = tq < 256; \
                    thrv[q] = all ? 0u : ((pref[q])); ntk[q] = need - above; const unsigned pt = (!all && cd > need - above) ? 1u : 0u; part[q] = pt; if (pt) anyp[0] = 1u; } } \
        } \
        __syncthreads(); \
    }
    DS_RADIX(0, 2);
    LAS unsigned* lcnt = (LAS unsigned*)(lds + DS_LCNT); LAS unsigned* lu = (LAS unsigned*)(lds + DS_LU); LAS unsigned* lk = (LAS unsigned*)(lds + DS_LK); LAS unsigned* mwl = (LAS unsigned*)(lds + DS_MWL); LAS unsigned* zwl = (LAS unsigned*)(lds + DS_ZW);
    if (tid < 32) lcnt[tid] = 0u;
    __syncthreads();
    { const unsigned p16 = pref[r32]; const bool all = t < 256;
      DS_KLOAD0();
#pragma unroll 1
      for (int kt = wid; kt < ntile; kt += 8) { unsigned u[16]; const bf16x8 ka0 = na0, ka1 = na1; { const int kn = (kt + 8 < ntile) ? kt + 8 : kt; const u16* kp = kbase + (size_t)kn * 32 * ZP; na0 = *(const bf16x8*)kp; na1 = *(const bf16x8*)(kp + 16); } idx_scores(ka0, ka1, Q, u);
          unsigned bits = 0u, zb = 0u;
#pragma unroll
          for (int r = 0; r < 16; ++r) { const int ps = crow(r, hi); const bool valid = (kt < qt) || ((32 * kt + ps) <= t); const unsigned y = u[r] >> 16;
              if (valid && (all || y > p16)) bits |= 1u << ps;
              const bool und = valid && !all && y == p16;
              if (und && u[r] == 0x80000000u) zb |= 1u << ps;
              if (und && u[r] != 0x80000000u) { const unsigned ix = __hip_atomic_fetch_add(lcnt + r32, 1u, __ATOMIC_RELAXED, __HIP_MEMORY_SCOPE_WORKGROUP); if (ix < 64u) { lu[r32 * 64 + ix] = u[r]; lk[r32 * 64 + ix] = (unsigned)(32 * kt + ps); } } }
          { const u32x2 hb = halves32(bits), hz = halves32(zb); bits = hb.x | hb.y; zb = hz.x | hz.y; }
          if (hi == 0) { mwl[r32 * 128 + kt] = bits; zwl[r32 * 128 + kt] = zb; } } }
    __syncthreads();
    bool ovf = false;
#pragma unroll
    for (int q = 0; q < 32; ++q) ovf = ovf || (lcnt[q] > 64u);
    if (!ovf) {
#pragma unroll 1
        for (int qi = 0; qi < 4; ++qi) { const int q = wid * 4 + qi; const unsigned n = (unsigned)__builtin_amdgcn_readfirstlane((int)lcnt[q]), need = krem[q]; const bool act = (unsigned)lane < n;
            const unsigned mu = act ? lu[q * 64 + lane] : 0u, mk = act ? lk[q * 64 + lane] : 0xffffffffu; unsigned rank = 0u;
            for (unsigned j = 0; j < n; ++j) { const unsigned uj = (unsigned)__builtin_amdgcn_readlane((int)mu, (int)j), kj = (unsigned)__builtin_amdgcn_readlane((int)mk, (int)j); rank += (uj > mu || (uj == mu && kj < mk)) ? 1u : 0u; }
            if (act && rank < need) __hip_atomic_fetch_or(mwl + q * 128 + (mk >> 5), 1u << (mk & 31u), __ATOMIC_RELAXED, __HIP_MEMORY_SCOPE_WORKGROUP);
            const unsigned nz = need > n ? need - n : 0u;
            const int k0 = 2 * lane, k1 = 2 * lane + 1; const unsigned z0 = k0 < ntile ? zwl[q * 128 + k0] : 0u, z1 = k1 < ntile ? zwl[q * 128 + k1] : 0u;
            const unsigned c0 = __popc(z0), c1 = __popc(z1), sm = c0 + c1; unsigned v = sm;

            { v = DS_DPPADD(v, 0x111); v = DS_DPPADD(v, 0x112); v = DS_DPPADD(v, 0x114); v = DS_DPPADD(v, 0x118);
              v += (unsigned)__builtin_amdgcn_update_dpp(0, (int)v, 0x142, 0xA, 0xF, false); v += (unsigned)__builtin_amdgcn_update_dpp(0, (int)v, 0x143, 0xC, 0xF, false); }
            const unsigned ex = v - sm;
            { const unsigned take0 = nz > ex ? (nz - ex < c0 ? nz - ex : c0) : 0u, take1 = nz > ex + c0 ? (nz - ex - c0 < c1 ? nz - ex - c0 : c1) : 0u;
              if (take0) mwl[q * 128 + k0] |= lowbits(z0, take0);
              if (take1) mwl[q * 128 + k1] |= lowbits(z1, take1); } }
        __syncthreads();
        unsigned* MWg = (unsigned*)(p.ws + OFF_MASKW) + ((size_t)b * SEQ + t0) * 128;
        for (int i = tid; i < 32 * ntile; i += NTHR) { const int q = i / ntile, kt = i - q * ntile; MWg[(size_t)q * 128 + kt] = mwl[q * 128 + kt]; }
        __syncthreads();
        return;
    }
    __syncthreads();
    DS_RADIX(2, 4);
#undef DS_RADIX
    const unsigned thr = thrv[r32], ntake = ntk[r32], ptl = part[r32]; const bool anyPartial = anyp[0] != 0u;
    if (anyPartial) {
        DS_KLOAD0();
#pragma unroll 1
        for (int kt = wid; kt < ntile; kt += 8) { unsigned u[16]; const bf16x8 ka0 = na0, ka1 = na1; { const int kn = (kt + 8 < ntile) ? kt + 8 : kt; const u16* kp = kbase + (size_t)kn * 32 * ZP; na0 = *(const bf16x8*)kp; na1 = *(const bf16x8*)(kp + 16); } idx_scores(ka0, ka1, Q, u); unsigned tb = 0u;
#pragma unroll
            for (int r = 0; r < 16; ++r) { const bool valid = (32 * kt + crow(r, hi)) <= t; if (valid && u[r] == thr) tb |= 1u << crow(r, hi); }
            tb |= SHFL_XOR(tb, 32); if (hi == 0) tcnt[r32 * 128 + kt] = __popc(tb); }
        __syncthreads();
#pragma unroll 1
        for (int qi = 0; qi < 4; ++qi) { const int q = wid * 4 + qi; const unsigned a0 = (2 * lane < ntile) ? tcnt[q * 128 + 2 * lane] : 0u, a1 = (2 * lane + 1 < ntile) ? tcnt[q * 128 + 2 * lane + 1] : 0u;
            const unsigned s = a0 + a1; unsigned v = s;
#pragma unroll
            for (int off = 1; off < 64; off <<= 1) { const unsigned tmp = SHFL_UP(v, off); if (lane >= off) v += tmp; }
            const unsigned ex = v - s; tcnt[q * 128 + 2 * lane] = ex; tcnt[q * 128 + 2 * lane + 1] = ex + a0; }
        __syncthreads();
    }
    unsigned* MW = (unsigned*)(p.ws + OFF_MASKW);
    DS_KLOAD0();
#pragma unroll 1
    for (int kt = wid; kt < ntile; kt += 8) { unsigned u[16]; const bf16x8 ka0 = na0, ka1 = na1; { const int kn = (kt + 8 < ntile) ? kt + 8 : kt; const u16* kp = kbase + (size_t)kn * 32 * ZP; na0 = *(const bf16x8*)kp; na1 = *(const bf16x8*)(kp + 16); } idx_scores(ka0, ka1, Q, u); unsigned bits = 0u, tb = 0u, base = 0u;
        if (anyPartial) {
#pragma unroll
            for (int r = 0; r < 16; ++r) { const bool valid = (32 * kt + crow(r, hi)) <= t; if (valid && u[r] == thr) tb |= 1u << crow(r, hi); }
            tb |= SHFL_XOR(tb, 32); base = tcnt[r32 * 128 + kt]; }
#pragma unroll
        for (int r = 0; r < 16; ++r) { const int ps = crow(r, hi); const bool valid = (32 * kt + ps) <= t; const bool tie = u[r] == thr;
            const bool tieok = !ptl || ((base + __popc(tb & ((1u << ps) - 1u))) < ntake);
            if (valid && (u[r] > thr || (tie && tieok))) bits |= 1u << ps; }
        bits |= SHFL_XOR(bits, 32);
        if (hi == 0) MW[row * 128 + kt] = bits; }
    __syncthreads();
}
#undef DS_KLOAD0
#undef DS_KTOUCH
#ifndef DBG_REP
#define DBG_REP 0
#endif
#define REP(g) for (int rep_ = 0; rep_ < (((DBG_REP >> (g)) & 1) ? 2 : 1); ++rep_)
struct SguRegs { u32x4 a, c; bf16x8 af[4]; u16 uu[4][4]; float bs[4]; };
__device__ __forceinline__ void sgu_load(const Params& p, int layer, int u, int tid, int wid, int fr, int fq, SguRegs& R) {
    const int b = u >> 7, n = (u >> 2) & 31, g = u & 3; const u16* Z = (const u16*)(p.ws + OFF_RZ); const size_t row0 = (size_t)b * SEQ + 128 * n;
    { const int s = tid >> 2, ch = tid & 3; const u16* src = Z + (row0 + s) * ZP + ZSG + 256 + g * 64 + ch * 16; R.a = *(const u32x4*)src; R.c = *(const u32x4*)(src + 8); }
    const u16* W = (const u16*)(p.ws + OFF_SGW) + ((size_t)(layer * 4 + g) * 128 + 16 * wid + fr) * 128 + fq * 8;
#pragma unroll
    for (int ks = 0; ks < 4; ++ks) R.af[ks] = *(const bf16x8*)(W + ks * 32);
#pragma unroll
    for (int r = 0; r < 4; ++r) { const int t = 16 * wid + 4 * fq + r; R.bs[r] = p.sgu_b[(layer * 4 + g) * 128 + t];
#pragma unroll
        for (int c = 0; c < 4; ++c) R.uu[r][c] = Z[(row0 + t) * ZP + ZSG + g * 64 + 16 * c + fr]; }
}
__device__ __forceinline__ void sgu_phase(const Params& p, int layer, LAS unsigned char* lds) {
    const int tid = tid_fresh(p.wave), lane = tid & 63, wid = tid >> 6, fr = lane & 15, fq = lane >> 4;
    LAS u16* vt = (LAS u16*)lds; u16* MC = (u16*)(p.ws + OFF_RH);
    int u = blockIdx.x; if (u >= 1024) return;
    SguRegs R; sgu_load(p, layer, u, tid, wid, fr, fq, R);
    for (;;) { const int un = u + gridDim.x; const bool more = un < 1024;
        { const int s = tid >> 2, ch = tid & 3; const u32x4 a = R.a, c = R.c; LAS u16* d = vt + (ch * 16) * 136 + s;
          d[0 * 136] = (u16)(a.x & 0xffff); d[1 * 136] = (u16)(a.x >> 16); d[2 * 136] = (u16)(a.y & 0xffff); d[3 * 136] = (u16)(a.y >> 16); d[4 * 136] = (u16)(a.z & 0xffff); d[5 * 136] = (u16)(a.z >> 16); d[6 * 136] = (u16)(a.w & 0xffff); d[7 * 136] = (u16)(a.w >> 16);
          d[8 * 136] = (u16)(c.x & 0xffff); d[9 * 136] = (u16)(c.x >> 16); d[10 * 136] = (u16)(c.y & 0xffff); d[11 * 136] = (u16)(c.y >> 16); d[12 * 136] = (u16)(c.z & 0xffff); d[13 * 136] = (u16)(c.z >> 16); d[14 * 136] = (u16)(c.w & 0xffff); d[15 * 136] = (u16)(c.w >> 16); }
        bf16x8 af[4]; u16 uu[4][4]; float bs[4];
#pragma unroll
        for (int k = 0; k < 4; ++k) { af[k] = R.af[k]; bs[k] = R.bs[k];
#pragma unroll
            for (int c = 0; c < 4; ++c) uu[k][c] = R.uu[k][c]; }
        if (more) sgu_load(p, layer, un, tid, wid, fr, fq, R);
        __syncthreads();
        const int b = u >> 7, n = (u >> 2) & 31, g = u & 3; const size_t row0 = (size_t)b * SEQ + 128 * n;
        f32x4 acc[4];
#pragma unroll
        for (int c = 0; c < 4; ++c) acc[c] = (f32x4){0.f, 0.f, 0.f, 0.f};
        const int nks = ((16 * wid + 15) >> 5) + 1;
#pragma unroll
        for (int ks = 0; ks < 4; ++ks) if (ks < nks) { const bf16x8 a = af[ks];
#pragma unroll
            for (int c = 0; c < 4; ++c) { const bf16x8 bb = *(const LAS bf16x8*)(vt + (16 * c + fr) * 136 + 32 * ks + fq * 8); acc[c] = __builtin_amdgcn_mfma_f32_16x16x32_bf16(a, bb, acc[c], 0, 0, 0); } }
#pragma unroll
        for (int r = 0; r < 4; ++r) { const int t = 16 * wid + 4 * fq + r; const float bias = bs[r];
#pragma unroll
            for (int c = 0; c < 4; ++c) { const int d = 16 * c + fr; MC[(row0 + t) * D + 768 + g * 64 + d] = f2bf(bf2f(uu[r][c]) * (acc[c][r] + bias)); } }
        __syncthreads();
        if (!more) break;
        u = un; }
}
constexpr int PH_L0 = 2;
constexpr int PH_PER_L0 = 9;
constexpr int PH_L1 = PH_L0 + PH_PER_L0;
constexpr int PH_END = PH_L1 + 7 + 2 * MOE_NCHUNK + 1;

__device__ __forceinline__ void mixer_phase1(const Params& p, int layer, LAS unsigned char* lds) {
    REP(4) phase_cmpattn(p, layer, lds);
    const u16* Z = (const u16*)(p.ws + OFF_RZ);
    REP(5) { AttnArgs A{(const u16*)(p.ws + OFF_QROT), 384, 0, Z, ZP, ZKV + 4 * 128, Z, ZP, ZKV + 5 * 128, (u16*)(p.ws + OFF_OW), 384, 0};
      for (int u = blockIdx.x; u < 768; u += gridDim.x) { const int qb = u & 15, h = (u >> 4) % 6, b = u / 96; AttnArgs B = A; B.kc += (h / 3) * 64; B.vc += (h / 3) * 64; attn_unit<3>(p, B, b, h, h / 3, qb, lds); } }
    REP(6) for (int pr = blockIdx.x; pr < 512; pr += gridDim.x) { const int b = pr >> 6, s = pr & 63; dsa_select_task(p, b, s, lds); dsa_select_task(p, b, 127 - s, lds); }
    REP(7) sgu_phase(p, layer, lds);
}
__device__ __forceinline__ int mix2_qb(int i, int k) { return k == 0 ? i : (k == 1 ? ((i + 8) & 15) : (i < 8 ? 14 - 2 * i : 31 - 2 * i)); }
__device__ __forceinline__ void mixer_phase2(const Params& p, int layer, LAS unsigned char* lds) {
    const u16* Z = (const u16*)(p.ws + OFF_RZ); u16* MC = (u16*)(p.ws + OFF_RH);
    const int vcu = (gridDim.x % 8 == 0) ? (int)((blockIdx.x % 8) * (gridDim.x / 8) + blockIdx.x / 8) : (int)blockIdx.x;
    for (int c = vcu; c < 256; c += gridDim.x) { const int b = c >> 5, grp = (c >> 4) & 1, i = c & 15;
        REP(8) for (int k = 0; k < 3; ++k) { const int h = 3 * grp + k, qb = mix2_qb(i, k);
            AttnArgs A{(const u16*)(p.ws + OFF_QROT), 384, 0, Z, ZP, ZKV + 2 * 128 + grp * 64, Z, ZP, ZKV + 3 * 128 + grp * 64, MC, D, 0};
            attn_unit<1>(p, A, b, h, grp, qb, lds); }
        REP(9) for (int k = 0; k < 3; ++k) { const int h = 3 * grp + k, qb = mix2_qb(i ^ 8, k);
            AttnArgs A{Z, ZP, ZDQ, Z, ZP, ZCKV, Z, ZP, ZCKV + 64, MC, D, 384}; attn_unit<2>(p, A, b, h, 0, qb, lds); } }
}
__device__ __forceinline__ Params fresh_params(const Params& p) { Params q = p; asm volatile("" : "+s"(q.ws)); return q; }
__global__ void __launch_bounds__(NTHR, 2) k_main(Params p_in) {
    Params p = p_in; p.wave = __builtin_amdgcn_readfirstlane((int)(threadIdx.x >> 6));
    extern __shared__ __attribute__((aligned(16))) unsigned char shm[];
    LAS unsigned char* lds = (LAS unsigned char*)shm;
    unsigned* bar = (unsigned*)(p.ws + OFF_BAR);
    LAS u32x4* xbw = (LAS u32x4*)(lds + LDS_BYTES - 16);
    XcdBarrier xb; xb.bar = bar; xb.x = 0; xb.wave = p.wave; xb.st = (volatile LAS unsigned*)xbw;
    if (p.use_bar) { if (tid_fresh(p.wave) == 0) *xbw = (u32x4){0u, 0u, 0u, 0u}; __syncthreads(); xb = xcd_barrier_post(bar, (volatile LAS unsigned*)xbw); xb.wave = p.wave; }
    const int G = gridDim.x, c = blockIdx.x;
#define PHASE(id) if ((id) >= p.phase_lo && (id) < p.phase_hi)
#define SEAM(id) do { if (p.use_bar && (id) >= p.phase_lo && (id) + 1 < p.phase_hi) xcd_barrier(xb); } while (0)
    PHASE(0) { const Params q = fresh_params(p); REP(0) prologue_all(q, c, G, lds); }
    SEAM(0);
    PHASE(1) { const Params q = fresh_params(p); REP(1) phase_lnmod0(q); }
    SEAM(1);
    for (int layer = 0; layer < DEPTH; ++layer) {
        const int base = layer == 0 ? PH_L0 : PH_L1;
        PHASE(base + 0) REP(2) { const Params q = fresh_params(p); pg8::SchedDense S; S.init(q.ws + OFF_RH, q.ws + OFF_WIN + (size_t)layer * ZP * D * 2, M, ZP, D, G, c); pg8::EpiBf16 E{(u16*)(q.ws + OFF_RZ), ZP}; pg8::gemm_phase(lds, D, S, E, q.wave); }
        SEAM(base + 0);
#ifndef DBG_NOMIX
        PHASE(base + 1) { const Params q = fresh_params(p); if ((DBG_REP >> 18) & 1) phase_prep<true>(q, layer, lds); phase_prep(q, layer, lds); REP(3) phase_compress(q, layer, lds); }
        SEAM(base + 1);
        PHASE(base + 2) { const Params q = fresh_params(p); mixer_phase1(q, layer, lds); }
        SEAM(base + 2);
        PHASE(base + 3) { const Params q = fresh_params(p); mixer_phase2(q, layer, lds); }
        SEAM(base + 3);
#else
        PHASE(base + 3) { const Params q = fresh_params(p); u32x4* mc = (u32x4*)(q.ws + OFF_RH); for (size_t i = (size_t)c * NTHR + tid_fresh(q.wave); i < (size_t)M * D / 8; i += (size_t)G * NTHR) mc[i] = (u32x4){0u, 0u, 0u, 0u}; }
        SEAM(base + 3);
#endif
        PHASE(base + 4) REP(10) { const Params q = fresh_params(p); pg8::SchedDense S; S.init(q.ws + OFF_RH, q.ws + OFF_WOUT + (size_t)layer * D * D * 2, M, D, D, G, c); pg8::EpiBf16 E{(u16*)(q.ws + OFF_RZ), D}; pg8::gemm_phase(lds, D, S, E, q.wave); }
        SEAM(base + 4);
        PHASE(base + 5) { const Params q = fresh_params(p); REP(layer == 0 ? 17 : 31) phase_ln1(q, layer, lds); }
        SEAM(base + 5);
        if (layer == 0) {
            PHASE(base + 6) REP(11) { const Params q = fresh_params(p);
#if FFN0_FP8 == 2
                pg8::SchedDense S; S.init(q.ws + OFF_RH, q.ws + OFF_WGU, M, 2 * DFF, D / 2, G, c); pg8::EpiSwiglu8 E{(unsigned char*)(q.ws + OFF_RZ), DFF, 0, ASC, 1.f / (WSC_UP * ASC)}; pg8::gemm_phase<pg8::EpiSwiglu8, pg8::SchedDense, true, SCB_UP, SCB_ACT>(lds, D / 2, S, E, q.wave);
#elif FFN0_FP8
                pg8::SchedDense S; S.init(q.ws + OFF_RH, q.ws + OFF_WGU, M, 2 * DFF, D / 2, G, c); pg8::EpiSwiglu E{(u16*)(q.ws + OFF_RZ), DFF, 0, 1.f / (WSC_UP * ASC)}; pg8::gemm_phase<pg8::EpiSwiglu, pg8::SchedDense, true, SCB_UP, SCB_ACT>(lds, D / 2, S, E, q.wave);
#else
                pg8::SchedDense S; S.init(q.ws + OFF_RH, q.ws + OFF_WGU, M, 2 * DFF, D, G, c); pg8::EpiSwiglu E{(u16*)(q.ws + OFF_RZ), DFF, 0}; pg8::gemm_phase(lds, D, S, E, q.wave);
#endif
            }
            SEAM(base + 6);
            PHASE(base + 7) REP(12) { const Params q = fresh_params(p);
#if FFN0_FP8 == 2
                pg8::SchedDense S; S.init(q.ws + OFF_RZ, q.ws + OFF_WDN, M, D, DFF / 2, G, c); pg8::EpiBf16 E{(u16*)(q.ws + OFF_RH), D, 1.f / (WSC_DN * ASC)}; pg8::gemm_phase<pg8::EpiBf16, pg8::SchedDense, true, SCB_DN, SCB_ACT>(lds, DFF / 2, S, E, q.wave);
#else
                pg8::SchedDense S; S.init(q.ws + OFF_RZ, q.ws + OFF_WDN, M, D, DFF, G, c); pg8::EpiBf16 E{(u16*)(q.ws + OFF_RH), D}; pg8::gemm_phase(lds, DFF, S, E, q.wave);
#endif
            }
            SEAM(base + 7);
            PHASE(base + 8) { const Params q = fresh_params(p); phase_ln2(q, layer); }
            SEAM(base + 8);
        } else {
            PHASE(base + 6) { const Params q = fresh_params(p); REP(16) phase_moe_slots(q, layer, lds); REP(13) moe_conv_all(q, lds); }
            SEAM(base + 6);
            PHASE(base + 7) REP(14) { const Params q = fresh_params(p); LAS int* tab = (LAS int*)(lds + LDS_TAB); moe_tables(q, 0, tab); const int T = tab[8]; const int ntl = T - 256;
                if (ntl > 0) { pg8::SchedMoe S{q.ws + OFF_HG8, q.ws + OFF_MW1, (size_t)256 * D, (size_t)2 * EFF * D, 256, ntl, 2 * EFF / 256, G, c, tab + 16};
                    pg8::EpiSwiglu8 E{(unsigned char*)(q.ws + OFF_HT), EFF, 256 * 256, ASC, 1.f / (WSC_UP * ASC)}; pg8::gemm_phase<pg8::EpiSwiglu8, pg8::SchedMoe, true, SCB_UP, SCB_ACT>(lds, D / 2, S, E, q.wave); }
                { pg8::SchedMoe S{q.ws + OFF_HG8, q.ws + OFF_MW1, (size_t)256 * D, (size_t)2 * EFF * D, 0, 128, 2 * EFF / 256, G, c, tab + 16};
                    pg8::EpiSwiglu8 E{(unsigned char*)(q.ws + OFF_RO), EFF, 0, ASC, 1.f / (WSC_UP * ASC)}; pg8::gemm_phase<pg8::EpiSwiglu8, pg8::SchedMoe, true, SCB_UP, SCB_ACT>(lds, D / 2, S, E, q.wave); } }
            SEAM(base + 7);
            PHASE(base + 8) REP(15) { const Params q = fresh_params(p); LAS int* tab = (LAS int*)(lds + LDS_TAB); moe_tables(q, 0, tab);
                pg8::SchedMoe S{q.ws + OFF_RO, q.ws + OFF_MW2, (size_t)256 * EFF, (size_t)D * EFF, 0, 128, D / 256, G, c, tab + 16};
                pg8::EpiBf16 E{(u16*)(q.ws + OFF_RH), D, 1.f / (WSC_DN * ASC)}; pg8::gemm_phase<pg8::EpiBf16, pg8::SchedMoe, true, SCB_DN, SCB_ACT>(lds, EFF / 2, S, E, q.wave); }
            SEAM(base + 8);
            PHASE(base + 9) REP(14) { const Params q = fresh_params(p); LAS int* tab = (LAS int*)(lds + LDS_TAB); moe_tables(q, 0, tab); const int T = tab[8]; const int ntl = T - 256;
                if (ntl > 0) { pg8::SchedMoe S{q.ws + OFF_HT - (size_t)256 * 256 * EFF, q.ws + OFF_MW2, (size_t)256 * EFF, (size_t)D * EFF, 256, ntl, D / 256, G, c, tab + 16};
                    pg8::EpiBf16 E{(u16*)(q.ws + OFF_RH), D, 1.f / (WSC_DN * ASC)}; pg8::gemm_phase<pg8::EpiBf16, pg8::SchedMoe, true, SCB_DN, SCB_ACT>(lds, EFF / 2, S, E, q.wave); }
                { pg8::SchedMoeSkip S{q.ws + OFF_HG8, q.ws + OFF_MW1, (size_t)256 * D, (size_t)2 * EFF * D, 128, 128, 2 * EFF / 256, G, c, tab + 16, ntl > 0 ? 4 * ntl : 0, 3};
                    pg8::EpiSwiglu8 E{(unsigned char*)(q.ws + OFF_RO), EFF, 128 * 256, ASC, 1.f / (WSC_UP * ASC)}; pg8::gemm_phase<pg8::EpiSwiglu8, pg8::SchedMoeSkip, true, SCB_UP, SCB_ACT>(lds, D / 2, S, E, q.wave); } }
            SEAM(base + 9);
            PHASE(base + 10) REP(15) { const Params q = fresh_params(p); LAS int* tab = (LAS int*)(lds + LDS_TAB); moe_tables(q, 0, tab);
                pg8::SchedMoe S{q.ws + OFF_RO - (size_t)128 * 256 * EFF, q.ws + OFF_MW2, (size_t)256 * EFF, (size_t)D * EFF, 128, 128, D / 256, G, c, tab + 16};
                pg8::EpiBf16 E{(u16*)(q.ws + OFF_RH), D, 1.f / (WSC_DN * ASC)}; pg8::gemm_phase<pg8::EpiBf16, pg8::SchedMoe, true, SCB_DN, SCB_ACT>(lds, EFF / 2, S, E, q.wave); }
            SEAM(base + 10);
            PHASE(base + 7 + 2 * MOE_NCHUNK) { const Params q = fresh_params(p); phase_ln2(q, layer); }
        }
    }
#undef PHASE
#undef SEAM
}

#include <cstdio>
#include <cstring>
#ifndef MK_LAUNCHES
#define MK_LAUNCHES 1
#endif
extern "C" void kernel_launch(void* const* d_in, const int* in_sizes, int n_in, void* d_out, int out_size, void* d_ws, size_t ws_size, hipStream_t stream) {
    static int grid = 0;
    if (grid == 0) {
        if (n_in != 29 || ws_size < WS_END) { fprintf(stderr, "kernel_launch: n_in %d ws %zu (need %zu)\n", n_in, ws_size, (size_t)WS_END); grid = -1; return; }
        int dev = 0, cus = 0, per_cu = 0;
        if (hipGetDevice(&dev) != hipSuccess || hipDeviceGetAttribute(&cus, hipDeviceAttributeMultiprocessorCount, dev) != hipSuccess) { grid = -1; return; }
        if (hipFuncSetAttribute((const void*)k_main, hipFuncAttributeMaxDynamicSharedMemorySize, LDS_BYTES) != hipSuccess) { fprintf(stderr, "kernel_launch: hipFuncSetAttribute failed\n"); grid = -1; return; }
        if (hipOccupancyMaxActiveBlocksPerMultiprocessor(&per_cu, (const void*)k_main, NTHR, LDS_BYTES) != hipSuccess || per_cu < 1) { fprintf(stderr, "kernel_launch: occupancy query says %d\n", per_cu); }
        grid = cus;
    }
    if (grid < 0) return;
    hipMemsetAsync((char*)d_ws + OFF_BAR, 0, 65536, stream);
    Params p; memset(&p, 0, sizeof(p));
    p.x = (const float*)d_in[0]; p.c = (const float*)d_in[1]; p.pos = (const int*)d_in[2]; p.w_ada = (const float*)d_in[3]; p.b_ada = (const float*)d_in[4]; p.w_in = (const float*)d_in[5];
    p.cmp_pos = (const float*)d_in[6]; p.cmp_w1 = (const float*)d_in[7]; p.cmp_w2 = (const float*)d_in[8]; p.kvn = (const float*)d_in[9]; p.w_uk = (const float*)d_in[10]; p.w_uv = (const float*)d_in[11];
    p.sgu_g = (const float*)d_in[12]; p.sgu_bn = (const float*)d_in[13]; p.sgu_w = (const float*)d_in[14]; p.sgu_b = (const float*)d_in[15]; p.w_out = (const float*)d_in[16];
    p.ln1g = (const float*)d_in[17]; p.ln1b = (const float*)d_in[18]; p.ln2g = (const float*)d_in[19]; p.ln2b = (const float*)d_in[20];
    p.fg = (const float*)d_in[21]; p.fu = (const float*)d_in[22]; p.fd = (const float*)d_in[23]; p.mr = (const float*)d_in[24]; p.mbr = (const float*)d_in[25]; p.mg = (const float*)d_in[26]; p.mu = (const float*)d_in[27]; p.md = (const float*)d_in[28];
    p.out = (float*)d_out; p.ws = (char*)d_ws;
#if MK_LAUNCHES == 1
    p.phase_lo = 0; p.phase_hi = PH_END; p.use_bar = 1;
    hipLaunchKernelGGL(k_main, dim3(grid), dim3(NTHR), LDS_BYTES, stream, p);
#else
    for (int ph = 0; ph < PH_END; ++ph) { p.phase_lo = ph; p.phase_hi = ph + 1; p.use_bar = 0; hipLaunchKernelGGL(k_main, dim3(grid), dim3(NTHR), LDS_BYTES, stream, p); }
#endif
}
```
